# Optimizing an MI355X kernel written in HIP

```python
import jax, jax.numpy as jnp
from jax import lax
import numpy as np

D_MODEL = 1024
BATCH = 2
SEQ = 8192
DEPTH = 2

RWKV_HEADS = 8
RWKV_HEAD_DIM = 64
RWKV_WIDTH = RWKV_HEADS * RWKV_HEAD_DIM
DECAY_LORA = 64
ICLR_LORA = 64
GATE_LORA = 128
RWKV_GN_EPS = 64e-5
RWKV_COLS = 3 * RWKV_WIDTH + DECAY_LORA + ICLR_LORA + GATE_LORA
RWKV_SPLITS = (RWKV_WIDTH, 2 * RWKV_WIDTH, 3 * RWKV_WIDTH, 3 * RWKV_WIDTH + DECAY_LORA, 3 * RWKV_WIDTH + DECAY_LORA + ICLR_LORA)

NSA_Q_HEADS = 8
NSA_KV_HEADS = 2
NSA_GROUP = NSA_Q_HEADS // NSA_KV_HEADS
NSA_HEAD_DIM = 64
NSA_WIDTH = NSA_Q_HEADS * NSA_HEAD_DIM
CMP_STRIDE = 16
CMP_BLOCK = 2 * CMP_STRIDE
CMP_HIDDEN = 256
SEL_BLOCK = 64
SEL_TOPK = 16
WINDOW = 512
Q_BLOCK = 128
FORCE_SCORE = 1e4
NEG_INF = -1e30
ROPE_THETA = 500000.0
ROPE_DIM = NSA_HEAD_DIM // 4
KV_COLS = 6 * NSA_KV_HEADS * NSA_HEAD_DIM
NSA_GATE_COLS = 3 * NSA_Q_HEADS

MERGE_COLS = 2 * D_MODEL
IN_COLS = RWKV_COLS + NSA_WIDTH + KV_COLS + NSA_GATE_COLS + MERGE_COLS
IN_SPLITS = (RWKV_COLS, RWKV_COLS + NSA_WIDTH, RWKV_COLS + NSA_WIDTH + KV_COLS, RWKV_COLS + NSA_WIDTH + KV_COLS + NSA_GATE_COLS)

N_EXPERTS = 16
N_GROUPS = 4
EXPERTS_PER_GROUP = N_EXPERTS // N_GROUPS
TOP_K = 2
D_EXPERT = 512
MOE_BLOCK = 256

NORM_EPS = 1e-6

kernel_name = "hybrid_rwkv7_nsa_grouped_moe_adaln"


def rms_norm(x, g):
    xf = x.astype(jnp.float32)
    y = xf * lax.rsqrt(jnp.mean(xf * xf, axis=-1, keepdims=True) + NORM_EPS)
    return (y * g.astype(jnp.float32)).astype(x.dtype)


def rope_partial(x, pos):
    half = ROPE_DIM // 2
    inv = jnp.power(ROPE_THETA, -jnp.arange(half, dtype=jnp.float32) * 2.0 / ROPE_DIM)
    ang = pos.astype(jnp.float32)[:, None] * inv[None, :]
    cos, sin = jnp.cos(ang), jnp.sin(ang)
    xf = x.astype(jnp.float32)
    x1, x2, rest = xf[..., :half], xf[..., half:ROPE_DIM], xf[..., ROPE_DIM:]
    out = jnp.concatenate([x1 * cos - x2 * sin, x2 * cos + x1 * sin, rest], axis=-1)
    return out.astype(x.dtype)


def masked_softmax(s, mask):
    s = jnp.where(mask, s.astype(jnp.float32), NEG_INF)
    m = jnp.max(s, axis=-1, keepdims=True)
    p = jnp.where(mask, jnp.exp(s - m), 0.0)
    return p / jnp.maximum(jnp.sum(p, axis=-1, keepdims=True), jnp.finfo(jnp.float32).tiny)


def token_shift(z):
    return jnp.pad(z[:, :-1], ((0, 0), (1, 0), (0, 0)))


def rwkv7_mix(p, mu, w0, w2, a0, a2, g2, k_k, k_a, r_k, gn_g, gn_b):
    B, T, _ = p.shape
    H, N = RWKV_HEADS, RWKV_HEAD_DIM
    f32 = jnp.float32
    pf = p.astype(f32)
    pf = pf + (token_shift(pf) - pf) * mu.astype(f32)
    r, k, v, wl, al, gl = jnp.split(pf, RWKV_SPLITS, axis=-1)
    w = -jax.nn.softplus(-(w0 + jnp.tanh(wl) @ w2)) - 0.5
    a = jax.nn.sigmoid(a0 + al @ a2)
    g = jax.nn.sigmoid(gl) @ g2
    heads = lambda z: z.reshape(B, T, H, N)
    kk = heads(k * k_k)
    kk = kk / jnp.maximum(jnp.sqrt(jnp.sum(kk * kk, axis=-1, keepdims=True)), 1e-12)
    k = k * (1.0 + (a - 1.0) * k_a)
    r, k, v, a = heads(r), heads(k), heads(v), heads(a)
    decay = jnp.exp(-jnp.exp(heads(w)))

    def step(S, inp):
        d_t, k_t, v_t, kk_t, a_t, r_t = inp
        sa = -jnp.einsum('bhij,bhj->bhi', S, kk_t)
        S = (S * d_t[:, :, None, :] + sa[..., None] * (kk_t * a_t)[:, :, None, :]
             + v_t[..., None] * k_t[:, :, None, :])
        return S, jnp.einsum('bhij,bhj->bhi', S, r_t)

    xs = tuple(jnp.moveaxis(z, 1, 0) for z in (decay, k, v, kk, a, r))
    _, y = lax.scan(step, jnp.zeros((B, H, N, N), f32), xs)
    y = jnp.moveaxis(y, 0, 1)
    mean = jnp.mean(y, axis=-1, keepdims=True)
    var = jnp.mean(jnp.square(y - mean), axis=-1, keepdims=True)
    y = (y - mean) * lax.rsqrt(var + RWKV_GN_EPS) * gn_g.reshape(H, N) + gn_b.reshape(H, N)
    y = y + jnp.sum(r * k * r_k, axis=-1, keepdims=True) * v
    return (y.reshape(B, T, RWKV_WIDTH) * g).astype(p.dtype)


def nsa_mix(q, kv, gates, qk_g, cmp_pos, cmp_w1, cmp_w2):
    B, T, _ = q.shape
    G, R, dh = NSA_KV_HEADS, NSA_GROUP, NSA_HEAD_DIM
    pos = jnp.arange(T, dtype=jnp.int32)
    scale = dh ** -0.5
    q = q.reshape(B, T, G, R, dh).transpose(0, 2, 3, 1, 4)
    q = rope_partial(rms_norm(q, qk_g[0]), pos)
    k_c, v_c, k_s, v_s, k_w, v_w = kv.reshape(B, T, 6, G, dh).transpose(2, 0, 3, 1, 4)
    k_s = rope_partial(rms_norm(k_s, qk_g[2]), pos)
    k_w = rope_partial(rms_norm(k_w, qk_g[3]), pos)

    n_chunk = T // CMP_STRIDE
    n_cmp = n_chunk - 1

    def compress(z, i):
        ch = z.reshape(B, G, n_chunk, CMP_STRIDE, dh)
        blk = jnp.concatenate([ch[:, :, :-1], ch[:, :, 1:]], axis=3) + cmp_pos[i]
        hid = jax.nn.gelu(blk.reshape(B, G, n_cmp, CMP_BLOCK * dh) @ cmp_w1[i])
        return hid @ cmp_w2[i]

    cmp_end = jnp.arange(n_cmp, dtype=jnp.int32) * CMP_STRIDE + CMP_BLOCK - 1
    k_cmp = rope_partial(rms_norm(compress(k_c, 0), qk_g[1]), cmp_end)
    v_cmp = compress(v_c, 1)

    n_sel = T // SEL_BLOCK
    topk = min(SEL_TOPK, n_sel)
    k_sb = k_s.reshape(B, G, n_sel, SEL_BLOCK, dh)
    v_sb = v_s.reshape(B, G, n_sel, SEL_BLOCK, dh)
    ci = jnp.arange(n_cmp)[:, None] * CMP_STRIDE
    sj = jnp.arange(n_sel)[None, :] * SEL_BLOCK
    overlap = ((ci <= sj + SEL_BLOCK - 1) & (ci + CMP_BLOCK - 1 >= sj)).astype(jnp.float32)
    bi = jnp.arange(B)[:, None, None, None]
    gi = jnp.arange(G)[None, :, None, None]
    sel_j = jnp.arange(n_sel, dtype=jnp.int32)

    k_wp = jnp.pad(k_w, ((0, 0), (0, 0), (WINDOW, 0), (0, 0)))
    v_wp = jnp.pad(v_w, ((0, 0), (0, 0), (WINDOW, 0), (0, 0)))

    def block_fn(args):
        qb, q0 = args
        t = q0 + jnp.arange(Q_BLOCK, dtype=jnp.int32)
        s = jnp.einsum('bgrqd,bgnd->bgrqn', qb, k_cmp) * scale
        p_c = masked_softmax(s, cmp_end[None, :] <= t[:, None])
        o_c = jnp.einsum('bgrqn,bgnd->bgrqd', p_c.astype(v_cmp.dtype), v_cmp)
        imp = jnp.einsum('bgqn,ns->bgqs', jnp.sum(p_c, axis=2), overlap)
        cur = (t // SEL_BLOCK)[:, None]
        forced = (sel_j[None, :] == 0) | (sel_j[None, :] == cur) | (sel_j[None, :] == cur - 1)
        valid = sel_j[None, :] * SEL_BLOCK <= t[:, None]
        imp = jnp.where(forced & valid, FORCE_SCORE, jnp.where(valid, imp, -1.0))
        _, sel = lax.top_k(imp, topk)
        ks = k_sb[bi, gi, sel].reshape(B, G, Q_BLOCK, topk * SEL_BLOCK, dh)
        vs = v_sb[bi, gi, sel].reshape(B, G, Q_BLOCK, topk * SEL_BLOCK, dh)
        kpos = (sel[..., None] * SEL_BLOCK + jnp.arange(SEL_BLOCK, dtype=jnp.int32)).reshape(B, G, Q_BLOCK, topk * SEL_BLOCK)
        s = jnp.einsum('bgrqd,bgqkd->bgrqk', qb, ks) * scale
        p_s = masked_softmax(s, (kpos <= t[:, None])[:, :, None])
        o_s = jnp.einsum('bgrqk,bgqkd->bgrqd', p_s.astype(vs.dtype), vs)
        kw = lax.dynamic_slice_in_dim(k_wp, q0, WINDOW + Q_BLOCK, axis=2)
        vw = lax.dynamic_slice_in_dim(v_wp, q0, WINDOW + Q_BLOCK, axis=2)
        spos = q0 - WINDOW + jnp.arange(WINDOW + Q_BLOCK, dtype=jnp.int32)
        wmask = (spos[None, :] <= t[:, None]) & (spos[None, :] > t[:, None] - WINDOW) & (spos[None, :] >= 0)
        s = jnp.einsum('bgrqd,bgkd->bgrqk', qb, kw) * scale
        p_w = masked_softmax(s, wmask)
        o_w = jnp.einsum('bgrqk,bgkd->bgrqd', p_w.astype(vw.dtype), vw)
        return o_c, o_s, o_w

    n_qb = T // Q_BLOCK
    qbs = q.reshape(B, G, R, n_qb, Q_BLOCK, dh).transpose(3, 0, 1, 2, 4, 5)
    starts = jnp.arange(n_qb, dtype=jnp.int32) * Q_BLOCK
    o_c, o_s, o_w = lax.map(block_fn, (qbs, starts))
    to_bthd = lambda o: o.transpose(1, 0, 4, 2, 3, 5).reshape(B, T, NSA_Q_HEADS, dh)
    gt = jax.nn.sigmoid(gates.reshape(B, T, NSA_Q_HEADS, 3))
    out = gt[..., 0:1] * to_bthd(o_c) + gt[..., 1:2] * to_bthd(o_s) + gt[..., 2:3] * to_bthd(o_w)
    return out.reshape(B, T, NSA_WIDTH).astype(q.dtype)


def moe_ffn(h, router_w, router_b, w_gate, w_up, w_down):
    B, T, D = h.shape
    N = B * T
    NK = N * TOP_K
    hf = h.reshape(N, D)
    score = jax.nn.sigmoid((hf @ router_w).astype(jnp.float32))
    sel_score = score + router_b.astype(jnp.float32)
    grp = sel_score.reshape(N, N_GROUPS, EXPERTS_PER_GROUP)
    grp_score = jnp.sum(lax.top_k(grp, TOP_K)[0], axis=-1)
    g_star = jnp.argmax(grp_score, axis=-1).astype(jnp.int32)
    in_grp = jnp.take_along_axis(grp, g_star[:, None, None], axis=1)[:, 0]
    _, loc = lax.top_k(in_grp, TOP_K)
    expert = g_star[:, None] * EXPERTS_PER_GROUP + loc.astype(jnp.int32)
    wts = jnp.take_along_axis(score, expert, axis=1)
    wts = wts / jnp.sum(wts, axis=-1, keepdims=True)

    e_flat = expert.reshape(-1)
    tok = jnp.repeat(jnp.arange(N, dtype=jnp.int32), TOP_K)
    order = jnp.argsort(e_flat)
    e_s, tok_s, w_s = e_flat[order], tok[order], wts.reshape(-1)[order]
    counts = jnp.zeros((N_EXPERTS,), jnp.int32).at[e_flat].add(1)
    seg_start = jnp.cumsum(counts) - counts
    padded = (counts + MOE_BLOCK - 1) // MOE_BLOCK * MOE_BLOCK
    pad_end = jnp.cumsum(padded)
    pad_start = pad_end - padded
    dest = pad_start[e_s] + jnp.arange(NK, dtype=jnp.int32) - seg_start[e_s]
    n_blk = -(-NK // MOE_BLOCK) + N_EXPERTS
    P = n_blk * MOE_BLOCK
    slot_tok = jnp.full((P,), N, jnp.int32).at[dest].set(tok_s)
    slot_w = jnp.zeros((P,), h.dtype).at[dest].set(w_s.astype(h.dtype))
    blk_start = jnp.arange(n_blk, dtype=jnp.int32) * MOE_BLOCK
    blk_expert = jnp.clip(jnp.searchsorted(pad_end, blk_start, side='right'), 0, N_EXPERTS - 1)
    hp = jnp.concatenate([hf, jnp.zeros((1, D), h.dtype)], axis=0)
    xb = hp[slot_tok].reshape(n_blk, MOE_BLOCK, D)

    def expert_block(args):
        xe, e = args
        return (jax.nn.silu(xe @ w_gate[e]) * (xe @ w_up[e])) @ w_down[e]

    yb = lax.map(expert_block, (xb, blk_expert)).reshape(P, D)
    y = jnp.zeros((N + 1, D), h.dtype).at[slot_tok].add(yb * slot_w[:, None])
    return y[:N].reshape(B, T, D)


def setup_inputs(seed: int = 0) -> dict:
    key = jax.random.key(seed)
    ks = jax.random.split(key, 32)
    f32 = jnp.float32
    D, L = D_MODEL, DEPTH
    nrm = lambda k, shape, s: jax.random.normal(k, shape, f32) * s
    return {
        "x": nrm(ks[0], (BATCH, SEQ, D), 1.0),
        "c": nrm(ks[1], (BATCH, D), 1.0),
        "w_ada": nrm(ks[2], (L, D, 6 * D), 0.5 * D ** -0.5),
        "b_ada": nrm(ks[3], (L, 6 * D), 0.02),
        "norm_g": 1.0 + nrm(ks[4], (L, 2, D), 0.02),
        "w_in": nrm(ks[5], (L, D, IN_COLS), D ** -0.5),
        "b_in": nrm(ks[6], (L, IN_COLS), 0.02),
        "rwkv_mu": jax.random.uniform(ks[7], (L, RWKV_COLS), f32, 0.0, 1.0),
        "rwkv_w0": jax.random.uniform(ks[8], (L, RWKV_WIDTH), f32, -6.0, -1.0),
        "rwkv_w2": nrm(ks[9], (L, DECAY_LORA, RWKV_WIDTH), DECAY_LORA ** -0.5),
        "rwkv_a0": nrm(ks[10], (L, RWKV_WIDTH), 0.1),
        "rwkv_a2": nrm(ks[11], (L, ICLR_LORA, RWKV_WIDTH), 0.5 * ICLR_LORA ** -0.5),
        "rwkv_g2": nrm(ks[12], (L, GATE_LORA, RWKV_WIDTH), GATE_LORA ** -0.5),
        "rwkv_k_k": 0.85 + nrm(ks[13], (L, RWKV_WIDTH), 0.02),
        "rwkv_k_a": 1.0 + nrm(ks[14], (L, RWKV_WIDTH), 0.02),
        "rwkv_r_k": nrm(ks[15], (L, RWKV_HEADS, RWKV_HEAD_DIM), 0.1),
        "rwkv_gn_g": 1.0 + nrm(ks[16], (L, RWKV_WIDTH), 0.02),
        "rwkv_gn_b": nrm(ks[17], (L, RWKV_WIDTH), 0.02),
        "qk_norm_g": 1.0 + nrm(ks[18], (L, 4, NSA_HEAD_DIM), 0.02),
        "cmp_pos": nrm(ks[19], (L, 2, CMP_BLOCK, NSA_HEAD_DIM), 0.1),
        "cmp_w1": nrm(ks[20], (L, 2, CMP_BLOCK * NSA_HEAD_DIM, CMP_HIDDEN), (CMP_BLOCK * NSA_HEAD_DIM) ** -0.5),
        "cmp_w2": nrm(ks[21], (L, 2, CMP_HIDDEN, NSA_HEAD_DIM), CMP_HIDDEN ** -0.5),
        "w_up_rwkv": nrm(ks[22], (L, RWKV_WIDTH, D), RWKV_WIDTH ** -0.5),
        "w_up_nsa": nrm(ks[23], (L, NSA_WIDTH, D), NSA_WIDTH ** -0.5),
        "w_out": nrm(ks[24], (L, D, D), D ** -0.5),
        "router_w": nrm(ks[25], (D, N_EXPERTS), D ** -0.5),
        "router_b": nrm(ks[26], (N_EXPERTS,), 0.01),
        "exp_w_gate": nrm(ks[27], (L, N_EXPERTS, D, D_EXPERT), D ** -0.5),
        "exp_w_up": nrm(ks[28], (L, N_EXPERTS, D, D_EXPERT), D ** -0.5),
        "exp_w_down": nrm(ks[29], (L, N_EXPERTS, D_EXPERT, D), D_EXPERT ** -0.5),
    }


def reference(x, c, w_ada, b_ada, norm_g, w_in, b_in, rwkv_mu, rwkv_w0, rwkv_w2, rwkv_a0, rwkv_a2,
              rwkv_g2, rwkv_k_k, rwkv_k_a, rwkv_r_k, rwkv_gn_g, rwkv_gn_b, qk_norm_g, cmp_pos, cmp_w1,
              cmp_w2, w_up_rwkv, w_up_nsa, w_out, router_w, router_b, exp_w_gate, exp_w_up, exp_w_down):
    for l in range(DEPTH):
        mod = jax.nn.silu(c) @ w_ada[l] + b_ada[l]
        sh1, sc1, gate_mix, sh2, sc2, gate_ffn = jnp.split(mod[:, None, :], 6, axis=-1)
        h = rms_norm(x, norm_g[l, 0]) * (1.0 + sc1) + sh1
        p = h @ w_in[l] + b_in[l]
        p_rwkv, p_q, p_kv, p_gate, p_merge = jnp.split(p, IN_SPLITS, axis=-1)
        y_a = rwkv7_mix(p_rwkv, rwkv_mu[l], rwkv_w0[l], rwkv_w2[l], rwkv_a0[l], rwkv_a2[l], rwkv_g2[l],
                        rwkv_k_k[l], rwkv_k_a[l], rwkv_r_k[l], rwkv_gn_g[l], rwkv_gn_b[l])
        y_b = nsa_mix(p_q, p_kv, p_gate, qk_norm_g[l], cmp_pos[l], cmp_w1[l], cmp_w2[l])
        m_a, m_b = jnp.split(jax.nn.sigmoid(p_merge), 2, axis=-1)
        mix = m_a * (y_a @ w_up_rwkv[l]) + m_b * (y_b @ w_up_nsa[l])
        x = x + gate_mix * (mix @ w_out[l])
        h2 = rms_norm(x, norm_g[l, 1]) * (1.0 + sc2) + sh2
        x = x + gate_ffn * moe_ffn(h2, router_w, router_b, exp_w_gate[l], exp_w_up[l], exp_w_down[l])
    return x
```

```cpp
#include <hip/hip_runtime.h>
#include <cstdio>
#include <cstdint>

#ifndef MK_N_LAUNCHES
#define MK_N_LAUNCHES 1
#endif

#define LAS __attribute__((address_space(3)))
typedef unsigned short bf16;
typedef short bf16x8 __attribute__((ext_vector_type(8)));
typedef short bf16x4 __attribute__((ext_vector_type(4)));
typedef float f32x4 __attribute__((ext_vector_type(4)));
typedef float f32x16 __attribute__((ext_vector_type(16)));
typedef float f32x2 __attribute__((ext_vector_type(2)));
typedef unsigned u32x4 __attribute__((ext_vector_type(4)));
typedef unsigned u32x2 __attribute__((ext_vector_type(2)));

constexpr int NB = 2, T = 8192, D = 1024, NTOK = NB * T, DEPTH = 2;
constexpr int RW = 512, RCOLS = 1792;
constexpr int QOFF = 1792, KVOFF = 2304, GOFF = 3072;
constexpr int N1 = 3096, N1P = 3072;
constexpr int NMRG = 2048, INC = 5144;
constexpr int NE = 16, DE = 512, NSLOT = 36864;
constexpr int NCMP = 511, NCMPP = 512;

constexpr size_t MiB = 1u << 20;
constexpr size_t WS_CTL = 0, CTL_BYTES = 1 * MiB;
constexpr size_t WS_SMALL = 1 * MiB;
constexpr size_t SM_MOD = 0;
constexpr size_t SM_ROPE = 128 * 1024;
constexpr size_t SM_CMPB = 704 * 1024;
constexpr size_t SM_BLK = 720 * 1024;
constexpr size_t SM_S2T = 768 * 1024;
constexpr size_t WS_TOK = 2 * MiB;
constexpr size_t WS_W = 3 * MiB;
constexpr size_t LW_WIN1 = 0;
constexpr size_t LW_WM = LW_WIN1 + (size_t)N1P * D * 2;
constexpr size_t LW_UPA = LW_WM + (size_t)NMRG * D * 2;
constexpr size_t LW_UPB = LW_UPA + (size_t)D * RW * 2;
constexpr size_t LW_OUT = LW_UPB + (size_t)D * RW * 2;
constexpr size_t LW_C1 = LW_OUT + (size_t)D * D * 2;
constexpr size_t LW_C2 = LW_C1 + (size_t)2 * 256 * 2048 * 2;
constexpr size_t LW_L2 = LW_C2 + (size_t)2 * 64 * 256 * 2;
constexpr size_t LW_A2 = LW_L2 + (size_t)512 * 64 * 2;
constexpr size_t LW_G2 = LW_A2 + (size_t)512 * 64 * 2;
constexpr size_t LW_WG = LW_G2 + (size_t)512 * 128 * 2;
constexpr size_t LW_BYTES = ((LW_WG + (size_t)64 * 1024 * 2 + MiB - 1) / MiB) * MiB;
constexpr size_t WS_H = WS_W + 2 * LW_BYTES;
constexpr size_t WS_R = WS_H + 32 * MiB;
constexpr size_t WS_P1 = WS_R;
constexpr size_t WS_RW = WS_R + 104 * MiB;
constexpr size_t RWT = (size_t)NTOK * RW * 2;
constexpr size_t WS_NSA = WS_RW + 128 * MiB;
constexpr size_t NS_Q = WS_NSA;
constexpr size_t KVT = (size_t)4 * T * 64 * 2;
constexpr size_t NS_KS = NS_Q + 16 * MiB, NS_KW = NS_KS + KVT, NS_VST = NS_KW + KVT, NS_VWT = NS_VST + KVT, NS_KC = NS_VWT + KVT, NS_VC = NS_KC + KVT;
constexpr size_t NS_KCMP = NS_VC + KVT;
constexpr size_t NS_VCMPT = NS_KCMP + (size_t)4 * 512 * 64 * 2;
constexpr size_t NS_GATE = NS_VCMPT + (size_t)4 * 512 * 64 * 2;
constexpr size_t NS_END = NS_GATE + (size_t)NTOK * 24 * 4;
constexpr size_t WS_Y = WS_R;
constexpr size_t WS_YA = WS_R + 32 * MiB, WS_YB = WS_YA + 16 * MiB;
constexpr size_t WS_WN = WS_R + 64 * MiB;
constexpr size_t WS_UPN = WS_R + 80 * MiB;
constexpr size_t WS_GC = WS_R + 96 * MiB;
constexpr size_t WS_PT = WS_R;
constexpr size_t WS_S0 = WS_RW + 48 * MiB;
constexpr size_t WS_PM = WS_R + 64 * MiB;
constexpr size_t WS_TMP = WS_R + 128 * MiB;
constexpr size_t WS_MIX = WS_R + 160 * MiB;
constexpr size_t WS_E2T = WS_R + 32 * MiB;
constexpr size_t WS_XR = WS_R;
constexpr size_t WS_XB = WS_H;
constexpr size_t WS_ACT = WS_XB + 72 * MiB;
constexpr size_t WS_YBS = WS_ACT + 36 * MiB;
constexpr size_t WS_WGU = WS_YBS + 72 * MiB;
constexpr size_t WS_WD = WS_WGU + 32 * MiB;
constexpr size_t WS_END_MOE = WS_WD + 16 * MiB;
constexpr size_t WS_END = (NS_END > WS_END_MOE ? NS_END : WS_END_MOE);
static_assert(WS_MIX + 32 * MiB <= WS_NSA + 64 * MiB, "map");
static_assert(WS_END <= 370 * MiB, "workspace too large");

constexpr int CW_QUEUE = 256;
constexpr int CW_CNT = 512;
constexpr int CW_BAR = 4096;

typedef __bf16 bf16x2_h __attribute__((ext_vector_type(2)));
__device__ __forceinline__ unsigned pk2(float lo, float hi) { const f32x2 v = {lo, hi}; const bf16x2_h b = __builtin_convertvector(v, bf16x2_h); return __builtin_bit_cast(unsigned, b); }
__device__ __forceinline__ unsigned f2bf(float f) { return pk2(f, 0.f) & 0xffffu; }
__device__ __forceinline__ float bf2f(unsigned h) { return __builtin_bit_cast(float, h << 16); }
__device__ __forceinline__ float bflo(unsigned w) { return __builtin_bit_cast(float, w << 16); }
__device__ __forceinline__ float bfhi(unsigned w) { return __builtin_bit_cast(float, w & 0xffff0000u); }
__device__ __forceinline__ float rcpf_(float x) { return __builtin_amdgcn_rcpf(x); }
__device__ __forceinline__ float sigmoidf_(float x) { return rcpf_(1.f + __expf(-x)); }
template <int CTRL> __device__ __forceinline__ float dpp_mov(float v) { return __builtin_bit_cast(float, __builtin_amdgcn_update_dpp(0, __builtin_bit_cast(int, v), CTRL, 0xF, 0xF, true)); }
template <int M> __device__ __forceinline__ float xor_lane(float v) {
    if constexpr (M == 1) return dpp_mov<0xB1>(v); else if constexpr (M == 2) return dpp_mov<0x4E>(v); else return __shfl_xor(v, M, 64);
}
__device__ __forceinline__ float sum_halves(float v) { return v + __shfl_xor(v, 32, 64); }
__device__ __forceinline__ float max_halves(float v) { return fmaxf(v, __shfl_xor(v, 32, 64)); }
__device__ __forceinline__ float other_half(float v, int hi) { return __shfl_xor(v, 32, 64); }
__device__ __forceinline__ float sum8(float v) { v += dpp_mov<0xB1>(v); v += dpp_mov<0x4E>(v); v += dpp_mov<0x141>(v); return v; }
__device__ __forceinline__ float sum16(float v) { v = sum8(v); v += dpp_mov<0x140>(v); return v; }
__device__ __forceinline__ float sum32(float v) { v = sum16(v); v += xor_lane<16>(v); return v; }
__device__ __forceinline__ float sum64(float v) { return sum_halves(sum32(v)); }

#define XB_TMO      128
#define XB_XCNT(j)  (256  + 64 * (j))
#define XB_XSUB(j)  (1280 + 64 * (j))
#define XB_XGEN(j)  (2304 + 64 * (j))
#define XB_TOP      3328
#define XB_TOPGEN   3392
#define XCD_BAR_WORDS 3456
#define XB_SPIN_CAP (1u << 22)
__device__ __forceinline__ unsigned xb_ld(unsigned* p)              { return __hip_atomic_load(p, __ATOMIC_RELAXED, __HIP_MEMORY_SCOPE_AGENT); }
__device__ __forceinline__ unsigned xb_add(unsigned* p, unsigned v) { return __hip_atomic_fetch_add(p, v, __ATOMIC_RELAXED, __HIP_MEMORY_SCOPE_AGENT); }
__device__ __forceinline__ unsigned xb_xcc_id() { return (unsigned)__builtin_amdgcn_s_getreg((3 << 11) | 20) & 0xFu; }
#define XB_SPIN(cond, bar) do { unsigned _sp = 0; while (cond) { __builtin_amdgcn_s_sleep(1); \
    if ((++_sp & 255u) == 0u) { if (xb_ld(&(bar)[XB_TMO])) break; if (_sp > XB_SPIN_CAP) { atomicAdd(&(bar)[XB_TMO], 1u); break; } } } } while (0)
struct XcdBarrier { unsigned* bar; unsigned x; volatile LAS unsigned* st; };
__device__ __forceinline__ XcdBarrier xcd_barrier_post(unsigned* bar, volatile LAS unsigned* st) {
    XcdBarrier b; b.bar = bar; b.x = xb_xcc_id(); b.st = st;
    if (threadIdx.x == 0) (void)xb_add(&bar[XB_XCNT(b.x)], 1u);
    return b;
}
__device__ __forceinline__ void xcd_barrier_complete(unsigned* bar, unsigned x, unsigned& nloc, unsigned& nx) {
    const unsigned G = gridDim.x * gridDim.y * gridDim.z;
    unsigned sum, cnt, mine, sp = 0u;
    for (;;) {
        sum = 0u; cnt = 0u; mine = 0u;
#pragma unroll
        for (unsigned j = 0; j < 16; ++j) { const unsigned c = xb_ld(&bar[XB_XCNT(j)]); sum += c; cnt += (c > 0u) ? 1u : 0u; mine = (j == x) ? c : mine; }
        if (sum == G) break;
        __builtin_amdgcn_s_sleep(1);
        if ((++sp & 255u) == 0u) { if (xb_ld(&bar[XB_TMO])) break; if (sp > XB_SPIN_CAP) { atomicAdd(&bar[XB_TMO], 1u); break; } }
    }
    nloc = mine > 0u ? mine : 1u; nx = cnt > 0u ? cnt : 1u;
}
__device__ __forceinline__ void xcd_barrier(const XcdBarrier& b) {
    asm volatile("s_waitcnt vmcnt(0)" ::: "memory");
    __syncthreads();
    if (threadIdx.x == 0) {
        unsigned* bar = b.bar;
        __builtin_amdgcn_s_waitcnt(0);
        unsigned nloc = b.st[0], nx = b.st[1];
        if (nloc == 0u) { xcd_barrier_complete(bar, b.x, nloc, nx); b.st[0] = nloc; b.st[1] = nx; }
        const unsigned old = xb_add(&bar[XB_XSUB(b.x)], 1u);
        const unsigned gen = old / nloc;
        if (old + 1u == (gen + 1u) * nloc) {
            __builtin_amdgcn_fence(__ATOMIC_RELEASE, "agent");
            asm volatile("s_waitcnt vmcnt(0)" ::: "memory");
            const unsigned og = xb_add(&bar[XB_TOP], 1u);
            const unsigned tg = og / nx;
            if (og + 1u == (tg + 1u) * nx) xb_add(&bar[XB_TOPGEN], 1u);
            else XB_SPIN(xb_ld(&bar[XB_TOPGEN]) == tg, bar);
            __builtin_amdgcn_fence(__ATOMIC_ACQUIRE, "agent");
            xb_add(&bar[XB_XGEN(b.x)], 1u);
            asm volatile("s_waitcnt vmcnt(0)" ::: "memory");
        } else {
            XB_SPIN(xb_ld(&bar[XB_XGEN(b.x)]) == gen, bar);
            __builtin_amdgcn_fence(__ATOMIC_ACQUIRE, "agent");
            asm volatile("s_waitcnt vmcnt(0)" ::: "memory");
        }
    }
    __syncthreads();
}

namespace pg8 {
#define PG8_LAS __attribute__((address_space(3)))
typedef unsigned short bf16_t;
constexpr int BM = 256, BK = 64, HALF = 128, HTB = HALF * BK * 2, STAGE_BYTES = 8 * HTB, NXCD = 8, WGM = 8;
__host__ __device__ __forceinline__ int lds_byte(int r, int c) { const int st = (r >> 4) * 2 + (c >> 5), rr = r & 15, cc = c & 31, ob = rr * 64 + cc * 2; return st * 1024 + (ob ^ (((ob >> 9) & 1) << 5)); }
__host__ __device__ __forceinline__ void stage_rc(int b, int& R, int& C) { const int st = b / 1024, sb = b % 1024, swz = sb ^ (((sb >> 9) & 1) << 5); R = (st >> 1) * 16 + swz / 64; C = (st & 1) * 32 + (swz % 64) / 2; }
__host__ __device__ __forceinline__ int perm32(int rho) { const int n = rho >> 4, i = rho & 15; return 8 * (i >> 2) + 4 * n + (i & 3); }
struct Unit { int pm, pn, bt, part; };
struct Gemm { const bf16_t* A; const bf16_t* Bt; int K; };
struct StaticOrder {
    int nM, nN, nwg, G, c;
    __device__ void init(int M, int N, int G_, int c_) { nM = M / BM; nN = N / BM; nwg = nM * nN; G = G_; c = c_; }
    __device__ bool next(int i, Unit& u) const {
        const long L = (long)i * G + c; if (L >= nwg) return false;
        int wgid = (int)L; { const int q = nwg / NXCD, r = nwg % NXCD, xcd = wgid % NXCD, off = wgid / NXCD; wgid = (xcd < r ? xcd * (q + 1) : r * (q + 1) + (xcd - r) * q) + off; }
        const int nig = WGM * nN, gid = wgid / nig, fm = gid * WGM, gsz = (nM - fm) < WGM ? (nM - fm) : WGM;
        u.pm = fm + ((wgid % nig) % gsz); u.pn = (wgid % nig) / gsz; u.bt = u.pn; u.part = 1; return true;
    }
};
struct MergePairOrder {
    StaticOrder base;
    __device__ bool next(int i, Unit& u) const { Unit b; if (!base.next(i >> 1, b)) return false; u.pm = b.pm; u.pn = b.pn + 4 * (i & 1); u.bt = u.pn; u.part = 1; return true; }
};
struct UpPairOrder {
    StaticOrder base;
    __device__ bool next(int i, Unit& u) const { Unit b; if (!base.next(i >> 1, b)) return false; const int p = i & 1; u.pm = b.pm + 64 * p; u.pn = b.pn; u.bt = b.pn + 4 * p; u.part = p; return true; }
};
struct MoeOrder {
    const PG8_LAS int* tb; int G, c; const int* e2t;
    __device__ bool next(int i, Unit& u) const {
        const int L = i * G + c; if (L >= tb[0] * 4) return false;
        u.pm = L >> 2; u.pn = L & 3; u.bt = tb[64 + u.pm] * 4 + u.pn; u.part = 1; return true;
    }
    __device__ int row_token(int pm, int r) const {
        const int e = tb[64 + pm], p = (pm - tb[1 + e]) * BM + r;
        return p < tb[17 + e] ? ((const __attribute__((address_space(1))) int*)e2t)[e * 16384 + p] : 0;
    }
};
typedef __bf16 bf16x2_c __attribute__((ext_vector_type(2)));
__device__ __forceinline__ unsigned cvt_pk_bf16(float lo, float hi) { const f32x2 v = {lo, hi}; const bf16x2_c b = __builtin_convertvector(v, bf16x2_c); return __builtin_bit_cast(unsigned, b); }

template <class Epi, class Sched, bool ALIGN_EPI = true, bool SP2 = true, bool GATHER = false>
__device__ __forceinline__ void gemm_phase(PG8_LAS unsigned char* lds, const Gemm g, const Sched& S, const Epi& E, const int tid, const int* rowidx = nullptr) {
    static_assert(!GATHER || SP2, "gather is wired into the SP2 schedule only");
    const int wid = __builtin_amdgcn_readfirstlane(tid >> 6), lane = tid & 63, wr = wid >> 2, wc = wid & 3, fr = lane & 15, fq = lane >> 4;
    const int K = g.K, nt = K / BK;
    unsigned voffA[2], voffB[2]; int rowA[2]; unsigned colA[2];
#pragma unroll
    for (int i = 0; i < 2; ++i) { int R, C; stage_rc(tid * 16 + i * 8192, R, C); const int Rb = Epi::PERM ? ((R & ~31) + perm32(R & 31)) : R;
        voffA[i] = (unsigned)(R * K + C) * 2u; voffB[i] = (unsigned)(Rb * K + C) * 2u; rowA[i] = R; colA[i] = (unsigned)C * 2u; }
    unsigned cvo[2][2], nvo[2][2];
#define PG8_VO(dst, pmv) do { _Pragma("unroll") for (int _h = 0; _h < 2; ++_h) _Pragma("unroll") for (int _i = 0; _i < 2; ++_i) dst[_h][_i] = (unsigned)S.row_token((pmv), _h * HALF + rowA[_i]) * (unsigned)(K * 2) + colA[_i]; } while (0)
#define PG8_VOCP(dst, src) do { _Pragma("unroll") for (int _h = 0; _h < 2; ++_h) _Pragma("unroll") for (int _i = 0; _i < 2; ++_i) dst[_h][_i] = src[_h][_i]; } while (0)
    const size_t kstep = (size_t)(BK * 2);
    const size_t hstep = (size_t)HALF * K * 2;
    const size_t tstep = 2 * hstep;
    const unsigned ldsw = (unsigned)wid * 1024u;
    const int aoff = lds_byte(wr * 64 + fr, fq * 8), boff = lds_byte(wc * 32 + fr, fq * 8);
#define PG8_SA(b, h) (((b) * 2 + (h)) * HTB)
#define PG8_SB(b, h) ((4 + (b) * 2 + (h)) * HTB)
#define PG8_STAGE(bufoff, gbase, voff) do { _Pragma("unroll") for (int _i = 0; _i < 2; ++_i) \
        __builtin_amdgcn_global_load_lds((const unsigned*)((const char*)(gbase) + (voff)[_i]), (PG8_LAS unsigned*)(lds + (bufoff) + ldsw + _i * 8192), 16, 0, 0); } while (0)
#define PG8_STAGE_A(bufoff, kb, h, nx) do { if constexpr (GATHER) { const unsigned vo_[2] = {(nx) ? nvo[h][0] : cvo[h][0], (nx) ? nvo[h][1] : cvo[h][1]}; PG8_STAGE(bufoff, kb, vo_); } \
        else { PG8_STAGE(bufoff, (kb) + (h) * hstep, voffA); } } while (0)
#define PG8_LDA(dst, b, h) do { _Pragma("unroll") for (int m = 0; m < 4; ++m) _Pragma("unroll") for (int k = 0; k < 2; ++k) dst[m][k] = *(const PG8_LAS bf16x8*)(lds + PG8_SA(b, h) + aoff + m * 2048 + k * 1024); } while (0)
#define PG8_LDB(dst, b, h) do { _Pragma("unroll") for (int n = 0; n < 2; ++n) _Pragma("unroll") for (int k = 0; k < 2; ++k) dst[n][k] = *(const PG8_LAS bf16x8*)(lds + PG8_SB(b, h) + boff + n * 2048 + k * 1024); } while (0)
#define PG8_MMA(ai, bj, At, Bt) do { __builtin_amdgcn_s_setprio(1); _Pragma("unroll") for (int m = 0; m < 4; ++m) _Pragma("unroll") for (int n = 0; n < 2; ++n) _Pragma("unroll") for (int k = 0; k < 2; ++k) \
        acc[ai][bj][m][n] = __builtin_amdgcn_mfma_f32_16x16x32_bf16(Bt[n][k], At[m][k], acc[ai][bj][m][n], 0, 0, 0); __builtin_amdgcn_s_setprio(0); } while (0)
#define PG8_WAIT_V(n) asm volatile("s_waitcnt vmcnt(" #n ")" ::: "memory")
#define PG8_WAIT_L(n) asm volatile("s_waitcnt lgkmcnt(" #n ")" ::: "memory")
#define PG8_BAR __builtin_amdgcn_s_barrier()
#define PG8_SCHED __builtin_amdgcn_sched_barrier(0)
    Unit cur, nxt; int ui = 0; bool has_next = false;
    if (!S.next(0, cur)) return;
    if constexpr (GATHER) { PG8_VO(cvo, cur.pm); has_next = S.next(1, nxt); if (has_next) PG8_VO(nvo, nxt.pm); else PG8_VOCP(nvo, cvo); }
    f32x4 acc[2][2][4][2];
#pragma unroll
    for (int a = 0; a < 2; ++a)
#pragma unroll
        for (int b = 0; b < 2; ++b)
#pragma unroll
            for (int m = 0; m < 4; ++m)
#pragma unroll
                for (int n = 0; n < 2; ++n) acc[a][b][m][n] = (f32x4){0.f, 0.f, 0.f, 0.f};
    bf16x8 At[4][2], B0[2][2], B1[2][2];
    const char* cA = (const char*)g.A + (GATHER ? (size_t)0 : (size_t)cur.pm * tstep); const char* cB = (const char*)g.Bt + (size_t)cur.bt * tstep;
    if constexpr (SP2) {
        PG8_STAGE(PG8_SB(0, 0), cB, voffB); PG8_STAGE(PG8_SB(0, 1), cB + hstep, voffB); PG8_STAGE_A(PG8_SA(0, 0), cA, 0, false); PG8_STAGE_A(PG8_SA(0, 1), cA, 1, false);
        if (wr == 1) PG8_BAR;
        PG8_WAIT_V(2); PG8_BAR;
        PG8_STAGE(PG8_SB(1, 0), cB + kstep, voffB); PG8_STAGE_A(PG8_SA(1, 0), cA + kstep, 0, false); PG8_STAGE(PG8_SB(1, 1), cB + hstep + kstep, voffB);
        PG8_WAIT_V(6); PG8_BAR;
    } else {
        PG8_STAGE(PG8_SB(0, 0), cB, voffB); PG8_STAGE(PG8_SA(0, 0), cA, voffA); PG8_STAGE(PG8_SB(0, 1), cB + hstep, voffB); PG8_STAGE(PG8_SA(0, 1), cA + hstep, voffA);
        if (wr == 1) PG8_BAR;
        PG8_WAIT_V(4); PG8_BAR;
        PG8_STAGE(PG8_SB(1, 0), cB + kstep, voffB); PG8_STAGE(PG8_SA(1, 0), cA + kstep, voffA); PG8_STAGE(PG8_SB(1, 1), cB + hstep + kstep, voffB);
        PG8_WAIT_V(6); PG8_BAR;
    }
    for (;;) {
        if constexpr (!GATHER) has_next = S.next(ui + 1, nxt);
        const char* nA = (has_next && !GATHER) ? (const char*)g.A + (size_t)nxt.pm * tstep : cA; const char* nB = has_next ? (const char*)g.Bt + (size_t)nxt.bt * tstep : cB;
        for (int t = 0; t < nt; t += 2) {
            const bool last = (t == nt - 2);
            const char* a1 = cA + (size_t)(t + 1) * kstep;
            const char* a2 = last ? nA : cA + (size_t)(t + 2) * kstep; const char* b2 = last ? nB : cB + (size_t)(t + 2) * kstep;
            const char* a3 = a2 + kstep; const char* b3 = b2 + kstep;
            if constexpr (SP2) {
            PG8_LDB(B0, 0, 0); PG8_LDB(B1, 0, 1); PG8_SCHED; PG8_LDA(At, 0, 0); PG8_STAGE_A(PG8_SA(1, 1), a1, 1, false);
            PG8_WAIT_V(8); PG8_WAIT_L(0); PG8_BAR; PG8_MMA(0, 0, At, B0); PG8_MMA(0, 1, At, B1); PG8_BAR; PG8_SCHED;
            PG8_LDA(At, 0, 1); PG8_STAGE(PG8_SB(0, 0), b2, voffB); PG8_STAGE(PG8_SB(0, 1), b2 + hstep, voffB); PG8_STAGE_A(PG8_SA(0, 0), a2, 0, last);
            PG8_WAIT_V(8); PG8_WAIT_L(0); PG8_BAR; PG8_MMA(1, 0, At, B0); PG8_MMA(1, 1, At, B1); PG8_BAR; PG8_SCHED;
            PG8_LDB(B0, 1, 0); PG8_LDB(B1, 1, 1); PG8_SCHED; PG8_LDA(At, 1, 0); PG8_STAGE_A(PG8_SA(0, 1), a2, 1, last);
            PG8_WAIT_V(8); PG8_WAIT_L(0); PG8_BAR; PG8_MMA(0, 0, At, B0); PG8_MMA(0, 1, At, B1); PG8_BAR; PG8_SCHED;
            PG8_LDA(At, 1, 1); PG8_STAGE(PG8_SB(1, 0), b3, voffB); PG8_STAGE(PG8_SB(1, 1), b3 + hstep, voffB); PG8_STAGE_A(PG8_SA(1, 0), a3, 0, last);
            PG8_WAIT_V(8); PG8_WAIT_L(0); PG8_BAR; PG8_MMA(1, 0, At, B0); PG8_MMA(1, 1, At, B1); PG8_BAR; PG8_SCHED;
            } else {
            PG8_LDB(B0, 0, 0); PG8_SCHED; PG8_LDA(At, 0, 0); PG8_STAGE(PG8_SA(1, 1), a1 + hstep, voffA);
            PG8_WAIT_L(8); PG8_BAR; PG8_WAIT_L(0); PG8_MMA(0, 0, At, B0); PG8_BAR; PG8_SCHED;
            PG8_LDB(B1, 0, 1); PG8_STAGE(PG8_SB(0, 0), b2, voffB);
            PG8_BAR; PG8_WAIT_L(0); PG8_MMA(0, 1, At, B1); PG8_BAR;
            PG8_LDA(At, 0, 1); PG8_STAGE(PG8_SA(0, 0), a2, voffA);
            PG8_BAR; PG8_WAIT_L(0); PG8_MMA(1, 0, At, B0); PG8_BAR; PG8_SCHED;
            PG8_STAGE(PG8_SB(0, 1), b2 + hstep, voffB);
            PG8_WAIT_V(6); PG8_BAR; PG8_MMA(1, 1, At, B1); PG8_BAR;
            PG8_LDB(B0, 1, 0); PG8_SCHED; PG8_LDA(At, 1, 0); PG8_STAGE(PG8_SA(0, 1), a2 + hstep, voffA);
            PG8_WAIT_L(8); PG8_BAR; PG8_WAIT_L(0); PG8_MMA(0, 0, At, B0); PG8_BAR; PG8_SCHED;
            PG8_LDB(B1, 1, 1); PG8_STAGE(PG8_SB(1, 0), b3, voffB);
            PG8_BAR; PG8_WAIT_L(0); PG8_MMA(0, 1, At, B1); PG8_BAR;
            PG8_LDA(At, 1, 1); PG8_STAGE(PG8_SA(1, 0), a3, voffA);
            PG8_BAR; PG8_WAIT_L(0); PG8_MMA(1, 0, At, B0); PG8_BAR; PG8_SCHED;
            PG8_STAGE(PG8_SB(1, 1), b3 + hstep, voffB);
            PG8_WAIT_V(6); PG8_BAR; PG8_MMA(1, 1, At, B1); PG8_BAR;
            }
        }
        Unit nn = nxt; bool has_nn = false; unsigned nnvo[2][2];
        if constexpr (GATHER) { has_nn = has_next && S.next(ui + 2, nn); if (has_nn) PG8_VO(nnvo, nn.pm); else PG8_VOCP(nnvo, nvo); }
        if constexpr (ALIGN_EPI) { if (wr == 0) PG8_BAR; }
        bool keep = false;
        if constexpr (Epi::PAIRED) { if (cur.part == 0) { E.mid(acc, cur, wr, wc, fr, fq); keep = true; } }
        if (!keep) E(acc, cur, wr, wc, fr, fq);
        if (!has_next) break;
        if (!keep) {
#pragma unroll
        for (int a = 0; a < 2; ++a)
#pragma unroll
            for (int b = 0; b < 2; ++b)
#pragma unroll
                for (int m = 0; m < 4; ++m)
#pragma unroll
                    for (int n = 0; n < 2; ++n) acc[a][b][m][n] = (f32x4){0.f, 0.f, 0.f, 0.f};
        }
        cur = nxt; cA = nA; cB = nB; ++ui;
        if constexpr (GATHER) { PG8_VOCP(cvo, nvo); PG8_VOCP(nvo, nnvo); nxt = nn; has_next = has_nn; }
        if constexpr (ALIGN_EPI) { if (wr == 1) PG8_BAR; }
    }
    PG8_WAIT_V(0);
    if constexpr (!ALIGN_EPI) { if (wr == 0) PG8_BAR; }
    PG8_BAR;
#undef PG8_SA
#undef PG8_SB
#undef PG8_STAGE
#undef PG8_LDA
#undef PG8_STAGE_A
#undef PG8_VO
#undef PG8_VOCP
#undef PG8_LDB
#undef PG8_MMA
#undef PG8_WAIT_V
#undef PG8_WAIT_L
#undef PG8_BAR
#undef PG8_SCHED
}

template <int ACT  > struct EpiBf16 {
    static constexpr bool PERM = true, PAIRED = false;
    bf16_t* O; int ldc; const float* bias;
    __device__ __forceinline__ void operator()(const f32x4 (&acc)[2][2][4][2], const Unit& u, int wr, int wc, int fr, int fq) const {
        const int row0 = u.pm * BM + wr * 64 + fr; const int col0 = u.pn * BM + wc * 32 + 8 * fq;
        f32x4 bv[2][2];
#pragma unroll
        for (int bj = 0; bj < 2; ++bj)
#pragma unroll
            for (int n = 0; n < 2; ++n) bv[bj][n] = bias ? *(const f32x4*)(bias + col0 + bj * HALF + 4 * n) : (f32x4){0.f, 0.f, 0.f, 0.f};
#pragma unroll
        for (int ai = 0; ai < 2; ++ai)
#pragma unroll
            for (int m = 0; m < 4; ++m) { bf16_t* rowp = O + (size_t)(row0 + ai * HALF + m * 16) * ldc + col0;
#pragma unroll
                for (int bj = 0; bj < 2; ++bj) { f32x4 v0 = acc[ai][bj][m][0] + bv[bj][0], v1 = acc[ai][bj][m][1] + bv[bj][1];
                    if (ACT == 1) {
#pragma unroll
                        for (int j = 0; j < 4; ++j) { v0[j] = __builtin_amdgcn_rcpf(1.f + __expf(-v0[j])); v1[j] = __builtin_amdgcn_rcpf(1.f + __expf(-v1[j])); } }
                    u32x4 w; w.x = cvt_pk_bf16(v0[0], v0[1]); w.y = cvt_pk_bf16(v0[2], v0[3]); w.z = cvt_pk_bf16(v1[0], v1[1]); w.w = cvt_pk_bf16(v1[2], v1[3]);
                    *(u32x4*)(rowp + bj * HALF) = w; } }
    }
};
template <int MODE> struct EpiUp {
    static constexpr bool PERM = true, PAIRED = false;
    const bf16_t* PMg; bf16_t* TMP; bf16_t* MIX;
    __device__ __forceinline__ void operator()(const f32x4 (&acc)[2][2][4][2], const Unit& u, int wr, int wc, int fr, int fq) const {
        const int row0 = u.pm * BM + wr * 64 + fr; const int col0 = u.pn * BM + wc * 32 + 8 * fq;
#pragma unroll
        for (int ai = 0; ai < 2; ++ai)
#pragma unroll
            for (int m = 0; m < 4; ++m) { const size_t row = (size_t)(row0 + ai * HALF + m * 16);
#pragma unroll
                for (int bj = 0; bj < 2; ++bj) { const int col = col0 + bj * HALF;
                    const u32x4 gw = *(const u32x4*)(PMg + row * NMRG + (MODE ? 1024 : 0) + col);
                    float gt[8] = {bflo(gw.x), bfhi(gw.x), bflo(gw.y), bfhi(gw.y), bflo(gw.z), bfhi(gw.z), bflo(gw.w), bfhi(gw.w)};
                    float v[8];
#pragma unroll
                    for (int j = 0; j < 4; ++j) { v[j] = acc[ai][bj][m][0][j] * gt[j]; v[4 + j] = acc[ai][bj][m][1][j] * gt[4 + j]; }
                    if (MODE == 1) { const u32x4 tw = *(const u32x4*)(TMP + row * D + col);
                        v[0] += bflo(tw.x); v[1] += bfhi(tw.x); v[2] += bflo(tw.y); v[3] += bfhi(tw.y); v[4] += bflo(tw.z); v[5] += bfhi(tw.z); v[6] += bflo(tw.w); v[7] += bfhi(tw.w); }
                    u32x4 w; w.x = cvt_pk_bf16(v[0], v[1]); w.y = cvt_pk_bf16(v[2], v[3]); w.z = cvt_pk_bf16(v[4], v[5]); w.w = cvt_pk_bf16(v[6], v[7]);
                    *(u32x4*)((MODE ? MIX : TMP) + row * D + col) = w; } }
    }
};
struct EpiUpPair {
    static constexpr bool PERM = true, PAIRED = true;
    const bf16_t* PMg; bf16_t* MIX;
    __device__ __forceinline__ void mid(f32x4 (&acc)[2][2][4][2], const Unit& u, int wr, int wc, int fr, int fq) const {
        const int row0 = u.pm * BM + wr * 64 + fr; const int col0 = u.pn * BM + wc * 32 + 8 * fq;
#pragma unroll
        for (int ai = 0; ai < 2; ++ai)
#pragma unroll
            for (int m = 0; m < 4; ++m) { const size_t row = (size_t)(row0 + ai * HALF + m * 16);
#pragma unroll
                for (int bj = 0; bj < 2; ++bj) { const int col = col0 + bj * HALF;
                    const u32x4 ga = *(const u32x4*)(PMg + row * NMRG + col), gb = *(const u32x4*)(PMg + row * NMRG + 1024 + col);
                    const float na[8] = {bflo(ga.x), bfhi(ga.x), bflo(ga.y), bfhi(ga.y), bflo(ga.z), bfhi(ga.z), bflo(ga.w), bfhi(ga.w)};
                    const float nb[8] = {bflo(gb.x), bfhi(gb.x), bflo(gb.y), bfhi(gb.y), bflo(gb.z), bfhi(gb.z), bflo(gb.w), bfhi(gb.w)};
#pragma unroll
                    for (int j = 0; j < 4; ++j) { acc[ai][bj][m][0][j] *= na[j] * __builtin_amdgcn_rcpf(nb[j]); acc[ai][bj][m][1][j] *= na[4 + j] * __builtin_amdgcn_rcpf(nb[4 + j]); } } }
    }
    __device__ __forceinline__ void operator()(const f32x4 (&acc)[2][2][4][2], const Unit& u, int wr, int wc, int fr, int fq) const {
        const int row0 = (u.pm - 64) * BM + wr * 64 + fr; const int col0 = u.pn * BM + wc * 32 + 8 * fq;
#pragma unroll
        for (int ai = 0; ai < 2; ++ai)
#pragma unroll
            for (int m = 0; m < 4; ++m) { const size_t row = (size_t)(row0 + ai * HALF + m * 16);
#pragma unroll
                for (int bj = 0; bj < 2; ++bj) { const int col = col0 + bj * HALF;
                    const u32x4 gb = *(const u32x4*)(PMg + row * NMRG + 1024 + col);
                    const float nb[8] = {bflo(gb.x), bfhi(gb.x), bflo(gb.y), bfhi(gb.y), bflo(gb.z), bfhi(gb.z), bflo(gb.w), bfhi(gb.w)};
                    u32x4 w; w.x = cvt_pk_bf16(acc[ai][bj][m][0][0] * nb[0], acc[ai][bj][m][0][1] * nb[1]); w.y = cvt_pk_bf16(acc[ai][bj][m][0][2] * nb[2], acc[ai][bj][m][0][3] * nb[3]);
                    w.z = cvt_pk_bf16(acc[ai][bj][m][1][0] * nb[4], acc[ai][bj][m][1][1] * nb[5]); w.w = cvt_pk_bf16(acc[ai][bj][m][1][2] * nb[6], acc[ai][bj][m][1][3] * nb[7]);
                    *(u32x4*)(MIX + row * D + col) = w; } }
    }
};
struct EpiOut {
    static constexpr bool PERM = true, PAIRED = false;
    const float* Xin; bf16_t* Xout; const float* gate;
    __device__ __forceinline__ void operator()(const f32x4 (&acc)[2][2][4][2], const Unit& u, int wr, int wc, int fr, int fq) const {
        const int row0 = u.pm * BM + wr * 64 + fr, col0 = u.pn * BM + wc * 32 + 8 * fq;
        const float* gp = gate + (size_t)((u.pm * BM) / T) * 6144;
        f32x4 gv[2][2];
#pragma unroll
        for (int bj = 0; bj < 2; ++bj)
#pragma unroll
            for (int n = 0; n < 2; ++n) gv[bj][n] = *(const f32x4*)(gp + col0 + bj * HALF + n * 4);
#pragma unroll
        for (int ai = 0; ai < 2; ++ai)
#pragma unroll
            for (int m = 0; m < 4; ++m) { const size_t ro = (size_t)(row0 + ai * HALF + m * 16) * D + col0;
#pragma unroll
                for (int bj = 0; bj < 2; ++bj) {
                    const f32x4 r0 = *(const f32x4*)(Xin + ro + bj * HALF) + gv[bj][0] * acc[ai][bj][m][0], r1 = *(const f32x4*)(Xin + ro + bj * HALF + 4) + gv[bj][1] * acc[ai][bj][m][1];
                    u32x4 w; w.x = cvt_pk_bf16(r0[0], r0[1]); w.y = cvt_pk_bf16(r0[2], r0[3]); w.z = cvt_pk_bf16(r1[0], r1[1]); w.w = cvt_pk_bf16(r1[2], r1[3]);
                    *(u32x4*)(Xout + ro + bj * HALF) = w; } }
    }
};
struct EpiGateUp {
    static constexpr bool PERM = true, PAIRED = false;
    bf16_t* ACT;
    __device__ __forceinline__ void operator()(const f32x4 (&acc)[2][2][4][2], const Unit& u, int wr, int wc, int fr, int fq) const {
        const int row0 = u.pm * BM + wr * 64 + fr; const int col0 = u.pn * HALF + wc * 32 + 8 * fq;
#pragma unroll
        for (int ai = 0; ai < 2; ++ai)
#pragma unroll
            for (int m = 0; m < 4; ++m) { bf16_t* rowp = ACT + (size_t)(row0 + ai * HALF + m * 16) * DE + col0;
                float v[8];
#pragma unroll
                for (int n = 0; n < 2; ++n)
#pragma unroll
                    for (int j = 0; j < 4; ++j) { const float gq = acc[ai][0][m][n][j], uq = acc[ai][1][m][n][j]; v[4 * n + j] = gq * __builtin_amdgcn_rcpf(1.f + __expf(-gq)) * uq; }
                u32x4 w; w.x = cvt_pk_bf16(v[0], v[1]); w.y = cvt_pk_bf16(v[2], v[3]); w.z = cvt_pk_bf16(v[4], v[5]); w.w = cvt_pk_bf16(v[6], v[7]);
                *(u32x4*)rowp = w; }
    }
};
}

constexpr int NTHR = 512, NWAVE = 8;
constexpr int LDS_BYTES = 147456;
constexpr int LDS_MISC = 143360;
struct Params { const float* in[30]; float* out; unsigned char* ws; int ph_lo, ph_hi, li, pad; };
enum { I_X = 0, I_C, I_WADA, I_BADA, I_NORMG, I_WIN, I_BIN, I_MU, I_W0, I_W2, I_A0, I_A2, I_G2, I_KK, I_KA, I_RK, I_GNG, I_GNB, I_QKG, I_CPOS, I_CW1, I_CW2, I_UPA, I_UPB, I_WOUT, I_RTW, I_RTB, I_EG, I_EU, I_ED };

#define CAS __attribute__((address_space(4)))
#define GAS __attribute__((address_space(1)))
template <class T> __device__ __forceinline__ T* as_global(T* p) { return (T*)(GAS T*)p; }
struct Frame {
    const CAS Params* p; LAS unsigned char* lds; unsigned char* ws; int tid, lane, wave, G, bid;
    __device__ __forceinline__ const float* in(int i) const { return as_global(p->in[i]); }
    __device__ __forceinline__ float* outp() const { return as_global(p->out); }
    __device__ __forceinline__ float* modp(int l, int b) const { return (float*)(ws + WS_SMALL + SM_MOD) + ((size_t)l * 2 + b) * 6144; }
    __device__ __forceinline__ bf16* lw(int l, size_t off) const { return (bf16*)(ws + WS_W + (size_t)l * LW_BYTES + off); }
};

__device__ __forceinline__ Frame relaunder(const Frame& F0) {
    Frame F = F0; int t_ = F0.tid; GAS unsigned char* w_ = (GAS unsigned char*)F0.ws; asm volatile("" : "+v"(t_), "+s"(w_)); F.tid = t_; F.lane = t_ & 63; F.wave = __builtin_amdgcn_readfirstlane(t_ >> 6); F.ws = (unsigned char*)w_; return F;
}
template <class RowMap>
__device__ __forceinline__ void xpose_job(const Frame& F, const float* src, int ld, int K, int c0, int nvalid, int npad, bf16* dst, RowMap rm, int& rot) {
    const int kparts = (K >= 512) ? 4 : 1, kspan = K / kparts, kw = kspan >> 3;
    const int nunit = (npad >> 6) * kparts;
    int start = (F.bid + F.G - (rot % F.G)) % F.G;
    for (int t = start; t < nunit; t += F.G) {
        const int kp = t % kparts, n_i = t / kparts;
        const int n = n_i * 64 + F.lane; const bool valid = n < nvalid;
        const float* sp = src + (size_t)(kp * kspan + F.wave * kw) * ld + c0 + n;
        bf16* dp = dst + (size_t)(rm(n_i) + F.lane) * K + kp * kspan + F.wave * kw;
#pragma unroll 2
        for (int k = 0; k < kw; k += 8) {
            float v[8];
#pragma unroll
            for (int j = 0; j < 8; ++j) v[j] = valid ? sp[(size_t)(k + j) * ld] : 0.f;
            u32x4 w; w.x = pk2(v[0], v[1]); w.y = pk2(v[2], v[3]); w.z = pk2(v[4], v[5]); w.w = pk2(v[6], v[7]);
            *(u32x4*)(dp + k) = w;
        }
    }
    rot += nunit;
}
struct RmId { __device__ int operator()(int n_i) const { return n_i * 64; } };
struct RmGate { int up; __device__ int operator()(int n_i) const { return 256 * (n_i >> 1) + 64 * (n_i & 1) + (up ? 128 : 0); } };

__device__ __forceinline__ double sin_poly(double x) {
    const double x2 = x * x; double term = x, sum = x;
#pragma unroll
    for (int k = 1; k <= 14; ++k) { term *= -x2 / (double)((2 * k) * (2 * k + 1)); sum += term; }
    return sum;
}
__device__ __forceinline__ double cos_poly(double x) {
    const double x2 = x * x; double term = 1.0, sum = 1.0;
#pragma unroll
    for (int k = 1; k <= 14; ++k) { term *= -x2 / (double)((2 * k - 1) * (2 * k)); sum += term; }
    return sum;
}

__device__ __forceinline__ void phase_prologue(const Frame& F) {
    const int tid = F.tid, G = F.G, bid = F.bid;
    {
        const double invf[8] = {1.0, 0.19392274474868576, 0.03760603093086393, 0.007292664737217109, 0.001414213562373095, 0.0002742481756762073, 5.318295896944988e-05, 1.031338537721246e-05};
        float* rope = (float*)(F.ws + WS_SMALL + SM_ROPE);
        for (int idx = bid * NTHR + tid; idx < T * 8; idx += G * NTHR) {
            const int t = idx >> 3, i = idx & 7;
            double fr = 1.0;
#pragma unroll
            for (int q = 0; q < 8; ++q) fr = (i == q) ? invf[q] : fr;
            double a = (double)t * fr; double r = a * 0.15915494309189535; r -= __builtin_floor(r + 0.5);
            const double x = r * 6.283185307179586;
            rope[t * 16 + i] = (float)cos_poly(x); rope[t * 16 + 8 + i] = (float)sin_poly(x);
        }
    }
    {
        LAS float* sc = (LAS float*)F.lds;
        LAS float* red = sc + 2048;
        for (int i = tid; i < 2048; i += NTHR) { const float cv = F.in(I_C)[i]; sc[i] = cv / (1.f + __expf(-cv)); }
        __syncthreads();
        for (int u = bid; u < 192; u += G) {
            const int l = u / 96, c0 = (u % 96) * 64, col = c0 + F.lane;
            const float* wp = F.in(I_WADA) + (size_t)l * D * 6144 + col;
            float a0 = 0.f, a1 = 0.f;
            const int kb = F.wave * 128;
#pragma unroll 8
            for (int k = 0; k < 128; ++k) { const float wv = wp[(size_t)(kb + k) * 6144]; a0 += sc[kb + k] * wv; a1 += sc[1024 + kb + k] * wv; }
            red[(F.wave * 2 + 0) * 64 + F.lane] = a0; red[(F.wave * 2 + 1) * 64 + F.lane] = a1;
            __syncthreads();
            if (tid < 128) { const int b = tid >> 6, ln = tid & 63; float s = 0.f;
#pragma unroll
                for (int w = 0; w < 8; ++w) s += red[(w * 2 + b) * 64 + ln];
                F.modp(l, b)[c0 + ln] = s + F.in(I_BADA)[l * 6144 + c0 + ln]; }
            __syncthreads();
        }
    }
    {
        LAS float* red = (LAS float*)F.lds;
        for (int u = bid; u < 16; u += G) {
            const int li = u >> 2, q = u & 3, c = tid & 255, hf = tid >> 8;
            const float* pos = F.in(I_CPOS) + (size_t)li * 2048 + q * 512 + hf * 256;
            const float* w1 = F.in(I_CW1) + (size_t)li * 2048 * 256 + (size_t)(q * 512 + hf * 256) * 256 + c;
            float a = 0.f;
#pragma unroll 8
            for (int j = 0; j < 256; ++j) a += pos[j] * w1[(size_t)j * 256];
            red[tid] = a; __syncthreads();
            if (tid < 256) ((float*)(F.ws + WS_SMALL + SM_CMPB))[(li * 4 + q) * 256 + tid] = red[tid] + red[tid + 256];
            __syncthreads();
        }
    }
}
__device__ __forceinline__ void phase_convert_weights(const Frame& F) {
    int rot = 0;
#pragma unroll 1
    for (int jj = 0; jj < DEPTH * 13; ++jj) {
        const int l = jj / 13, j = jj - l * 13;
        const float* src; int ld, K, c0 = 0, nvalid, npad; bf16* dst;
        if (j == 0)      { src = F.in(I_WIN) + (size_t)l * D * INC; ld = INC; K = D; nvalid = N1P; npad = N1P; dst = F.lw(l, LW_WIN1); }
        else if (j == 1) { src = F.in(I_WIN) + (size_t)l * D * INC; ld = INC; K = D; c0 = N1; nvalid = NMRG; npad = NMRG; dst = F.lw(l, LW_WM); }
        else if (j == 2) { src = F.in(I_UPA) + (size_t)l * RW * D; ld = D; K = RW; nvalid = D; npad = D; dst = F.lw(l, LW_UPA); }
        else if (j == 3) { src = F.in(I_UPB) + (size_t)l * RW * D; ld = D; K = RW; nvalid = D; npad = D; dst = F.lw(l, LW_UPB); }
        else if (j == 4) { src = F.in(I_WOUT) + (size_t)l * D * D; ld = D; K = D; nvalid = D; npad = D; dst = F.lw(l, LW_OUT); }
        else if (j <= 6) { const int i = j - 5; src = F.in(I_CW1) + (size_t)(l * 2 + i) * 2048 * 256; ld = 256; K = 2048; nvalid = 256; npad = 256; dst = F.lw(l, LW_C1) + (size_t)i * 256 * 2048; }
        else if (j <= 8) { const int i = j - 7; src = F.in(I_CW2) + (size_t)(l * 2 + i) * 256 * 64; ld = 64; K = 256; nvalid = 64; npad = 64; dst = F.lw(l, LW_C2) + (size_t)i * 64 * 256; }
        else if (j == 9) { src = F.in(I_W2) + (size_t)l * 64 * RW; ld = RW; K = 64; nvalid = RW; npad = RW; dst = F.lw(l, LW_L2); }
        else if (j == 10) { src = F.in(I_A2) + (size_t)l * 64 * RW; ld = RW; K = 64; nvalid = RW; npad = RW; dst = F.lw(l, LW_A2); }
        else if (j == 11) { src = F.in(I_G2) + (size_t)l * 128 * RW; ld = RW; K = 128; nvalid = RW; npad = RW; dst = F.lw(l, LW_G2); }
        else { src = F.in(I_WIN) + (size_t)l * D * INC; ld = INC; K = D; c0 = N1P; nvalid = 24; npad = 64; dst = F.lw(l, LW_WG); }
        xpose_job(F, src, ld, K, c0, nvalid, npad, dst, RmId{}, rot);
    }
}
__device__ __forceinline__ void convert_experts(const Frame& F, int l) {
    int rot = 0;
    for (int e = 0; e < NE; ++e) {
        bf16* wgu = (bf16*)(F.ws + WS_WGU) + (size_t)e * 1024 * 1024;
        xpose_job(F, F.in(I_EG) + ((size_t)l * NE + e) * D * DE, DE, D, 0, DE, DE, wgu, RmGate{0}, rot);
        xpose_job(F, F.in(I_EU) + ((size_t)l * NE + e) * D * DE, DE, D, 0, DE, DE, wgu, RmGate{1}, rot);
        xpose_job(F, F.in(I_ED) + ((size_t)l * NE + e) * DE * D, D, DE, 0, D, D, (bf16*)(F.ws + WS_WD) + (size_t)e * 1024 * 512, RmId{}, rot);
    }
}

constexpr int LDS_MOETB = LDS_MISC + 1024;
__device__ __forceinline__ LAS int* moe_tables(const Frame& F, int l) {
    LAS int* tb = (LAS int*)(F.lds + LDS_MOETB);
    if (F.tid < NE) tb[17 + F.tid] = (int)__hip_atomic_load((const unsigned*)(F.ws + WS_CTL) + CW_CNT + 64 * l + F.tid, __ATOMIC_RELAXED, __HIP_MEMORY_SCOPE_AGENT);
    __syncthreads();
    if (F.tid == 0) { int nb = 0;
        for (int e = 0; e < NE; ++e) { tb[1 + e] = nb; nb += (tb[17 + e] + 255) >> 8; }
        tb[0] = nb; }
    __syncthreads();
    if (F.tid < tb[0]) { int e = 0;
#pragma unroll
        for (int q = 1; q < NE; ++q) e += (tb[1 + q] <= F.tid) ? 1 : 0;
        tb[64 + F.tid] = e; }
    __syncthreads();
    return tb;
}

template <bool COMBINE, bool NORM, bool FROM_OUT = false>
__device__ __forceinline__ void phase_norm(const Frame& F, int l, int lc) {
    const float* xin = (COMBINE || FROM_OUT) ? F.outp() : F.in(I_X);
    bf16* H = (bf16*)(F.ws + WS_H);
    const int* texp = (const int*)(F.ws + WS_TOK); const int* tpos = (const int*)(F.ws + WS_TOK + 131072); const float* tw = (const float*)(F.ws + WS_TOK + 2 * 131072);
    const LAS int* tb = COMBINE ? moe_tables(F, lc) : nullptr;
    const bf16* yb = (const bf16*)(F.ws + WS_YBS);
    constexpr int RB = COMBINE ? 2 : 4;
    const int rstride = F.G * NWAVE;
    for (int nb = F.bid * NWAVE + F.wave; nb < NTOK; nb += rstride * RB) {
        f32x4 xv[RB][4]; u32x2 y0[RB][4], y1[RB][4]; float w0[RB], w1[RB];
#pragma unroll
        for (int r = 0; r < RB; ++r) { const int n = (nb + r * rstride < NTOK) ? nb + r * rstride : nb;
#pragma unroll
            for (int j = 0; j < 4; ++j) {
                if (COMBINE) { const u32x2 xr = *(const u32x2*)((const bf16*)(F.ws + WS_XR) + (size_t)n * D + 4 * F.lane + 256 * j); xv[r][j] = (f32x4){bflo(xr.x), bfhi(xr.x), bflo(xr.y), bfhi(xr.y)}; }
                else xv[r][j] = *(const f32x4*)(xin + (size_t)n * D + 4 * F.lane + 256 * j); }
            if (COMBINE) { const int s0 = tb[1 + texp[n * 2]] * 256 + tpos[n * 2], s1 = tb[1 + texp[n * 2 + 1]] * 256 + tpos[n * 2 + 1]; w0[r] = tw[n * 2]; w1[r] = tw[n * 2 + 1];
#pragma unroll
                for (int j = 0; j < 4; ++j) { const int c = 4 * F.lane + 256 * j; y0[r][j] = *(const u32x2*)(yb + (size_t)s0 * D + c); y1[r][j] = *(const u32x2*)(yb + (size_t)s1 * D + c); } }
        }
#pragma unroll
        for (int r = 0; r < RB; ++r) { const int n = (nb + r * rstride < NTOK) ? nb + r * rstride : nb; const int b = n / T;
            if (COMBINE) {
                const float* gf = F.modp(lc, b) + 5120;
#pragma unroll
                for (int j = 0; j < 4; ++j) {
                    const int c = 4 * F.lane + 256 * j;
                    const f32x4 gv = *(const f32x4*)(gf + c);
                    xv[r][j][0] += gv[0] * (w0[r] * bflo(y0[r][j].x) + w1[r] * bflo(y1[r][j].x)); xv[r][j][1] += gv[1] * (w0[r] * bfhi(y0[r][j].x) + w1[r] * bfhi(y1[r][j].x));
                    xv[r][j][2] += gv[2] * (w0[r] * bflo(y0[r][j].y) + w1[r] * bflo(y1[r][j].y)); xv[r][j][3] += gv[3] * (w0[r] * bfhi(y0[r][j].y) + w1[r] * bfhi(y1[r][j].y));
                    *(f32x4*)(F.outp() + (size_t)n * D + c) = xv[r][j];
                }
            }
            if (NORM) {
                float ss = 0.f;
#pragma unroll
                for (int j = 0; j < 4; ++j) ss += xv[r][j][0] * xv[r][j][0] + xv[r][j][1] * xv[r][j][1] + xv[r][j][2] * xv[r][j][2] + xv[r][j][3] * xv[r][j][3];
                ss = sum64(ss);
                const float inv = __builtin_amdgcn_rsqf(ss * (1.f / D) + 1e-6f);
                const float* ng = F.in(I_NORMG) + (size_t)(l * 2 + 0) * D; const float* sh = F.modp(l, b); const float* scp = sh + 1024;
#pragma unroll
                for (int j = 0; j < 4; ++j) {
                    const int c = 4 * F.lane + 256 * j;
                    const f32x4 g = *(const f32x4*)(ng + c), s1 = *(const f32x4*)(scp + c), s0 = *(const f32x4*)(sh + c);
                    float o[4];
#pragma unroll
                    for (int q = 0; q < 4; ++q) o[q] = xv[r][j][q] * inv * g[q] * (1.f + s1[q]) + s0[q];
                    u32x2 w; w.x = pk2(o[0], o[1]); w.y = pk2(o[2], o[3]);
                    *(u32x2*)(H + (size_t)n * D + c) = w;
                }
            }
        }
    }
}

__device__ __forceinline__ f32x16 mfma32(bf16x8 a, bf16x8 b, f32x16 c) { return __builtin_amdgcn_mfma_f32_32x32x16_bf16(a, b, c, 0, 0, 0); }
__device__ __forceinline__ f32x16 zero16() { f32x16 z;
#pragma unroll
    for (int q = 0; q < 16; ++q) z[q] = 0.f; return z; }

__device__ __forceinline__ void st_bf(bf16* p, float v) { *p = (bf16)f2bf(v); }
__device__ __forceinline__ float quad_sum(float v) {
    v += __builtin_bit_cast(float, __builtin_amdgcn_update_dpp(0, __builtin_bit_cast(int, v), 0xB1, 0xF, 0xF, true));
    v += __builtin_bit_cast(float, __builtin_amdgcn_update_dpp(0, __builtin_bit_cast(int, v), 0x4E, 0xF, 0xF, true));
    return v;
}
constexpr int PR_STRIDE = 3600, LA_OFF = 33 * PR_STRIDE, LA_STRIDE = 528;
__device__ __forceinline__ void phase_prep(const Frame& F, int l) {
    const int tid = F.tid, lane = F.lane, wave = F.wave, l31 = lane & 31, hi = lane >> 5;
    const bf16* p1 = (const bf16*)(F.ws + WS_P1);
    bf16* rwR = (bf16*)(F.ws + WS_RW); bf16* rwK = rwR + (size_t)NTOK * RW; bf16* rwV = rwK + (size_t)NTOK * RW; bf16* rwKK = rwV + (size_t)NTOK * RW;
    bf16* rwB = rwKK + (size_t)NTOK * RW; bf16* rwG = rwB + (size_t)NTOK * RW; float* rwD = (float*)(F.ws + WS_RW + 96 * MiB);
    const float* mu = F.in(I_MU) + (size_t)l * RCOLS;
    const bf16* w2t = F.lw(l, LW_L2); const bf16* a2t = F.lw(l, LW_A2); const bf16* g2t = F.lw(l, LW_G2);
    const float* rope = (const float*)(F.ws + WS_SMALL + SM_ROPE);
    const float* qkg = F.in(I_QKG) + (size_t)l * 4 * 64;
    bf16* nsQ = (bf16*)(F.ws + NS_Q); bf16* nsKS = (bf16*)(F.ws + NS_KS); bf16* nsKW = (bf16*)(F.ws + NS_KW); bf16* nsVST = (bf16*)(F.ws + NS_VST); bf16* nsVWT = (bf16*)(F.ws + NS_VWT);
    bf16* nsKC = (bf16*)(F.ws + NS_KC); bf16* nsVC = (bf16*)(F.ws + NS_VC); float* nsG = (float*)(F.ws + NS_GATE);
    LAS unsigned char* lds = F.lds;
    for (int u = F.bid; u < NTOK / 32; u += F.G) {
        const int n0 = u * 32, t0 = n0 % T, bb = n0 / T;
        {
            const Frame Fg = relaunder(F); const int tid = Fg.tid, lane = Fg.lane, wave = Fg.wave, l31 = lane & 31, hi = lane >> 5;
            const bf16* Hh = (const bf16*)(Fg.ws + WS_H) + (size_t)(n0 + l31) * D + 128 * wave + hi * 8; const bf16* Wg = Fg.lw(l, LW_WG) + (size_t)l31 * D + 128 * wave + hi * 8;
            float* nsG = (float*)(Fg.ws + NS_GATE);
            f32x16 d = zero16();
#pragma unroll
            for (int ks = 0; ks < 8; ++ks) d = mfma32(*(const bf16x8*)(Hh + ks * 16), *(const bf16x8*)(Wg + ks * 16), d);
            LAS float* part = (LAS float*)lds + wave * 1024;
#pragma unroll
            for (int q = 0; q < 16; ++q) part[(8 * (q >> 2) + 4 * hi + (q & 3)) * 32 + l31] = d[q];
            __syncthreads();
            for (int i = tid; i < 32 * 24; i += NTHR) { const int tl = i / 24, j = i - tl * 24; float a = F.in(I_BIN)[(size_t)l * INC + N1P + j];
#pragma unroll
                for (int w = 0; w < 8; ++w) a += ((const LAS float*)lds)[w * 1024 + tl * 32 + j];
                nsG[(size_t)(n0 + tl) * 24 + j] = sigmoidf_(a); }
            __syncthreads();
        }
        {
            const Frame Fs = relaunder(F); const int tid = Fs.tid; const bf16* p1 = (const bf16*)(Fs.ws + WS_P1);
            u32x4 sv[15];
#pragma unroll
            for (int it = 0; it < 15; ++it) { const int idx = tid + it * NTHR; const int row = idx / 224, ch = idx - row * 224;
                sv[it] = (u32x4){0u, 0u, 0u, 0u};
                if (idx < 33 * 224 && !(row == 0 && t0 == 0)) sv[it] = *(const u32x4*)(p1 + (size_t)(n0 - 1 + row) * N1P + ch * 8); }
#pragma unroll
            for (int it = 0; it < 15; ++it) { const int idx = tid + it * NTHR; const int row = idx / 224, ch = idx - row * 224;
                if (idx < 33 * 224) *(LAS u32x4*)(lds + row * PR_STRIDE + ch * 16) = sv[it]; }
        }
        __syncthreads();
        {
            const int i = lane >> 1, cs = 32 * wave + 16 * (lane & 1);
            const LAS u32x4* cur = (const LAS u32x4*)(lds + (i + 1) * PR_STRIDE + (1536 + cs) * 2); const LAS u32x4* prv = (const LAS u32x4*)(lds + i * PR_STRIDE + (1536 + cs) * 2);
            const u32x4 c0 = cur[0], c1 = cur[1], q0 = prv[0], q1 = prv[1];
            const unsigned cw[8] = {c0.x, c0.y, c0.z, c0.w, c1.x, c1.y, c1.z, c1.w}, pw[8] = {q0.x, q0.y, q0.z, q0.w, q1.x, q1.y, q1.z, q1.w};
            const float* mup = mu + 1536 + cs;
            unsigned ow[8];
#pragma unroll
            for (int jj = 0; jj < 8; ++jj) {
                const f32x2 m2 = *(const f32x2*)(mup + 2 * jj);
                const float ca = bflo(cw[jj]), cb = bfhi(cw[jj]), pa = bflo(pw[jj]), pb = bfhi(pw[jj]);
                const float sa = ca + (pa - ca) * m2[0], sb = cb + (pb - cb) * m2[1];
                float fa, fb;
                if (wave < 2) { fa = 1.f - 2.f * rcpf_(__expf(2.f * sa) + 1.f); fb = 1.f - 2.f * rcpf_(__expf(2.f * sb) + 1.f); }
                else if (wave < 4) { fa = sa; fb = sb; }
                else { fa = sigmoidf_(sa); fb = sigmoidf_(sb); }
                ow[jj] = pk2(fa, fb);
            }
            LAS u32x4* la = (LAS u32x4*)(lds + LA_OFF + i * LA_STRIDE + cs * 2);
            la[0] = (u32x4){ow[0], ow[1], ow[2], ow[3]}; la[1] = (u32x4){ow[4], ow[5], ow[6], ow[7]};
        }
        __syncthreads();
        {
            f32x16 accw[2], acca[2], accg[2];
            int colv = 64 * wave + l31; asm volatile("" : "+v"(colv));
#pragma unroll
            for (int ct = 0; ct < 2; ++ct) {
#pragma unroll
                for (int q = 0; q < 16; ++q) { accw[ct][q] = 0.f; acca[ct][q] = 0.f; accg[ct][q] = 0.f; }
                const int col = colv + 32 * ct;
                const LAS unsigned char* lap = lds + LA_OFF + l31 * LA_STRIDE + hi * 16;
#pragma unroll
                for (int ks = 0; ks < 4; ++ks) {
                    const bf16x8 a1 = *(const LAS bf16x8*)(lap + ks * 32), a2 = *(const LAS bf16x8*)(lap + 128 + ks * 32);
                    const bf16x8 b1 = *(const bf16x8*)(w2t + (size_t)col * 64 + ks * 16 + hi * 8), b2 = *(const bf16x8*)(a2t + (size_t)col * 64 + ks * 16 + hi * 8);
                    accw[ct] = mfma32(a1, b1, accw[ct]); acca[ct] = mfma32(a2, b2, acca[ct]);
                }
#pragma unroll
                for (int ks = 0; ks < 8; ++ks) {
                    const bf16x8 a3 = *(const LAS bf16x8*)(lap + 256 + ks * 32);
                    const bf16x8 b3 = *(const bf16x8*)(g2t + (size_t)col * 128 + ks * 16 + hi * 8);
                    accg[ct] = mfma32(a3, b3, accg[ct]);
                }
            }
            const int col0 = colv;
            float mur[2], muk[2], muv[2], w0[2], a0[2], kkc[2], kac[2];
#pragma unroll
            for (int ct = 0; ct < 2; ++ct) { const int col = col0 + 32 * ct;
                mur[ct] = mu[col]; muk[ct] = mu[512 + col]; muv[ct] = mu[1024 + col];
                w0[ct] = F.in(I_W0)[l * RW + col]; a0[ct] = F.in(I_A0)[l * RW + col]; kkc[ct] = F.in(I_KK)[l * RW + col]; kac[ct] = F.in(I_KA)[l * RW + col]; }
#pragma unroll
            for (int i = 0; i < 16; ++i) {
                const int ti = 8 * (i >> 2) + 4 * hi + (i & 3);
                const LAS bf16* cur = (const LAS bf16*)(lds + (ti + 1) * PR_STRIDE) + col0; const LAS bf16* prv = (const LAS bf16*)(lds + ti * PR_STRIDE) + col0;
                const size_t o = (size_t)(n0 + ti) * RW + col0;
                float kx[2], av[2];
#pragma unroll
                for (int ct = 0; ct < 2; ++ct) {
                    const float rc = bf2f(cur[32 * ct]), rp = bf2f(prv[32 * ct]), kc = bf2f(cur[512 + 32 * ct]), kp = bf2f(prv[512 + 32 * ct]), vc = bf2f(cur[1024 + 32 * ct]), vp = bf2f(prv[1024 + 32 * ct]);
                    const float rs = rc + (rp - rc) * mur[ct], ks_ = kc + (kp - kc) * muk[ct], vs = vc + (vp - vc) * muv[ct];
                    const float z = w0[ct] + accw[ct][i];
                    const float sp = (z < 0.f ? -z : 0.f) + 0.6931471805599453f * __builtin_amdgcn_logf(1.f + __expf(-__builtin_fabsf(z)));
                    const float wlog = -sp - 0.5f;
                    const float dec = -__expf(wlog);
                    const float a = sigmoidf_(a0[ct] + acca[ct][i]);
                    st_bf(rwR + o + 32 * ct, rs); st_bf(rwV + o + 32 * ct, vs); st_bf(rwG + o + 32 * ct, accg[ct][i]); rwD[o + 32 * ct] = dec; st_bf(rwK + o + 32 * ct, ks_ * (1.f + (a - 1.f) * kac[ct]));
                    kx[ct] = ks_ * kkc[ct]; av[ct] = a;
                }
                float ss = kx[0] * kx[0] + kx[1] * kx[1];
                ss = sum32(ss);
                const float inv = fminf(__builtin_amdgcn_rsqf(ss), 1e12f);
#pragma unroll
                for (int ct = 0; ct < 2; ++ct) { const float kk = kx[ct] * inv; st_bf(rwKK + o + 32 * ct, kk); st_bf(rwB + o + 32 * ct, kk * av[ct]); }
            }
        }
        __syncthreads();
        {
            const Frame Fs = relaunder(F); const int tid = Fs.tid, lane = Fs.lane, wave = Fs.wave; const bf16* p1 = (const bf16*)(Fs.ws + WS_P1);
            int u_ = u; asm volatile("" : "+s"(u_)); const int n0 = u_ * 32, t0 = n0 % T, bb = n0 / T;
            bf16* nsQ = (bf16*)(Fs.ws + NS_Q); bf16* nsKS = (bf16*)(Fs.ws + NS_KS); bf16* nsKW = (bf16*)(Fs.ws + NS_KW); bf16* nsVST = (bf16*)(Fs.ws + NS_VST); bf16* nsVWT = (bf16*)(Fs.ws + NS_VWT);
            bf16* nsKC = (bf16*)(Fs.ws + NS_KC); bf16* nsVC = (bf16*)(Fs.ws + NS_VC); const float* rope = (const float*)(Fs.ws + WS_SMALL + SM_ROPE);
            const int lq = lane & 15, sub = lane >> 4;
            LAS bf16* vts = (LAS bf16*)lds;
            const int tl = wave * 4 + sub, n = n0 + tl, t = t0 + tl;
#pragma unroll
            for (int sb = 0; sb < 20; sb += 5) {
            u32x2 raws[5];
#pragma unroll
            for (int s5 = 0; s5 < 5; ++s5) raws[s5] = *(const u32x2*)(p1 + (size_t)n * N1P + QOFF + 64 * (sb + s5) + 4 * lq);
#pragma unroll
            for (int s5 = 0; s5 < 5; ++s5) {
                const int v = sb + s5;
                const u32x2 raw = raws[s5];
                float x[4] = {bflo(raw.x), bfhi(raw.x), bflo(raw.y), bfhi(raw.y)};
                const int g = v & 1;
                const bool isq = v < 8, isks = (v == 12 || v == 13), iskw = (v == 16 || v == 17);
                if (isq || isks || iskw) {
                    float ss = x[0] * x[0] + x[1] * x[1] + x[2] * x[2] + x[3] * x[3];
                    ss = sum16(ss);
                    const float inv = __builtin_amdgcn_rsqf(ss * (1.f / 64.f) + 1e-6f);
                    const float* gw = qkg + (isq ? 0 : (isks ? 128 : 192)) + 4 * lq;
#pragma unroll
                    for (int j = 0; j < 4; ++j) x[j] = x[j] * inv * gw[j];
                    float px[4];
#pragma unroll
                    for (int j = 0; j < 4; ++j) px[j] = xor_lane<2>(x[j]);
                    if (lq < 4) {
                        const float* rp = rope + (size_t)t * 16 + 4 * (lq & 1);
#pragma unroll
                        for (int j = 0; j < 4; ++j) { const float c = rp[j], sn = rp[8 + j]; x[j] = (lq < 2) ? (x[j] * c - px[j] * sn) : (x[j] * c + px[j] * sn); }
                    }
                    if (isq) {
#pragma unroll
                        for (int j = 0; j < 4; ++j) x[j] *= 0.18033688011112042f;
                    }
                    u32x2 w; w.x = pk2(x[0], x[1]); w.y = pk2(x[2], x[3]);
                    if (isq) *(u32x2*)(nsQ + (size_t)n * 512 + 64 * v + 4 * lq) = w;
                    else if (isks) {
                        const size_t off = (size_t)(bb * 2 + g) * T * 64 + (size_t)(t >> 6) * 4096 + (size_t)(((((t >> 5) & 1) * 4 + (lq >> 2)) * 32 + (t & 31)) * 2 + ((lq >> 1) & 1)) * 8 + 4 * (lq & 1);
                        *(u32x2*)(nsKS + off) = w;
                    } else *(u32x2*)(nsKW + ((size_t)(bb * 2 + g) * T + t) * 64 + 4 * lq) = w;
                } else if (v < 12) {
                    *(u32x2*)((v < 10 ? nsKC : nsVC) + ((size_t)(bb * 2 + g) * T + t) * 64 + 4 * lq) = raw;
                } else {
                    const int slot = (v >= 18 ? 2 : 0) + g;
                    LAS bf16* dp = vts + (slot * 64 + 4 * lq) * 40 + tl;
                    dp[0] = (bf16)(raw.x & 0xffffu); dp[40] = (bf16)(raw.x >> 16); dp[80] = (bf16)(raw.y & 0xffffu); dp[120] = (bf16)(raw.y >> 16);
                }
            }
            }
            __syncthreads();
            {
                const int row = tid >> 1, hf = tid & 1, slot = row >> 6, d = row & 63, g = slot & 1;
                const LAS u32x4* sp = (const LAS u32x4*)(vts + row * 40 + hf * 16);
                const u32x4 a = sp[0], b = sp[1];
                if (slot >> 1) { bf16* dst = nsVWT + ((size_t)(bb * 2 + g) * 64 + d) * T + t0 + hf * 16; *(u32x4*)dst = a; *(u32x4*)(dst + 8) = b; }
                else {
                    const int sq = ((t0 >> 5) & 1) * 2 + hf;
                    bf16* dst = nsVST + (size_t)(bb * 2 + g) * 64 * T + (size_t)(t0 >> 6) * 4096 + (size_t)((((d >> 5) * 4 + sq) * 32 + (d & 31)) * 2) * 8;
                    *(u32x4*)dst = (u32x4){a.x, a.y, b.x, b.y}; *(u32x4*)(dst + 8) = (u32x4){a.z, a.w, b.z, b.w};
                }
            }
        }
        __syncthreads();
    }
}

__device__ __forceinline__ float gelu_tanh(float x) { const float u = 0.7978845608028654f * (x + 0.044715f * x * x * x); const float e = __expf(2.f * u); return 0.5f * x * (2.f - 2.f * __builtin_amdgcn_rcpf(e + 1.f)); }
__device__ __forceinline__ void phase_compress(const Frame& F, int l) {
    const int tid = F.tid, lane = F.lane, wave = F.wave, l31 = lane & 31, hi = lane >> 5;
    LAS unsigned char* lds = F.lds;
    LAS bf16* hid = (LAS bf16*)lds;
    LAS float* outl = (LAS float*)(lds + 32 * 528);
    const float* cbp = (const float*)(F.ws + WS_SMALL + SM_CMPB);
    const float* rope = (const float*)(F.ws + WS_SMALL + SM_ROPE);
    const float* qkg1 = F.in(I_QKG) + (size_t)l * 256 + 64;
    for (int u = F.bid; u < 128; u += F.G) {
        const int i = u >> 6, bg = (u >> 4) & 3, rt = u & 15;
        const bf16* src = (const bf16*)(F.ws + (i ? NS_VC : NS_KC)) + (size_t)bg * T * 64;
        const bf16* w1t = F.lw(l, LW_C1) + (size_t)i * 256 * 2048; const bf16* w2t = F.lw(l, LW_C2) + (size_t)i * 64 * 256;
        int nrow = rt * 32 + l31; if (nrow > NCMP - 1) nrow = NCMP - 1;
        const bf16* ap = src + (size_t)nrow * 1024 + hi * 8; const bf16* bp = w1t + (size_t)(32 * wave + l31) * 2048 + hi * 8;
        f32x16 acc;
#pragma unroll
        for (int q = 0; q < 16; ++q) acc[q] = 0.f;
#pragma unroll 8
        for (int ks = 0; ks < 128; ++ks) acc = mfma32(*(const bf16x8*)(ap + ks * 16), *(const bf16x8*)(bp + ks * 16), acc);
        {
            const int col = 32 * wave + l31; const int li = l * 2 + i;
            const float cb = cbp[(li * 4 + 0) * 256 + col] + cbp[(li * 4 + 1) * 256 + col] + cbp[(li * 4 + 2) * 256 + col] + cbp[(li * 4 + 3) * 256 + col];
#pragma unroll
            for (int q = 0; q < 16; ++q) { const int r = 8 * (q >> 2) + 4 * hi + (q & 3); hid[r * 264 + col] = (bf16)f2bf(gelu_tanh(acc[q] + cb)); }
        }
        __syncthreads();
        if (wave < 2) {
            f32x16 o;
#pragma unroll
            for (int q = 0; q < 16; ++q) o[q] = 0.f;
#pragma unroll
            for (int ks = 0; ks < 16; ++ks) o = mfma32(*(const LAS bf16x8*)(hid + l31 * 264 + ks * 16 + hi * 8), *(const bf16x8*)(w2t + (size_t)(32 * wave + l31) * 256 + ks * 16 + hi * 8), o);
#pragma unroll
            for (int q = 0; q < 16; ++q) { const int r = 8 * (q >> 2) + 4 * hi + (q & 3); outl[r * 65 + 32 * wave + l31] = o[q]; }
        }
        __syncthreads();
        if (i == 0) {
            const int r = tid >> 4, lq = tid & 15, n = rt * 32 + r;
            float x[4];
#pragma unroll
            for (int j = 0; j < 4; ++j) x[j] = outl[r * 65 + 4 * lq + j];
            float ss = x[0] * x[0] + x[1] * x[1] + x[2] * x[2] + x[3] * x[3];
            ss = sum16(ss);
            const float inv = __builtin_amdgcn_rsqf(ss * (1.f / 64.f) + 1e-6f);
#pragma unroll
            for (int j = 0; j < 4; ++j) x[j] = x[j] * inv * qkg1[4 * lq + j];
            float px[4];
#pragma unroll
            for (int j = 0; j < 4; ++j) px[j] = xor_lane<2>(x[j]);
            const int pos = (n < NCMP) ? 16 * n + 31 : 0;
            if (lq < 4) {
                const float* rp = rope + (size_t)pos * 16 + 4 * (lq & 1);
#pragma unroll
                for (int j = 0; j < 4; ++j) { const float c = rp[j], sn = rp[8 + j]; x[j] = (lq < 2) ? (x[j] * c - px[j] * sn) : (x[j] * c + px[j] * sn); }
            }
            if (n >= NCMP) { x[0] = x[1] = x[2] = x[3] = 0.f; }
            u32x2 w; w.x = pk2(x[0], x[1]); w.y = pk2(x[2], x[3]);
            *(u32x2*)((bf16*)(F.ws + NS_KCMP) + ((size_t)bg * NCMPP + n) * 64 + 4 * lq) = w;
        } else {
            const int d = tid >> 3, n4 = (tid & 7) * 4;
            float x[4];
#pragma unroll
            for (int j = 0; j < 4; ++j) { const int n = rt * 32 + n4 + j; x[j] = (n < NCMP) ? outl[(n4 + j) * 65 + d] : 0.f; }
            u32x2 w; w.x = pk2(x[0], x[1]); w.y = pk2(x[2], x[3]);
            *(u32x2*)((bf16*)(F.ws + NS_VCMPT) + ((size_t)bg * 64 + d) * NCMPP + rt * 32 + n4) = w;
        }
        __syncthreads();
    }
}

constexpr int T72 = 144;
__device__ __forceinline__ f32x16 mm64(const LAS unsigned char* A, const LAS unsigned char* Bt, int m0, int n0, int l31, int hi, f32x16 acc) {
#pragma unroll
    for (int ks = 0; ks < 4; ++ks) acc = mfma32(*(const LAS bf16x8*)(A + (m0 + l31) * T72 + ks * 32 + hi * 16), *(const LAS bf16x8*)(Bt + (n0 + l31) * T72 + ks * 32 + hi * 16), acc);
    return acc;
}
__device__ __forceinline__ void st_tile_T_bf(LAS unsigned char* dst, const f32x16& d, int m0, int n0, int l31, int hi) {
#pragma unroll
    for (int g = 0; g < 4; ++g) { u32x2 w; w.x = pk2(d[4 * g], d[4 * g + 1]); w.y = pk2(d[4 * g + 2], d[4 * g + 3]); *(LAS u32x2*)(dst + (n0 + l31) * T72 + (m0 + 8 * g + 4 * hi) * 2) = w; }
}
__device__ __forceinline__ void st_tile_T_f32(LAS unsigned char* dst, const f32x16& d, int m0, int n0, int l31, int hi) {
#pragma unroll
    for (int g = 0; g < 4; ++g) *(LAS f32x4*)(dst + (n0 + l31) * 272 + (m0 + 8 * g + 4 * hi) * 4) = (f32x4){d[4 * g], d[4 * g + 1], d[4 * g + 2], d[4 * g + 3]};
}

constexpr int R1_AN = 0, R1_BN = 9216, R1_KN = 18432, R1_BHT = 27648, R1_KHT = 36864, R1_VT = 46080, R1_ATF = 55296, R1_AAB = 72704, R1_AAK = 90112, R1_RHS2 = 99328, R1_TT = 116736, R1_AOFF = 120832;
__device__ __forceinline__ void rw1_unit(const Frame& F, int u) {
    const int tid = F.tid, lane = F.lane, wave = F.wave, l31 = lane & 31, hi = lane >> 5;
    LAS unsigned char* lds = F.lds;
    const int c = u & 127, bh = u >> 7, b = bh >> 3, h = bh & 7;
    const size_t n0 = (size_t)b * T + 64 * c; const int cb = 64 * h;
    const bf16* rwK = (const bf16*)(F.ws + WS_RW) + (size_t)NTOK * RW; const bf16* rwV = rwK + (size_t)NTOK * RW; const bf16* rwKK = rwV + (size_t)NTOK * RW; const bf16* rwB = rwKK + (size_t)NTOK * RW;
    const float* rwD = (const float*)(F.ws + WS_RW + 96 * MiB);
    {
        float ldv[8]; unsigned kkr[8], br[8], kr[8], vr[8];
#pragma unroll
        for (int q = 0; q < 8; ++q) { const size_t o = (n0 + 8 * wave + q) * RW + cb + lane; ldv[q] = rwD[o]; kkr[q] = rwKK[o]; br[q] = rwB[o]; kr[q] = rwK[o]; vr[q] = rwV[o]; }
        float part = 0.f;
#pragma unroll
        for (int q = 0; q < 8; ++q) part += ldv[q];
        LAS float* psum = (LAS float*)(lds + R1_AAB);
        psum[wave * 64 + lane] = part;
        __syncthreads();
        float pre = 0.f, tot = 0.f;
#pragma unroll
        for (int w = 0; w < 8; ++w) { const float x = psum[w * 64 + lane]; if (w < wave) pre += x; tot += x; }
        float cwv = pre, atf[8]; unsigned bh_[8], kh_[8];
#pragma unroll
        for (int q = 0; q < 8; ++q) {
            const int t = 8 * wave + q;
            const float cwx = cwv; cwv += ldv[q];
            const float kkv = bf2f(kkr[q]), bv = bf2f(br[q]), kv = bf2f(kr[q]);
            const float ex = __expf(cwx), em = __expf(-cwv), eh = __expf(tot - cwv);
            const float an = -kkv * ex;
            *(LAS bf16*)(lds + R1_AN + t * T72 + lane * 2) = (bf16)f2bf(an);
            *(LAS bf16*)(lds + R1_BN + t * T72 + lane * 2) = (bf16)f2bf(bv * em);
            *(LAS bf16*)(lds + R1_KN + t * T72 + lane * 2) = (bf16)f2bf(kv * em);
            atf[q] = an; bh_[q] = f2bf(bv * eh); kh_[q] = f2bf(kv * eh);
        }
        *(LAS u32x4*)(lds + R1_BHT + lane * T72 + wave * 16) = (u32x4){bh_[0] | (bh_[1] << 16), bh_[2] | (bh_[3] << 16), bh_[4] | (bh_[5] << 16), bh_[6] | (bh_[7] << 16)};
        *(LAS u32x4*)(lds + R1_KHT + lane * T72 + wave * 16) = (u32x4){kh_[0] | (kh_[1] << 16), kh_[2] | (kh_[3] << 16), kh_[4] | (kh_[5] << 16), kh_[6] | (kh_[7] << 16)};
        *(LAS u32x4*)(lds + R1_VT + lane * T72 + wave * 16) = (u32x4){vr[0] | (vr[1] << 16), vr[2] | (vr[3] << 16), vr[4] | (vr[5] << 16), vr[6] | (vr[7] << 16)};
        *(LAS f32x4*)(lds + R1_ATF + lane * 272 + wave * 32) = (f32x4){atf[0], atf[1], atf[2], atf[3]};
        *(LAS f32x4*)(lds + R1_ATF + lane * 272 + wave * 32 + 16) = (f32x4){atf[4], atf[5], atf[6], atf[7]};
        if (wave == 0) ((float*)(F.ws + WS_GC))[(size_t)u * 64 + lane] = __expf(tot);
    }
    __syncthreads();
    {
        const int p = wave >> 2, mt = (wave >> 1) & 1, nt = wave & 1;
        f32x16 d = zero16();
        if (mt <= nt) d = mm64(lds + (p ? R1_KN : R1_BN), lds + R1_AN, 32 * mt, 32 * nt, l31, hi, d);
#pragma unroll
        for (int q = 0; q < 16; ++q) { const int tau = 32 * mt + 8 * (q >> 2) + 4 * hi + (q & 3), t = 32 * nt + l31; if (!(tau < t)) d[q] = 0.f; }
        if (p == 0) {
            st_tile_T_f32(lds + R1_AAB, d, 32 * mt, 32 * nt, l31, hi);
#pragma unroll
            for (int q = 0; q < 16; ++q) { const int tau = 32 * mt + 8 * (q >> 2) + 4 * hi + (q & 3), t = 32 * nt + l31; if ((tau >> 4) == (t >> 4)) d[q] = 0.f; }
            st_tile_T_bf(lds + R1_AOFF, d, 32 * mt, 32 * nt, l31, hi);
        } else st_tile_T_bf(lds + R1_AAK, d, 32 * mt, 32 * nt, l31, hi);
    }
    __syncthreads();
    if (wave < 4) { const int mt = wave >> 1, nt = wave & 1; f32x16 d = zero16(); d = mm64(lds + R1_AAK, lds + R1_VT, 32 * mt, 32 * nt, l31, hi, d); st_tile_T_f32(lds + R1_RHS2, d, 32 * mt, 32 * nt, l31, hi); }
    else if (wave == 4) {
        const int blk = lane >> 4, c = lane & 15;
#pragma unroll
        for (int q = 0; q < 4; ++q) *(LAS u32x4*)(lds + R1_TT + lane * 64 + q * 16) = (u32x4){0u, 0u, 0u, 0u};
        float x[16];
#pragma unroll
        for (int r = 0; r < 16; ++r) x[r] = (r == c) ? 1.f : 0.f;
        unsigned ab_ = (unsigned)(size_t)(lds + R1_AAB) + (unsigned)(blk * 16 * 272 + blk * 64); asm volatile("" : "+v"(ab_));
#pragma unroll
        for (int r = 1; r < 16; ++r) {
            float s0 = 0.f;
#pragma unroll
            for (int q = 0; q < (r + 3) / 4; ++q) { const f32x4 a = *(const LAS f32x4*)((const LAS unsigned char*)(size_t)ab_ + r * 272 + q * 16);
                s0 += a[0] * x[4 * q]; if (4 * q + 1 < r) s0 += a[1] * x[4 * q + 1]; if (4 * q + 2 < r) s0 += a[2] * x[4 * q + 2]; if (4 * q + 3 < r) s0 += a[3] * x[4 * q + 3]; }
            x[r] += s0;
            asm volatile("" : "+v"(x[r]));
        }
#pragma unroll
        for (int r = 0; r < 16; ++r) *(LAS bf16*)(lds + R1_TT + ((blk * 16 + r) * 32 + 8 * (c >> 2) + (c & 3)) * 2) = (bf16)f2bf(x[r]);
    } else {
        const int t3 = F.tid - 320;
#pragma unroll
        for (int q = 0; q < 6; ++q) *(LAS u32x4*)(lds + R1_AN + (t3 + 192 * q) * 16) = (u32x4){0u, 0u, 0u, 0u};
    }
    __syncthreads();
    {
        const int cl = lane & 15, qd = lane >> 4, col = 16 * (wave & 3) + cl, isu = wave >> 2;
        const LAS unsigned char* rhs = lds + (isu ? R1_RHS2 : R1_ATF) + col * 272;
        LAS unsigned char* xt = lds + (isu ? R1_BN : R1_AN) + col * T72;
        bf16* gp = (bf16*)(F.ws + (isu ? WS_UPN : WS_WN)) + (size_t)u * 4096 + col;
#pragma unroll
        for (int d = 0; d < 4; ++d) {
            f32x4 acc = *(const LAS f32x4*)(rhs + (16 * d + 4 * qd) * 4);
            if (d > 0) {
#pragma unroll
                for (int ks = 0; ks < (d == 3 ? 2 : 1); ++ks) {
                    const bf16x8 a = *(const LAS bf16x8*)(lds + R1_AOFF + (16 * d + cl) * T72 + (32 * ks + 8 * qd) * 2), bx = *(const LAS bf16x8*)(xt + (32 * ks + 8 * qd) * 2);
                    acc = __builtin_amdgcn_mfma_f32_16x16x32_bf16(a, bx, acc, 0, 0, 0);
                }
            }
            u32x4 bw; bw.x = pk2(acc[0], acc[1]); bw.y = pk2(acc[2], acc[3]); bw.z = 0u; bw.w = 0u;
            const bf16x8 ta = *(const LAS bf16x8*)(lds + R1_TT + ((d * 16 + cl) * 32 + 8 * qd) * 2);
            f32x4 xo = (f32x4){0.f, 0.f, 0.f, 0.f};
            xo = __builtin_amdgcn_mfma_f32_16x16x32_bf16(ta, __builtin_bit_cast(bf16x8, bw), xo, 0, 0, 0);
            u32x2 w; w.x = pk2(xo[0], xo[1]); w.y = pk2(xo[2], xo[3]);
            *(LAS u32x2*)(xt + (16 * d + 4 * qd) * 2) = w;
#pragma unroll
            for (int r = 0; r < 4; ++r) gp[(16 * d + 4 * qd + r) * 64] = (bf16)f2bf(xo[r]);
        }
    }
    __syncthreads();
    {
        const int mt = (wave >> 1) & 1, nt = wave & 1;
        f32x16 d = zero16();
        if (wave < 4) {
            d = mm64(lds + R1_BHT, lds + R1_AN  , 32 * mt, 32 * nt, l31, hi, d);
            unsigned char* img = F.ws + WS_PT + (size_t)u * 16384;
            const int j = 32 * nt + l31, s_ = j >> 4, r_ = j & 15, half = r_ >> 3, hj = (r_ >> 2) & 1, e_ = r_ & 3;
#pragma unroll
            for (int q = 0; q < 16; ++q) { const int jp = 32 * mt + 8 * (q >> 2) + 4 * hi + (q & 3);
                *(bf16*)(img + (((((jp >> 5) * 4 + s_) * 2 + hj) * 32 + (jp & 31)) * 16 + half * 8 + e_ * 2)) = (bf16)f2bf(d[q]); }
        } else {
            d = mm64(lds + R1_BHT, lds + R1_BN  , 32 * mt, 32 * nt, l31, hi, d);
            d = mm64(lds + R1_KHT, lds + R1_VT, 32 * mt, 32 * nt, l31, hi, d);
            unsigned char* img = F.ws + WS_PT + (size_t)u * 16384 + 8192;
#pragma unroll
            for (int g = 0; g < 4; ++g) { u32x2 w; w.x = pk2(d[4 * g], d[4 * g + 1]); w.y = pk2(d[4 * g + 2], d[4 * g + 3]); *(u32x2*)(img + (((((nt * 2 + mt) * 4 + g) * 2 + hi) * 32 + l31) * 8)) = w; }
        }
    }
    __syncthreads();
}

constexpr int R2_SLOT = 16640, R2_NST = 8, R2_QI = 8192, R2_G = 16384;
__device__ __forceinline__ void rw2_issue(LAS unsigned char* slot, const unsigned char* img, const float* gsrc, int lane) {
#pragma unroll
    for (int i = 0; i < 16; ++i) __builtin_amdgcn_global_load_lds((const unsigned*)(img + i * 1024 + lane * 16), (LAS unsigned*)(slot + i * 1024), 16, 0, 0);
    if (lane < 16) __builtin_amdgcn_global_load_lds((const unsigned*)((const unsigned char*)gsrc + lane * 16), (LAS unsigned*)(slot + R2_G), 16, 0, 0);
}
__device__ __forceinline__ void rw2_wg(const Frame& F, int bh) {
    const int lane = F.lane, wave = F.wave, l31 = lane & 31, hi = lane >> 5;
    LAS unsigned char* lds = F.lds;
    LAS unsigned* ctr = (LAS unsigned*)(lds + LDS_MISC + 128);
    if (F.tid < 8) ctr[F.tid] = 0u;
    __syncthreads();
    const unsigned char* IMG = F.ws + WS_PT + (size_t)bh * 128 * 16384; const float* GC = (const float*)(F.ws + WS_GC) + (size_t)bh * 128 * 64;
    if (wave >= 4) {
        const int k = wave - 4;
        rw2_issue(lds + k * R2_SLOT, IMG + (size_t)k * 16384, GC + k * 64, lane);
        rw2_issue(lds + (k + 4) * R2_SLOT, IMG + (size_t)(k + 4) * 16384, GC + (k + 4) * 64, lane);
#pragma unroll 1
        for (int m = 0; m < 32; ++m) {
            const int c = k + 4 * m;
            if (m < 31) asm volatile("s_waitcnt vmcnt(17)" ::: "memory"); else asm volatile("s_waitcnt vmcnt(0)" ::: "memory");
            if (lane == 0) __hip_atomic_store(ctr + k, (unsigned)(m + 1), __ATOMIC_RELEASE, __HIP_MEMORY_SCOPE_WORKGROUP);
            const int cn = c + 8;
            if (cn < 128) {
                for (;;) { const unsigned a = __hip_atomic_load(ctr + 4, __ATOMIC_ACQUIRE, __HIP_MEMORY_SCOPE_WORKGROUP), b2 = __hip_atomic_load(ctr + 5, __ATOMIC_ACQUIRE, __HIP_MEMORY_SCOPE_WORKGROUP);
                    if ((a < b2 ? a : b2) >= (unsigned)(c + 1)) break; __builtin_amdgcn_s_sleep(1); }
                rw2_issue(lds + (cn & 7) * R2_SLOT, IMG + (size_t)cn * 16384, GC + cn * 64, lane);
            } else if (m < 31) {   asm volatile("s_waitcnt vmcnt(0)" ::: "memory"); }
        }
    } else if (wave < 2) {
        const int ih = wave, irow = 32 * ih + l31;
        bf16* S0 = (bf16*)(F.ws + WS_S0);
        f32x16 acc[2]; acc[0] = zero16(); acc[1] = zero16();
#pragma unroll 1
        for (int c = 0; c < 128; ++c) {
            const size_t ub = ((size_t)bh * 128 + c) * 4096;
            const LAS unsigned char* slot = lds + (c & 7) * R2_SLOT;
            bf16x8 xb[4];
#pragma unroll
            for (int jt = 0; jt < 2; ++jt) {
                u32x4 lo, hi4;
                lo.x = pg8::cvt_pk_bf16(acc[jt][0], acc[jt][1]); lo.y = pg8::cvt_pk_bf16(acc[jt][2], acc[jt][3]); lo.z = pg8::cvt_pk_bf16(acc[jt][4], acc[jt][5]); lo.w = pg8::cvt_pk_bf16(acc[jt][6], acc[jt][7]);
                hi4.x = pg8::cvt_pk_bf16(acc[jt][8], acc[jt][9]); hi4.y = pg8::cvt_pk_bf16(acc[jt][10], acc[jt][11]); hi4.z = pg8::cvt_pk_bf16(acc[jt][12], acc[jt][13]); hi4.w = pg8::cvt_pk_bf16(acc[jt][14], acc[jt][15]);
                xb[2 * jt] = __builtin_bit_cast(bf16x8, lo); xb[2 * jt + 1] = __builtin_bit_cast(bf16x8, hi4);
                bf16* sp = S0 + ub + (size_t)irow * 64 + 32 * jt + 4 * hi;
                *(u32x2*)(sp) = (u32x2){lo.x, lo.y}; *(u32x2*)(sp + 8) = (u32x2){lo.z, lo.w}; *(u32x2*)(sp + 16) = (u32x2){hi4.x, hi4.y}; *(u32x2*)(sp + 24) = (u32x2){hi4.z, hi4.w};
            }
            while (__hip_atomic_load(ctr + (c & 3), __ATOMIC_ACQUIRE, __HIP_MEMORY_SCOPE_WORKGROUP) < (unsigned)((c >> 2) + 1)) __builtin_amdgcn_s_sleep(1);
            f32x16 nw[2];
#pragma unroll
            for (int jt = 0; jt < 2; ++jt)
#pragma unroll
                for (int g = 0; g < 4; ++g) {
                    const u32x2 qv = *(const LAS u32x2*)(slot + R2_QI + (((((ih * 2 + jt) * 4 + g) * 2 + hi) * 32 + l31) * 8));
                    const f32x4 gv = *(const LAS f32x4*)(slot + R2_G + (32 * jt + 8 * g + 4 * hi) * 4);
                    nw[jt][4 * g + 0] = bflo(qv.x) + gv[0] * acc[jt][4 * g + 0]; nw[jt][4 * g + 1] = bfhi(qv.x) + gv[1] * acc[jt][4 * g + 1];
                    nw[jt][4 * g + 2] = bflo(qv.y) + gv[2] * acc[jt][4 * g + 2]; nw[jt][4 * g + 3] = bfhi(qv.y) + gv[3] * acc[jt][4 * g + 3];
                }
#pragma unroll
            for (int jt = 0; jt < 2; ++jt)
#pragma unroll
                for (int s_ = 0; s_ < 4; ++s_) {
                    const bf16x8 af = *(const LAS bf16x8*)(slot + ((((jt * 4 + s_) * 2 + hi) * 32 + l31) * 16));
                    nw[jt] = mfma32(af, xb[s_], nw[jt]);
                }
            asm volatile("s_waitcnt lgkmcnt(0)" ::: "memory");
            if (lane == 0) __hip_atomic_store(ctr + 4 + wave, (unsigned)(c + 1), __ATOMIC_RELEASE, __HIP_MEMORY_SCOPE_WORKGROUP);
            acc[0] = nw[0]; acc[1] = nw[1];
        }
    }
}

constexpr int R3_RN = 0, R3_BN = 9216, R3_KN = 18432, R3_WN = 27648, R3_S0 = 36864, R3_VT = 46080, R3_UT = 55296, R3_ARB = 64512, R3_ARK = 73728, R3_YL = 82944;
__device__ __forceinline__ void rw3_unit(const Frame& F, int u, int l) {
    const int tid = F.tid, lane = F.lane, wave = F.wave, l31 = lane & 31, hi = lane >> 5;
    LAS unsigned char* lds = F.lds;
    const int c = u & 127, bh = u >> 7, b = bh >> 3, h = bh & 7;
    const size_t n0 = (size_t)b * T + 64 * c; const int cb = 64 * h;
    const bf16* rwR = (const bf16*)(F.ws + WS_RW); const bf16* rwK = rwR + (size_t)NTOK * RW; const bf16* rwV = rwK + (size_t)NTOK * RW; const bf16* rwB = rwR + (size_t)4 * NTOK * RW;
    const float* rwD = (const float*)(F.ws + WS_RW + 96 * MiB);
    {
        float ldv[8]; unsigned rr[8], br[8], kr[8], vr[8];
#pragma unroll
        for (int q = 0; q < 8; ++q) { const size_t o = (n0 + 8 * wave + q) * RW + cb + lane; ldv[q] = rwD[o]; rr[q] = rwR[o]; br[q] = rwB[o]; kr[q] = rwK[o]; vr[q] = rwV[o]; }
        const int row = tid >> 3, ch = (tid & 7) * 8;
        const u32x4 wcp = *(const u32x4*)((const bf16*)(F.ws + WS_WN) + (size_t)u * 4096 + row * 64 + ch), scp = *(const u32x4*)((const bf16*)(F.ws + WS_S0) + (size_t)u * 4096 + row * 64 + ch);
        float part = 0.f;
#pragma unroll
        for (int q = 0; q < 8; ++q) part += ldv[q];
        LAS float* psum = (LAS float*)(lds + R3_YL);
        psum[wave * 64 + lane] = part;
        __syncthreads();
        float cwv = 0.f;
#pragma unroll
        for (int w = 0; w < 8; ++w) { const float x = psum[w * 64 + lane]; if (w < wave) cwv += x; }
#pragma unroll
        for (int q = 0; q < 8; ++q) {
            const int t = 8 * wave + q;
            cwv += ldv[q];
            const float ep = __expf(cwv), em = __expf(-cwv);
            *(LAS bf16*)(lds + R3_RN + t * T72 + lane * 2) = (bf16)f2bf(bf2f(rr[q]) * ep);
            *(LAS bf16*)(lds + R3_BN + t * T72 + lane * 2) = (bf16)f2bf(bf2f(br[q]) * em);
            *(LAS bf16*)(lds + R3_KN + t * T72 + lane * 2) = (bf16)f2bf(bf2f(kr[q]) * em);
        }
        *(LAS u32x4*)(lds + R3_VT + lane * T72 + wave * 16) = (u32x4){vr[0] | (vr[1] << 16), vr[2] | (vr[3] << 16), vr[4] | (vr[5] << 16), vr[6] | (vr[7] << 16)};
        *(LAS u32x4*)(lds + R3_WN + row * T72 + ch * 2) = wcp;
        *(LAS u32x4*)(lds + R3_S0 + row * T72 + ch * 2) = scp;
    }
    __syncthreads();
    f32x16 y = zero16();
    {
        const int p = wave >> 2, mt = (wave >> 1) & 1, nt = wave & 1;
        f32x16 d = zero16();
        if (mt <= nt) d = mm64(lds + (p ? R3_KN : R3_BN), lds + R3_RN, 32 * mt, 32 * nt, l31, hi, d);
#pragma unroll
        for (int q = 0; q < 16; ++q) { const int tau = 32 * mt + 8 * (q >> 2) + 4 * hi + (q & 3), t = 32 * nt + l31; if (!(tau <= t)) d[q] = 0.f; }
        st_tile_T_bf(lds + (p ? R3_ARK : R3_ARB), d, 32 * mt, 32 * nt, l31, hi);
        if (wave < 4) {
            f32x16 uu;
            const bf16* up = (const bf16*)(F.ws + WS_UPN) + (size_t)u * 4096 + 32 * nt + l31;
#pragma unroll
            for (int q = 0; q < 16; ++q) uu[q] = bf2f(up[(32 * mt + 8 * (q >> 2) + 4 * hi + (q & 3)) * 64]);
            uu = mm64(lds + R3_WN, lds + R3_S0, 32 * mt, 32 * nt, l31, hi, uu);
            st_tile_T_bf(lds + R3_UT, uu, 32 * mt, 32 * nt, l31, hi);
        } else y = mm64(lds + R3_RN, lds + R3_S0, 32 * mt, 32 * nt, l31, hi, y);
    }
    __syncthreads();
    if (wave >= 4) {
        const int mt = (wave >> 1) & 1, nt = wave & 1;
        y = mm64(lds + R3_ARB, lds + R3_UT, 32 * mt, 32 * nt, l31, hi, y);
        y = mm64(lds + R3_ARK, lds + R3_VT, 32 * mt, 32 * nt, l31, hi, y);
#pragma unroll
        for (int q = 0; q < 16; ++q) *(LAS float*)(lds + R3_YL + (32 * mt + 8 * (q >> 2) + 4 * hi + (q & 3)) * 272 + (32 * nt + l31) * 4) = y[q];
    }
    __syncthreads();
    {
        const int t = tid >> 3, i8 = (tid & 7) * 8; const size_t o = (n0 + t) * RW + cb + i8;
        const f32x4 y0 = *(const LAS f32x4*)(lds + R3_YL + t * 272 + i8 * 4), y1 = *(const LAS f32x4*)(lds + R3_YL + t * 272 + i8 * 4 + 16);
        const bf16* rwG = rwR + (size_t)5 * NTOK * RW;
        const u32x4 rw = *(const u32x4*)(rwR + o), kw = *(const u32x4*)(rwK + o), vw = *(const u32x4*)(rwV + o), gw = *(const u32x4*)(rwG + o);
        float yy[8] = {y0[0], y0[1], y0[2], y0[3], y1[0], y1[1], y1[2], y1[3]};
        const float r[8] = {bflo(rw.x), bfhi(rw.x), bflo(rw.y), bfhi(rw.y), bflo(rw.z), bfhi(rw.z), bflo(rw.w), bfhi(rw.w)};
        const float k[8] = {bflo(kw.x), bfhi(kw.x), bflo(kw.y), bfhi(kw.y), bflo(kw.z), bfhi(kw.z), bflo(kw.w), bfhi(kw.w)};
        const float v[8] = {bflo(vw.x), bfhi(vw.x), bflo(vw.y), bfhi(vw.y), bflo(vw.z), bfhi(vw.z), bflo(vw.w), bfhi(vw.w)};
        const float g[8] = {bflo(gw.x), bfhi(gw.x), bflo(gw.y), bfhi(gw.y), bflo(gw.z), bfhi(gw.z), bflo(gw.w), bfhi(gw.w)};
        const float* gng = F.in(I_GNG) + l * RW + cb + i8; const float* gnb = F.in(I_GNB) + l * RW + cb + i8; const float* rk = F.in(I_RK) + l * RW + cb + i8;
        float sm = 0.f, bon = 0.f;
#pragma unroll
        for (int j = 0; j < 8; ++j) { sm += yy[j]; bon += r[j] * k[j] * rk[j]; }
        sm = sum8(sm); bon = sum8(bon);
        const float mean = sm * (1.f / 64.f);
        float var = 0.f;
#pragma unroll
        for (int j = 0; j < 8; ++j) { yy[j] -= mean; var += yy[j] * yy[j]; }
        var = sum8(var);
        const float inv = __builtin_amdgcn_rsqf(var * (1.f / 64.f) + 64e-5f);
        float ov[8];
#pragma unroll
        for (int j = 0; j < 8; ++j) ov[j] = (yy[j] * inv * gng[j] + gnb[j] + bon * v[j]) * g[j];
        u32x4 w; w.x = pk2(ov[0], ov[1]); w.y = pk2(ov[2], ov[3]); w.z = pk2(ov[4], ov[5]); w.w = pk2(ov[6], ov[7]);
        *(u32x4*)((bf16*)(F.ws + WS_YA) + o) = w;
    }
    __syncthreads();
}

constexpr int AT_KT = 0, AT_VT = 18432, AT_IMP = 36864, AT_MASK = 69632, AT_OUT = 70656;
struct KvRegs { u32x4 k, v; };
__device__ __forceinline__ KvRegs kv_load(const bf16* kbase, const bf16* vtbase, int vstride, int key0, int tid) {
    KvRegs r; const int row = tid >> 3, ch = (tid & 7) * 8;
    r.k = *(const u32x4*)(kbase + (size_t)(key0 + row) * 64 + ch);
    r.v = *(const u32x4*)(vtbase + (size_t)row * vstride + key0 + ch);
    return r;
}
__device__ __forceinline__ void kv_store(LAS unsigned char* lds, int buf, const KvRegs& r, int tid) {
    const int row = tid >> 3, ch = (tid & 7) * 16;
    *(LAS u32x4*)(lds + AT_KT + buf * 9216 + row * 144 + ch) = r.k;
    {   const int c = tid & 7, s_ = c >> 1, half = c & 1, dt = row >> 5, r31 = row & 31;
        LAS unsigned char* vb = lds + AT_VT + buf * 9216 + ((((dt * 4 + s_) * 2) * 32 + r31) * 16) + half * 8;
        *(LAS u32x2*)vb = (u32x2){r.v.x, r.v.y}; *(LAS u32x2*)(vb + 512) = (u32x2){r.v.z, r.v.w}; }
}
__device__ __forceinline__ void qk_tile(const LAS unsigned char* kt, const bf16x8 (&qf)[4], int l31, int hi, f32x16& s0, f32x16& s1, float init) {
#pragma unroll
    for (int q = 0; q < 16; ++q) { s0[q] = init; s1[q] = init; }
#pragma unroll
    for (int sl = 0; sl < 4; ++sl) {
        const bf16x8 a0 = *(const LAS bf16x8*)(kt + l31 * 144 + sl * 32 + hi * 16), a1 = *(const LAS bf16x8*)(kt + (32 + l31) * 144 + sl * 32 + hi * 16);
        s0 = mfma32(a0, qf[sl], s0); s1 = mfma32(a1, qf[sl], s1);
    }
}
__device__ __forceinline__ void pv_tile(const LAS unsigned char* vt, const f32x16& p0, const f32x16& p1, int l31, int hi, f32x16 (&o)[2]) {
#pragma unroll
    for (int s = 0; s < 4; ++s) {
        const f32x16& pp = (s < 2) ? p0 : p1; const int rb = (s & 1) * 8;
        bf16x8 pb; u32x4 pw;
        pw.x = pg8::cvt_pk_bf16(pp[rb + 0], pp[rb + 1]); pw.y = pg8::cvt_pk_bf16(pp[rb + 2], pp[rb + 3]); pw.z = pg8::cvt_pk_bf16(pp[rb + 4], pp[rb + 5]); pw.w = pg8::cvt_pk_bf16(pp[rb + 6], pp[rb + 7]);
        pb = __builtin_bit_cast(bf16x8, pw);
#pragma unroll
        for (int dt = 0; dt < 2; ++dt) {
            const bf16x8 vf = *(const LAS bf16x8*)(vt + ((((dt * 4 + s) * 2 + hi) * 32 + l31) * 16));
            o[dt] = mfma32(vf, pb, o[dt]);
        }
    }
}
constexpr float NEG_BIG = -1e30f;
__device__ __forceinline__ void mask_lt(f32x16& s0, f32x16& s1, int lim, int hi) {
    const int l2 = lim - 4 * hi;
#pragma unroll
    for (int q = 0; q < 16; ++q) { const int kq = 8 * (q >> 2) + (q & 3); s0[q] = (kq < l2) ? s0[q] : NEG_BIG; s1[q] = (kq + 32 < l2) ? s1[q] : NEG_BIG; }
}
__device__ __forceinline__ void mask_ge(f32x16& s0, f32x16& s1, int lim, int hi) {
    const int l2 = lim - 4 * hi;
#pragma unroll
    for (int q = 0; q < 16; ++q) { const int kq = 8 * (q >> 2) + (q & 3); s0[q] = (kq >= l2) ? s0[q] : NEG_BIG; s1[q] = (kq + 32 >= l2) ? s1[q] : NEG_BIG; }
}
constexpr float SM_OFF = -16.f;
__device__ __forceinline__ void exp_tile(f32x16& s0, f32x16& s1, float& lsum) {
    float ps = 0.f;
#pragma unroll
    for (int q = 0; q < 16; ++q) { s0[q] = __builtin_amdgcn_exp2f(s0[q]); s1[q] = __builtin_amdgcn_exp2f(s1[q]); ps += s0[q] + s1[q]; }
    lsum += ps;
}
__device__ __forceinline__ void attn_unit(const Frame& F_, int unit) {
    const Frame& F = F_;
    const int tid = F.tid, lane = F.lane, wave = F.wave, l31 = lane & 31, hi = lane >> 5;
    const int bg = unit >> 7, qb = unit & 127, b = bg >> 1, g = bg & 1;
    LAS unsigned char* lds = F.lds;
    LAS float* IMP = (LAS float*)(lds + AT_IMP); LAS unsigned* MASK = (LAS unsigned*)(lds + AT_MASK);
    const int ql = 8 * wave + (l31 >> 2), hd = l31 & 3;
    const int tq = ql;
    const size_t nq = (size_t)b * T + 64 * qb + ql;
    bf16x8 qf[4];
    {
        const bf16* qp = (const bf16*)(F.ws + NS_Q) + nq * 512 + g * 256 + hd * 64 + hi * 8;
#pragma unroll
        for (int sl = 0; sl < 4; ++sl) qf[sl] = *(const bf16x8*)(qp + sl * 16);
    }
    const float* gt = (const float*)(F.ws + NS_GATE) + nq * 24 + (g * 4 + hd) * 3;
    LAS float* outl = (LAS float*)(lds + AT_OUT) + wave * 2048 + lane;
    const bf16* kcmp = (const bf16*)(F.ws + NS_KCMP) + (size_t)bg * NCMPP * 64; const bf16* vcmpT = (const bf16*)(F.ws + NS_VCMPT) + (size_t)bg * 64 * NCMPP;
    const int ntc = (4 * qb + 3 + 63) >> 6;
    const int tabs = 64 * qb + tq;
    const int nvis = (tabs >= 31) ? ((tabs - 31) >> 4) + 1 : 0;
    const int tmin_w = 64 * qb + 8 * wave; const int nvis_min = (tmin_w >= 31) ? ((tmin_w - 31) >> 4) + 1 : 0;
    float lc = 0.f;
    f32x16 o[2];
    const bf16* ks_e = (const bf16*)(F.ws + NS_KS) + (size_t)bg * T * 64; const bf16* vsT_e = (const bf16*)(F.ws + NS_VST) + (size_t)bg * 64 * T;
    const bf16* kw_e = (const bf16*)(F.ws + NS_KW) + (size_t)bg * T * 64; const bf16* vwT_e = (const bf16*)(F.ws + NS_VWT) + (size_t)bg * 64 * T;
    const KvRegs pre_c0 = kv_load(kcmp, vcmpT, NCMPP, 0, tid);
    {
        KvRegs pre = pre_c0;
        for (int jt = 0; jt < ntc; ++jt) {
            kv_store(lds, jt & 1, pre, tid);
            if (jt + 1 < ntc) pre = kv_load(kcmp, vcmpT, NCMPP, 64 * (jt + 1), tid);
            __syncthreads();
            f32x16 s0, s1; qk_tile(lds + AT_KT + (jt & 1) * 9216, qf, l31, hi, s0, s1, SM_OFF);
            if (64 * (jt + 1) > nvis_min) { int nv = nvis - 64 * jt; asm volatile("" : "+v"(nv)); mask_lt(s0, s1, nv, hi); }
            exp_tile(s0, s1, lc);
        }
    }
    __syncthreads();
    {
        lc = sum_halves(lc);
        const float invl = (lc > 0.f) ? 1.f / lc : 0.f;
#pragma unroll
        for (int q = 0; q < 16; ++q) { o[0][q] = 0.f; o[1][q] = 0.f; }
        float carry = 0.f;
        KvRegs pre = pre_c0;
        for (int jt = 0; jt < ntc; ++jt) {
            kv_store(lds, jt & 1, pre, tid);
            if (jt + 1 < ntc) pre = kv_load(kcmp, vcmpT, NCMPP, 64 * (jt + 1), tid);
            __syncthreads();
            f32x16 s0, s1; qk_tile(lds + AT_KT + (jt & 1) * 9216, qf, l31, hi, s0, s1, SM_OFF);
            if (64 * (jt + 1) > nvis_min) { int nv = nvis - 64 * jt; asm volatile("" : "+v"(nv)); mask_lt(s0, s1, nv, hi); }
#pragma unroll
            for (int q = 0; q < 16; ++q) { s0[q] = __builtin_amdgcn_exp2f(s0[q]) * invl; s1[q] = __builtin_amdgcn_exp2f(s1[q]) * invl; }
            pv_tile(lds + AT_VT + (jt & 1) * 9216, s0, s1, l31, hi, o);
            float gs[8], ls[8];
#pragma unroll
            for (int kt = 0; kt < 2; ++kt)
#pragma unroll
                for (int j = 0; j < 4; ++j) { const f32x16& pp = kt ? s1 : s0; gs[kt * 4 + j] = quad_sum(pp[4 * j] + pp[4 * j + 1] + pp[4 * j + 2] + pp[4 * j + 3]); ls[kt * 4 + j] = quad_sum(pp[4 * j + 3]); }
            float lx[8];
#pragma unroll
            for (int i = 0; i < 8; ++i) lx[i] = other_half(ls[i], hi);
#pragma unroll
            for (int i = 0; i < 8; ++i) {
                const float add = hi ? lx[i] : (i == 0 ? carry : lx[i - 1]);
                if (hd == 0) IMP[ql * 128 + 16 * jt + 2 * i + hi] = gs[i] + add;
            }
            carry = lx[7];
        }
        const float g0 = gt[0];
#pragma unroll
        for (int q = 0; q < 16; ++q) { outl[q * 64] = g0 * o[0][q]; outl[(16 + q) * 64] = g0 * o[1][q]; }
    }
    __syncthreads();
    {
        const unsigned long long lt_mask = (1ull << lane) - 1ull;
#pragma unroll 1
        for (int qi = 0; qi < 8; ++qi) {
            const int qq = 8 * wave + qi;
            unsigned long long m0, m1;
            if (qb < 16) { m0 = __ballot(lane <= qb); m1 = 0ull; }
            else {
                const int sA = lane, sB = lane + 64;
                const unsigned kA = (sA > qb) ? 0u : ((sA == 0 || sA == qb || sA == qb - 1) ? 0x461c4000u : __builtin_bit_cast(unsigned, IMP[qq * 128 + sA]));
                const unsigned kB = (sB > qb) ? 0u : ((sB == qb || sB == qb - 1) ? 0x461c4000u : __builtin_bit_cast(unsigned, IMP[qq * 128 + sB]));
                unsigned thr = 0u;
#pragma unroll 1
                for (int bitp = 30; bitp >= 0; --bitp) { const unsigned cand = thr | (1u << bitp);
                    const int cnt = __popcll(__ballot(kA >= cand)) + __popcll(__ballot(kB >= cand)); if (cnt >= 16) thr = cand; }
                const unsigned long long gA = __ballot(kA > thr), gB = __ballot(kB > thr), eA = __ballot(kA == thr), eB = __ballot(kB == thr);
                const int need = 16 - (__popcll(gA) + __popcll(gB));
                const bool selA = (kA > thr) || (kA == thr && __popcll(eA & lt_mask) < need);
                const bool selB = (kB > thr) || (kB == thr && __popcll(eA) + __popcll(eB & lt_mask) < need);
                m0 = __ballot(selA && sA <= qb); m1 = __ballot(selB && sB <= qb);
            }
            if (lane == 0) { MASK[qq * 4 + 0] = (unsigned)m0; MASK[qq * 4 + 1] = (unsigned)(m0 >> 32); MASK[qq * 4 + 2] = (unsigned)m1; MASK[qq * 4 + 3] = (unsigned)(m1 >> 32); }
        }
    }
    __syncthreads();
    unsigned selm[4];
#pragma unroll
    for (int i = 0; i < 4; ++i) selm[i] = MASK[ql * 4 + i];
    {
        const Frame F = relaunder(F_);
        const bf16* ks = (const bf16*)(F.ws + NS_KS) + (size_t)bg * T * 64; const bf16* vsT = (const bf16*)(F.ws + NS_VST) + (size_t)bg * 64 * T;
        float lsum = 0.f;
#pragma unroll
        for (int q = 0; q < 16; ++q) { o[0][q] = 0.f; o[1][q] = 0.f; }
        unsigned wm[4];
#pragma unroll
        for (int i = 0; i < 4; ++i) { unsigned w = 0u;
#pragma unroll
            for (int q = 0; q < 8; ++q) w |= (unsigned)__builtin_amdgcn_readlane((int)selm[i], 4 * q);
            wm[i] = w; }
        unsigned long long wlo = ((unsigned long long)wm[1] << 32) | wm[0], whi = ((unsigned long long)wm[3] << 32) | wm[2];
#define SEL_NEXT(dst) do { if (wlo) { dst = __builtin_ctzll(wlo); wlo &= wlo - 1ull; } else if (whi) { dst = 64 + __builtin_ctzll(whi); whi &= whi - 1ull; } else dst = -1; } while (0)
#define SEL_LOAD(kX, vX, jj) do { const bf16* kp_ = ks + (size_t)(jj) * 4096 + (l31 * 2 + hi) * 8; const bf16* vp_ = vsT + (size_t)(jj) * 4096 + (l31 * 2 + hi) * 8; \
            _Pragma("unroll") for (int sl = 0; sl < 4; ++sl) { kX[2 * sl] = *(const bf16x8*)(kp_ + sl * 512); kX[2 * sl + 1] = *(const bf16x8*)(kp_ + 2048 + sl * 512); } \
            _Pragma("unroll") for (int i = 0; i < 8; ++i) vX[i] = *(const bf16x8*)(vp_ + i * 512); } while (0)
#define SEL_COMPUTE(kX, vX, jj) do { \
            const unsigned bit = (((jj) & 32) ? (((jj) & 64) ? selm[3] : selm[1]) : (((jj) & 64) ? selm[2] : selm[0])) >> ((jj) & 31) & 1u; \
            const float init = bit ? SM_OFF : NEG_BIG; \
            f32x16 s0, s1; \
            _Pragma("unroll") for (int q = 0; q < 16; ++q) { s0[q] = init; s1[q] = init; } \
            _Pragma("unroll") for (int sl = 0; sl < 4; ++sl) { s0 = mfma32(kX[2 * sl], qf[sl], s0); s1 = mfma32(kX[2 * sl + 1], qf[sl], s1); } \
            if ((jj) == qb) { int tql = tq + 1; asm volatile("" : "+v"(tql)); mask_lt(s0, s1, tql, hi); } \
            exp_tile(s0, s1, lsum); \
            _Pragma("unroll") for (int sq = 0; sq < 4; ++sq) { \
                const f32x16& pp = (sq < 2) ? s0 : s1; const int rb = (sq & 1) * 8; \
                u32x4 pw; \
                pw.x = pg8::cvt_pk_bf16(pp[rb + 0], pp[rb + 1]); pw.y = pg8::cvt_pk_bf16(pp[rb + 2], pp[rb + 3]); pw.z = pg8::cvt_pk_bf16(pp[rb + 4], pp[rb + 5]); pw.w = pg8::cvt_pk_bf16(pp[rb + 6], pp[rb + 7]); \
                const bf16x8 pb = __builtin_bit_cast(bf16x8, pw); \
                _Pragma("unroll") for (int dt = 0; dt < 2; ++dt) o[dt] = mfma32(vX[dt * 4 + sq], pb, o[dt]); } } while (0)
        int j; SEL_NEXT(j);
        bf16x8 kA[8], vA[8], kB[8], vB[8];
        if (j >= 0) SEL_LOAD(kA, vA, j);
        while (j >= 0) {
            int jn; SEL_NEXT(jn);
            if (jn >= 0) SEL_LOAD(kB, vB, jn);
            SEL_COMPUTE(kA, vA, j);
            if (jn < 0) break;
            j = jn; SEL_NEXT(jn);
            if (jn >= 0) SEL_LOAD(kA, vA, jn);
            SEL_COMPUTE(kB, vB, j);
            j = jn;
        }
#undef SEL_LOAD
#undef SEL_COMPUTE
#undef SEL_NEXT
        lsum = sum_halves(lsum);
        const float sc = gt[1] / fmaxf(lsum, 1.17549435e-38f);
#pragma unroll
        for (int q = 0; q < 16; ++q) { outl[q * 64] += sc * o[0][q]; outl[(16 + q) * 64] += sc * o[1][q]; }
    }
    __syncthreads();
    {
        const Frame F = relaunder(F_); const int tid = F.tid;
        const bf16* kw = (const bf16*)(F.ws + NS_KW) + (size_t)bg * T * 64; const bf16* vwT = (const bf16*)(F.ws + NS_VWT) + (size_t)bg * 64 * T;
        float lsum = 0.f;
#pragma unroll
        for (int q = 0; q < 16; ++q) { o[0][q] = 0.f; o[1][q] = 0.f; }
        const int j0 = qb >= 8 ? qb - 8 : 0;
        KvRegs pre = kv_load(kw, vwT, T, 64 * j0, tid);
        for (int j = j0; j <= qb; ++j) {
            kv_store(lds, j & 1, pre, tid);
            if (j + 1 <= qb) pre = kv_load(kw, vwT, T, 64 * (j + 1), tid);
            __syncthreads();
            f32x16 s0, s1; qk_tile(lds + AT_KT + (j & 1) * 9216, qf, l31, hi, s0, s1, SM_OFF);
            if (j == qb || j + 8 == qb) {
                int tql = tq + 1; asm volatile("" : "+v"(tql));
                if (j == qb) mask_lt(s0, s1, tql, hi); else mask_ge(s0, s1, tql, hi);
            }
            exp_tile(s0, s1, lsum);
            pv_tile(lds + AT_VT + (j & 1) * 9216, s0, s1, l31, hi, o);
        }
        lsum = sum_halves(lsum);
        const float sc = gt[2] / fmaxf(lsum, 1.17549435e-38f);
        bf16* yb = (bf16*)(F.ws + WS_YB) + nq * 512 + g * 256 + hd * 64;
#pragma unroll
        for (int dt = 0; dt < 2; ++dt)
#pragma unroll
            for (int j = 0; j < 4; ++j) {
                float v4[4];
#pragma unroll
                for (int r = 0; r < 4; ++r) v4[r] = outl[(16 * dt + 4 * j + r) * 64] + sc * o[dt][4 * j + r];
                u32x2 w; w.x = pg8::cvt_pk_bf16(v4[0], v4[1]); w.y = pg8::cvt_pk_bf16(v4[2], v4[3]);
                *(u32x2*)(yb + 32 * dt + 8 * j + 4 * hi) = w;
            }
    }
    __syncthreads();
}
__device__ __forceinline__ void phase_mix(const Frame& F, int l, int rep) {
    LAS int* slot = (LAS int*)(F.lds + LDS_MISC + 64);
    const int home = (int)(xb_xcc_id() >> 1) & 3;
    for (int k = 0; k < 4; ++k) {
        const int qd = (home + k) & 3;
        unsigned* head = (unsigned*)(F.ws + WS_CTL) + CW_QUEUE + 64 * l + 4 * qd;
        for (;;) {
            if (F.tid == 0) *slot = (int)__hip_atomic_fetch_add(head, 1u, __ATOMIC_RELAXED, __HIP_MEMORY_SCOPE_AGENT);
            __syncthreads();
            const int it = *slot;
            __syncthreads();
            const Frame Fi = relaunder(F);
            if (it >= 4 + 128) break;
            if (it < 4) { rw2_wg(Fi, qd * 4 + it); __syncthreads(); }
            else attn_unit(Fi, (qd << 7) | (127 - (it - 4)));
        }
    }
}
__device__ __forceinline__ void phase_rw1(const Frame& F, int l) {
    unsigned* head = (unsigned*)(F.ws + WS_CTL) + CW_QUEUE + 64 * l + 32;
    LAS int* slot = (LAS int*)(F.lds + LDS_MISC + 64);
    for (;;) {
        if (F.tid == 0) *slot = (int)__hip_atomic_fetch_add(head, 2u, __ATOMIC_RELAXED, __HIP_MEMORY_SCOPE_AGENT);
        __syncthreads();
        const int u0 = *slot;
        __syncthreads();
        if (u0 >= 2048) break;
        { const Frame Fi = relaunder(F); rw1_unit(Fi, u0); }
        { const Frame Fi = relaunder(F); rw1_unit(Fi, u0 + 1); }
    }
}
__device__ __forceinline__ void phase_rw3(const Frame& F, int l) { for (int u = F.bid; u < 2048; u += F.G) { const Frame Fi = relaunder(F); rw3_unit(Fi, u, l); } }
__device__ __forceinline__ void phase_router(const Frame& F, int l) {
    LAS float* rwt = (LAS float*)F.lds;
    LAS float* lg = (LAS float*)(F.lds + 65536);
    LAS unsigned* lcnt = (LAS unsigned*)(F.lds + 65536 + 2048);
    if (F.tid < 32) lcnt[F.tid] = 0u;
    for (int i = F.tid; i < 16384; i += NTHR) { const int c = i >> 4, e = i & 15; rwt[e * 1024 + c] = F.in(I_RTW)[i]; }
    __syncthreads();
    const bf16* xin = (const bf16*)(F.ws + WS_XR);
    int* texp = (int*)(F.ws + WS_TOK); int* tpos = (int*)(F.ws + WS_TOK + 131072); float* tw = (float*)(F.ws + WS_TOK + 2 * 131072);
    unsigned* cnt = (unsigned*)(F.ws + WS_CTL) + CW_CNT + 64 * l;
    const float* ng = F.in(I_NORMG) + (size_t)(l * 2 + 1) * D;
    LAS float* mylg = lg + F.wave * 64;
    bf16* H2 = (bf16*)(F.ws + WS_H); int* e2t = (int*)(F.ws + WS_E2T);
    for (int n4 = (F.bid * NWAVE + F.wave) * 4; n4 < NTOK; n4 += F.G * NWAVE * 4) {
        const int b = n4 / T; const float* sh = F.modp(l, b) + 3072; const float* scp = sh + 1024;
        float hv[4][16];
#pragma unroll
        for (int tk = 0; tk < 4; ++tk) {
            f32x4 xv[4]; float ss = 0.f;
#pragma unroll
            for (int j = 0; j < 4; ++j) { const u32x2 xr = *(const u32x2*)(xin + (size_t)(n4 + tk) * D + 4 * F.lane + 256 * j); xv[j] = (f32x4){bflo(xr.x), bfhi(xr.x), bflo(xr.y), bfhi(xr.y)}; ss += xv[j][0] * xv[j][0] + xv[j][1] * xv[j][1] + xv[j][2] * xv[j][2] + xv[j][3] * xv[j][3]; }
            ss = sum64(ss);
            const float inv = __builtin_amdgcn_rsqf(ss * (1.f / D) + 1e-6f);
#pragma unroll
            for (int j = 0; j < 4; ++j) { const int c = 4 * F.lane + 256 * j; const f32x4 g = *(const f32x4*)(ng + c), s1 = *(const f32x4*)(scp + c), s0 = *(const f32x4*)(sh + c);
#pragma unroll
                for (int q = 0; q < 4; ++q) hv[tk][4 * j + q] = xv[j][q] * inv * g[q] * (1.f + s1[q]) + s0[q];
                u32x2 w; w.x = pk2(hv[tk][4 * j], hv[tk][4 * j + 1]); w.y = pk2(hv[tk][4 * j + 2], hv[tk][4 * j + 3]);
                *(u32x2*)(H2 + (size_t)(n4 + tk) * D + c) = w; }
        }
        float acc[64];
#pragma unroll
        for (int i = 0; i < 64; ++i) acc[i] = 0.f;
#pragma unroll
        for (int e = 0; e < 16; ++e)
#pragma unroll
            for (int j = 0; j < 4; ++j) { const f32x4 w = *(const LAS f32x4*)(rwt + e * 1024 + 4 * F.lane + 256 * j);
#pragma unroll
                for (int tk = 0; tk < 4; ++tk) acc[tk * 16 + e] += hv[tk][4 * j] * w[0] + hv[tk][4 * j + 1] * w[1] + hv[tk][4 * j + 2] * w[2] + hv[tk][4 * j + 3] * w[3]; }
#define RT_STEP(MSK, XCHG) do { const bool up = (F.lane & (MSK)) != 0; \
            _Pragma("unroll") for (int i = 0; i < (MSK); ++i) { const float keep = up ? acc[i + (MSK)] : acc[i], send = up ? acc[i] : acc[i + (MSK)]; acc[i] = keep + XCHG; } } while (0)
        RT_STEP(32, other_half(send, F.lane >> 5)); RT_STEP(16, xor_lane<16>(send)); RT_STEP(8, xor_lane<8>(send)); RT_STEP(4, xor_lane<4>(send)); RT_STEP(2, xor_lane<2>(send)); RT_STEP(1, xor_lane<1>(send));
#undef RT_STEP
        mylg[F.lane] = acc[0];
        __builtin_amdgcn_fence(__ATOMIC_RELEASE, "workgroup"); __builtin_amdgcn_s_waitcnt(0xc07f); __builtin_amdgcn_fence(__ATOMIC_ACQUIRE, "workgroup");
        if (F.lane < 4) {
            const int tk = F.lane, n = n4 + tk;
            float sc[16], sl[16];
#pragma unroll
            for (int e = 0; e < 16; ++e) { sc[e] = sigmoidf_(mylg[tk * 16 + e]); sl[e] = sc[e] + F.in(I_RTB)[e]; }
            int bestg = 0; float bests = -1e30f;
#pragma unroll
            for (int gq = 0; gq < 4; ++gq) { float m1 = -1e30f, m2 = -1e30f;
#pragma unroll
                for (int j = 0; j < 4; ++j) { const float v = sl[gq * 4 + j]; if (v > m1) { m2 = m1; m1 = v; } else if (v > m2) m2 = v; }
                const float gs = m1 + m2; if (gs > bests) { bests = gs; bestg = gq; } }
            float v1 = -1e30f, v2 = -1e30f; int e1 = 0, e2 = 0; float s1 = 0.f, s2 = 0.f;
#pragma unroll
            for (int gq = 0; gq < 4; ++gq)
#pragma unroll
                for (int j = 0; j < 4; ++j) { if (gq == bestg) { const float v = sl[gq * 4 + j], s = sc[gq * 4 + j]; const int e = gq * 4 + j;
                    if (v > v1) { v2 = v1; e2 = e1; s2 = s1; v1 = v; e1 = e; s1 = s; } else if (v > v2) { v2 = v; e2 = e; s2 = s; } } }
            const float den = s1 + s2;
            texp[n * 2] = e1; texp[n * 2 + 1] = e2; tw[n * 2] = s1 / den; tw[n * 2 + 1] = s2 / den;
            tpos[n * 2] = (int)__hip_atomic_fetch_add(lcnt + e1, 1u, __ATOMIC_RELAXED, __HIP_MEMORY_SCOPE_WORKGROUP);
            tpos[n * 2 + 1] = (int)__hip_atomic_fetch_add(lcnt + e2, 1u, __ATOMIC_RELAXED, __HIP_MEMORY_SCOPE_WORKGROUP);
        }
    }
    __syncthreads();
    if (F.tid < NE) { const unsigned c = lcnt[F.tid]; lcnt[16 + F.tid] = c ? __hip_atomic_fetch_add(cnt + F.tid, c, __ATOMIC_RELAXED, __HIP_MEMORY_SCOPE_AGENT) : 0u; }
    __syncthreads();
    for (int n4 = (F.bid * NWAVE + F.wave) * 4; n4 < NTOK; n4 += F.G * NWAVE * 4)
        if (F.lane < 8) { const int i = (n4 + (F.lane >> 1)) * 2 + (F.lane & 1); const int e = texp[i], p = tpos[i] + (int)lcnt[16 + e]; tpos[i] = p; e2t[e * 16384 + p] = i >> 1; }
}
constexpr int PH_PER_LAYER = 14, N_PHASES = 1 + DEPTH * PH_PER_LAYER + 1;
#define KIND(k) ((k) == 0 ? 0 : ((k) == N_PHASES - 1 ? PH_PER_LAYER + 1 : (((k) - 1) % PH_PER_LAYER) + 1))
#define IN(k) ((KSEL < 0 || KIND(k) == KSEL) && lo <= (k) && (k) < hi)
#define SEAM(k) do { if (IN(k) && IN((k) + 1)) { XcdBarrier b2_ = bar; unsigned* q_ = b2_.bar; unsigned x_ = b2_.x; asm volatile("" : "+s"(q_), "+s"(x_)); b2_.bar = q_; b2_.x = x_; xcd_barrier(b2_); } } while (0)
#define FRESH() do { int t_ = threadIdx.x; asm volatile("" : "+v"(t_)); F.tid = t_; F.lane = t_ & 63; F.wave = __builtin_amdgcn_readfirstlane(t_ >> 6); \
        const CAS Params* k_ = (const CAS Params*)__builtin_amdgcn_kernarg_segment_ptr(); asm volatile("" : "+s"(k_)); F.p = k_; \
        GAS unsigned char* w_ = (GAS unsigned char*)k_->ws; asm volatile("" : "+s"(w_)); F.ws = (unsigned char*)w_; int b_ = blockIdx.x; asm volatile("" : "+s"(b_)); F.bid = b_; int g_ = gridDim.x; asm volatile("" : "+s"(g_)); F.G = g_; } while (0)

template <int KSEL, int l>
__device__ __forceinline__ void layer_phases(Frame& F, const XcdBarrier& bar, const int lo, const int hi) {
    constexpr int pb = 1 + PH_PER_LAYER * l;
        if (IN(pb + 0)) { FRESH(); if (l == 0) { phase_norm<false, true>(F, 0, 0); FRESH(); phase_convert_weights(F); } else phase_norm<true, true>(F, l, l - 1); }
        SEAM(pb + 0);
        if (IN(pb + 1)) { FRESH();
            pg8::Gemm g{(const bf16*)(F.ws + WS_H), F.lw(l, LW_WIN1), D}; pg8::StaticOrder S; S.init(NTOK, N1P, F.G, F.bid);
            pg8::EpiBf16<0> E{(bf16*)(F.ws + WS_P1), N1P, F.in(I_BIN) + (size_t)l * INC};
            pg8::gemm_phase(F.lds, g, S, E, F.tid);
        }
        SEAM(pb + 1);
        if (IN(pb + 2)) { FRESH(); phase_prep(F, l); }
        SEAM(pb + 2);
        if (IN(pb + 3)) { FRESH(); phase_compress(F, l); FRESH(); phase_rw1(F, l); }
        SEAM(pb + 3);
        if (IN(pb + 5)) { FRESH(); phase_mix(F, l, 0); }
        SEAM(pb + 5);
        if (IN(pb + 6)) { FRESH(); phase_rw3(F, l); }
        SEAM(pb + 6);
        if (IN(pb + 7)) { FRESH();
            pg8::Gemm g{(const bf16*)(F.ws + WS_H), F.lw(l, LW_WM), D}; pg8::MergePairOrder S; S.base.init(NTOK, D, F.G, F.bid);
            pg8::EpiBf16<1> E{(bf16*)(F.ws + WS_PM), NMRG, F.in(I_BIN) + (size_t)l * INC + N1};
            pg8::gemm_phase(F.lds, g, S, E, F.tid);
        }
        if (IN(pb + 8)) { FRESH();
            static_assert(WS_YB == WS_YA + (size_t)NTOK * RW * 2 && LW_UPB == LW_UPA + (size_t)D * RW * 2, "y_b follows y_a, W_up_nsa follows W_up_rwkv");
            pg8::UpPairOrder S; S.base.init(NTOK, D, F.G, F.bid);
            pg8::Gemm g{(const bf16*)(F.ws + WS_YA), F.lw(l, LW_UPA), RW}; pg8::EpiUpPair E{(const bf16*)(F.ws + WS_PM), (bf16*)(F.ws + WS_MIX)};
            pg8::gemm_phase(F.lds, g, S, E, F.tid);
        }
        SEAM(pb + 8);
        if (IN(pb + 9)) { FRESH();
            pg8::Gemm g{(const bf16*)(F.ws + WS_MIX), F.lw(l, LW_OUT), D}; pg8::StaticOrder S; S.init(NTOK, D, F.G, F.bid);
            pg8::EpiOut E{l == 0 ? F.in(I_X) : (const float*)F.outp(), (bf16*)(F.ws + WS_XR), F.modp(l, 0) + 2048};
            pg8::gemm_phase(F.lds, g, S, E, F.tid);
        }
        SEAM(pb + 9);
        if (IN(pb + 10)) { FRESH(); phase_router(F, l); __syncthreads(); FRESH(); convert_experts(F, l); }
        SEAM(pb + 10);
        if (IN(pb + 12)) { FRESH(); const LAS int* tb = moe_tables(F, l);
            pg8::Gemm g{(const bf16*)(F.ws + WS_H), (const bf16*)(F.ws + WS_WGU), D}; pg8::MoeOrder S{tb, F.G, F.bid, (const int*)(F.ws + WS_E2T)};
            pg8::EpiGateUp E{(bf16*)(F.ws + WS_ACT)};
            pg8::gemm_phase<pg8::EpiGateUp, pg8::MoeOrder, true, true, true>(F.lds, g, S, E, F.tid);
        }
        SEAM(pb + 12);
        if (IN(pb + 13)) { FRESH(); const LAS int* tb = moe_tables(F, l);
            pg8::Gemm g{(const bf16*)(F.ws + WS_ACT), (const bf16*)(F.ws + WS_WD), DE}; pg8::MoeOrder S{tb, F.G, F.bid, (const int*)(F.ws + WS_E2T)};
            pg8::EpiBf16<0> E{(bf16*)(F.ws + WS_YBS), D, nullptr};
            pg8::gemm_phase(F.lds, g, S, E, F.tid);
        }
        SEAM(pb + 13);
    }

template <int KSEL>
__global__ void __launch_bounds__(NTHR, 2) mk_fwd(Params prm) {
    extern __shared__ __attribute__((aligned(16))) unsigned char lds_raw[];
    Frame F; F.p = (const CAS Params*)__builtin_amdgcn_kernarg_segment_ptr(); F.lds = (LAS unsigned char*)lds_raw; F.ws = F.p->ws; F.tid = threadIdx.x; F.lane = F.tid & 63; F.wave = __builtin_amdgcn_readfirstlane(F.tid >> 6); F.G = gridDim.x; F.bid = blockIdx.x;
    if (F.tid < 64) ((LAS unsigned*)(F.lds + LDS_MISC))[F.tid] = 0u;
    __syncthreads();
    const int lo = F.p->ph_lo, hi = F.p->ph_hi;
    XcdBarrier bar; bar.bar = (unsigned*)(F.ws + WS_CTL) + CW_BAR + F.p->li * XCD_BAR_WORDS; bar.x = 0; bar.st = (volatile LAS unsigned*)(F.lds + LDS_MISC);
    if (hi - lo > 1) bar = xcd_barrier_post((unsigned*)(F.ws + WS_CTL) + CW_BAR + F.p->li * XCD_BAR_WORDS, (volatile LAS unsigned*)(F.lds + LDS_MISC));
    if (IN(0)) { FRESH(); phase_prologue(F); }
    SEAM(0);
    layer_phases<KSEL, 0>(F, bar, lo, hi);
    layer_phases<KSEL, 1>(F, bar, lo, hi);
    if (IN(N_PHASES - 1)) { FRESH(); phase_norm<true, false>(F, 0, DEPTH - 1); }

}

#if MK_N_LAUNCHES == 1
static hipError_t set_lds_attr() { return hipFuncSetAttribute((const void*)mk_fwd<-1>, hipFuncAttributeMaxDynamicSharedMemorySize, LDS_BYTES); }
#else
template <int K> static hipError_t set_lds_attr_k() { hipError_t e = hipFuncSetAttribute((const void*)mk_fwd<K>, hipFuncAttributeMaxDynamicSharedMemorySize, LDS_BYTES); if (e != hipSuccess) return e; if constexpr (K > 0) return set_lds_attr_k<K - 1>(); else return hipSuccess; }
static hipError_t set_lds_attr() { return set_lds_attr_k<PH_PER_LAYER + 1>(); }
template <int K> static void launch_kind_k(int kind, int grid, hipStream_t stream, const Params& p) {
    if (kind == K) { hipLaunchKernelGGL(mk_fwd<K>, dim3(grid), dim3(NTHR), LDS_BYTES, stream, p); return; }
    if constexpr (K > 0) launch_kind_k<K - 1>(kind, grid, stream, p);
}
static void launch_kind(int kind, int grid, hipStream_t stream, const Params& p) { launch_kind_k<PH_PER_LAYER + 1>(kind, grid, stream, p); }
#endif
extern "C" void kernel_launch(void* const* d_in, const int* in_sizes, int n_in, void* d_out, int out_size, void* d_ws, size_t ws_size, hipStream_t stream) {
    static int grid = 0;
    if (grid == 0) {
        if (n_in != 30 || in_sizes[0] != NTOK * D || out_size != NTOK * D || ws_size < WS_END) {
            fprintf(stderr, "kernel_launch: unexpected problem: n_in %d in0 %d out %d ws %zu (need %zu); nothing launched\n", n_in, n_in > 0 ? in_sizes[0] : -1, out_size, ws_size, (size_t)WS_END); grid = -1; return; }
        int dev = 0, cus = 0;
        if (hipGetDevice(&dev) != hipSuccess || hipDeviceGetAttribute(&cus, hipDeviceAttributeMultiprocessorCount, dev) != hipSuccess) { grid = -1; return; }
        if (set_lds_attr() != hipSuccess) { fprintf(stderr, "kernel_launch: hipFuncSetAttribute failed\n"); grid = -1; return; }
        (void)hipGetLastError();
        grid = cus;
    }
    if (grid < 0) return;
    (void)hipMemsetAsync((char*)d_ws + WS_CTL, 0, CTL_BYTES, stream);
    Params p{};
    for (int i = 0; i < 30; ++i) p.in[i] = (const float*)d_in[i];
    p.out = (float*)d_out; p.ws = (unsigned char*)d_ws;
#if MK_N_LAUNCHES == 1
#ifdef MK_CUTS
    { const int cuts[] = {0, MK_CUTS, N_PHASES}; const int nc = (int)(sizeof(cuts) / sizeof(int));
      for (int i = 0; i + 1 < nc; ++i) { p.ph_lo = cuts[i]; p.ph_hi = cuts[i + 1]; p.li = i; hipLaunchKernelGGL(mk_fwd<-1>, dim3(grid), dim3(NTHR), LDS_BYTES, stream, p); } }
#else
    p.ph_lo = 0; p.ph_hi = N_PHASES;
    hipLaunchKernelGGL(mk_fwd<-1>, dim3(grid), dim3(NTHR), LDS_BYTES, stream, p);
#endif
#else
    for (int k = 0; k < N_PHASES; ++k) { p.ph_lo = k; p.ph_hi = k + 1; launch_kind(KIND(k), grid, stream, p); }
#endif
}
```

```cpp
#include <hip/hip_runtime.h>
#include <cstdio>
#include <cstdint>

#ifndef MK_N_LAUNCHES
#define MK_N_LAUNCHES 1
#endif

#define LAS __attribute__((address_space(3)))
typedef unsigned short bf16;
typedef short bf16x8 __attribute__((ext_vector_type(8)));
typedef short bf16x4 __attribute__((ext_vector_type(4)));
typedef float f32x4 __attribute__((ext_vector_type(4)));
typedef float f32x16 __attribute__((ext_vector_type(16)));
typedef float f32x2 __attribute__((ext_vector_type(2)));
typedef unsigned u32x4 __attribute__((ext_vector_type(4)));
typedef unsigned u32x2 __attribute__((ext_vector_type(2)));

constexpr int NB = 2, T = 8192, D = 1024, NTOK = NB * T, DEPTH = 2;
constexpr int RW = 512, RCOLS = 1792;
constexpr int QOFF = 1792, KVOFF = 2304, GOFF = 3072;
constexpr int N1 = 3096, N1P = 3072;
constexpr int NMRG = 2048, INC = 5144;
constexpr int NE = 16, DE = 512, NSLOT = 36864;
constexpr int NCMP = 511, NCMPP = 512;

constexpr size_t MiB = 1u << 20;
constexpr size_t WS_CTL = 0, CTL_BYTES = 1 * MiB;
constexpr size_t WS_SMALL = 1 * MiB;
constexpr size_t SM_MOD = 0;
constexpr size_t SM_ROPE = 128 * 1024;
constexpr size_t SM_CMPB = 704 * 1024;
constexpr size_t SM_BLK = 720 * 1024;
constexpr size_t SM_S2T = 768 * 1024;
constexpr size_t WS_TOK = 2 * MiB;
constexpr size_t WS_W = 3 * MiB;
constexpr size_t LW_WIN1 = 0;
constexpr size_t LW_WM = LW_WIN1 + (size_t)N1P * D * 2;
constexpr size_t LW_UPA = LW_WM + (size_t)NMRG * D * 2;
constexpr size_t LW_UPB = LW_UPA + (size_t)D * RW * 2;
constexpr size_t LW_OUT = LW_UPB + (size_t)D * RW * 2;
constexpr size_t LW_C1 = LW_OUT + (size_t)D * D * 2;
constexpr size_t LW_C2 = LW_C1 + (size_t)2 * 256 * 2048 * 2;
constexpr size_t LW_L2 = LW_C2 + (size_t)2 * 64 * 256 * 2;
constexpr size_t LW_A2 = LW_L2 + (size_t)512 * 64 * 2;
constexpr size_t LW_G2 = LW_A2 + (size_t)512 * 64 * 2;
constexpr size_t LW_WG = LW_G2 + (size_t)512 * 128 * 2;
constexpr size_t LW_BYTES = ((LW_WG + (size_t)64 * 1024 * 2 + MiB - 1) / MiB) * MiB;
constexpr size_t WS_H = WS_W + 2 * LW_BYTES;
constexpr size_t WS_R = WS_H + 32 * MiB;
constexpr size_t WS_P1 = WS_R;
constexpr size_t WS_RW = WS_R + 104 * MiB;
constexpr size_t RWT = (size_t)NTOK * RW * 2;
constexpr size_t WS_NSA = WS_RW + 128 * MiB;
constexpr size_t NS_Q = WS_NSA;
constexpr size_t KVT = (size_t)4 * T * 64 * 2;
constexpr size_t NS_KS = NS_Q + 16 * MiB, NS_KW = NS_KS + KVT, NS_VST = NS_KW + KVT, NS_VWT = NS_VST + KVT, NS_KC = NS_VWT + KVT, NS_VC = NS_KC + KVT;
constexpr size_t NS_KCMP = NS_VC + KVT;
constexpr size_t NS_VCMPT = NS_KCMP + (size_t)4 * 512 * 64 * 2;
constexpr size_t NS_GATE = NS_VCMPT + (size_t)4 * 512 * 64 * 2;
constexpr size_t NS_END = NS_GATE + (size_t)NTOK * 24 * 4;
constexpr size_t WS_Y = WS_R;
constexpr size_t WS_YA = WS_R + 32 * MiB, WS_YB = WS_YA + 16 * MiB;
constexpr size_t WS_WN = WS_R + 64 * MiB;
constexpr size_t WS_UPN = WS_R + 80 * MiB;
constexpr size_t WS_GC = WS_R + 96 * MiB;
constexpr size_t WS_PT = WS_R;
constexpr size_t WS_S0 = WS_RW + 48 * MiB;
constexpr size_t WS_PM = WS_R + 64 * MiB;
constexpr size_t WS_TMP = WS_R + 128 * MiB;
constexpr size_t WS_MIX = WS_R + 160 * MiB;
constexpr size_t WS_E2T = WS_R + 32 * MiB;
constexpr size_t WS_XR = WS_R;
constexpr size_t WS_XB = WS_H;
constexpr size_t WS_ACT = WS_XB + 72 * MiB;
constexpr size_t WS_YBS = WS_ACT + 36 * MiB;
constexpr size_t WS_WGU = WS_YBS + 72 * MiB;
constexpr size_t WS_WD = WS_WGU + 32 * MiB;
constexpr size_t WS_END_MOE = WS_WD + 16 * MiB;
constexpr size_t WS_END = (NS_END > WS_END_MOE ? NS_END : WS_END_MOE);
static_assert(WS_MIX + 32 * MiB <= WS_NSA + 64 * MiB, "map");
static_assert(WS_END <= 370 * MiB, "workspace too large");

constexpr int CW_QUEUE = 256;
constexpr int CW_CNT = 512;
constexpr int CW_BAR = 4096;

typedef __bf16 bf16x2_h __attribute__((ext_vector_type(2)));
__device__ __forceinline__ unsigned pk2(float lo, float hi) { const f32x2 v = {lo, hi}; const bf16x2_h b = __builtin_convertvector(v, bf16x2_h); return __builtin_bit_cast(unsigned, b); }
__device__ __forceinline__ unsigned f2bf(float f) { return pk2(f, 0.f) & 0xffffu; }
__device__ __forceinline__ float bf2f(unsigned h) { return __builtin_bit_cast(float, h << 16); }
__device__ __forceinline__ float bflo(unsigned w) { return __builtin_bit_cast(float, w << 16); }
__device__ __forceinline__ float bfhi(unsigned w) { return __builtin_bit_cast(float, w & 0xffff0000u); }
__device__ __forceinline__ float rcpf_(float x) { return __builtin_amdgcn_rcpf(x); }
__device__ __forceinline__ float sigmoidf_(float x) { return rcpf_(1.f + __expf(-x)); }
template <int CTRL> __device__ __forceinline__ float dpp_mov(float v) { return __builtin_bit_cast(float, __builtin_amdgcn_update_dpp(0, __builtin_bit_cast(int, v), CTRL, 0xF, 0xF, true)); }
template <int M> __device__ __forceinline__ float xor_lane(float v) {
    if constexpr (M == 1) return dpp_mov<0xB1>(v); else if constexpr (M == 2) return dpp_mov<0x4E>(v); else return __shfl_xor(v, M, 64);
}
__device__ __forceinline__ float sum_halves(float v) { return v + __shfl_xor(v, 32, 64); }
__device__ __forceinline__ float max_halves(float v) { return fmaxf(v, __shfl_xor(v, 32, 64)); }
__device__ __forceinline__ float other_half(float v, int hi) { return __shfl_xor(v, 32, 64); }
__device__ __forceinline__ float sum8(float v) { v += dpp_mov<0xB1>(v); v += dpp_mov<0x4E>(v); v += dpp_mov<0x141>(v); return v; }
__device__ __forceinline__ float sum16(float v) { v = sum8(v); v += dpp_mov<0x140>(v); return v; }
__device__ __forceinline__ float sum32(float v) { v = sum16(v); v += xor_lane<16>(v); return v; }
__device__ __forceinline__ float sum64(float v) { return sum_halves(sum32(v)); }

#define XB_TMO      128
#define XB_XCNT(j)  (256  + 64 * (j))
#define XB_XSUB(j)  (1280 + 64 * (j))
#define XB_XGEN(j)  (2304 + 64 * (j))
#define XB_TOP      3328
#define XB_TOPGEN   3392
#define XCD_BAR_WORDS 3456
#define XB_SPIN_CAP (1u << 22)
__device__ __forceinline__ unsigned xb_ld(unsigned* p)              { return __hip_atomic_load(p, __ATOMIC_RELAXED, __HIP_MEMORY_SCOPE_AGENT); }
__device__ __forceinline__ unsigned xb_add(unsigned* p, unsigned v) { return __hip_atomic_fetch_add(p, v, __ATOMIC_RELAXED, __HIP_MEMORY_SCOPE_AGENT); }
__device__ __forceinline__ unsigned xb_xcc_id() { return (unsigned)__builtin_amdgcn_s_getreg((3 << 11) | 20) & 0xFu; }
#define XB_SPIN(cond, bar) do { unsigned _sp = 0; while (cond) { __builtin_amdgcn_s_sleep(1); \
    if ((++_sp & 255u) == 0u) { if (xb_ld(&(bar)[XB_TMO])) break; if (_sp > XB_SPIN_CAP) { atomicAdd(&(bar)[XB_TMO], 1u); break; } } } } while (0)
struct XcdBarrier { unsigned* bar; unsigned x; volatile LAS unsigned* st; };
__device__ __forceinline__ XcdBarrier xcd_barrier_post(unsigned* bar, volatile LAS unsigned* st) {
    XcdBarrier b; b.bar = bar; b.x = xb_xcc_id(); b.st = st;
    if (threadIdx.x == 0) (void)xb_add(&bar[XB_XCNT(b.x)], 1u);
    return b;
}
__device__ __forceinline__ void xcd_barrier_complete(unsigned* bar, unsigned x, unsigned& nloc, unsigned& nx) {
    const unsigned G = gridDim.x * gridDim.y * gridDim.z;
    unsigned sum, cnt, mine, sp = 0u;
    for (;;) {
        sum = 0u; cnt = 0u; mine = 0u;
#pragma unroll
        for (unsigned j = 0; j < 16; ++j) { const unsigned c = xb_ld(&bar[XB_XCNT(j)]); sum += c; cnt += (c > 0u) ? 1u : 0u; mine = (j == x) ? c : mine; }
        if (sum == G) break;
        __builtin_amdgcn_s_sleep(1);
        if ((++sp & 255u) == 0u) { if (xb_ld(&bar[XB_TMO])) break; if (sp > XB_SPIN_CAP) { atomicAdd(&bar[XB_TMO], 1u); break; } }
    }
    nloc = mine > 0u ? mine : 1u; nx = cnt > 0u ? cnt : 1u;
}
__device__ __forceinline__ void xcd_barrier(const XcdBarrier& b) {
    asm volatile("s_waitcnt vmcnt(0)" ::: "memory");
    __syncthreads();
    if (threadIdx.x == 0) {
        unsigned* bar = b.bar;
        __builtin_amdgcn_s_waitcnt(0);
        unsigned nloc = b.st[0], nx = b.st[1];
        if (nloc == 0u) { xcd_barrier_complete(bar, b.x, nloc, nx); b.st[0] = nloc; b.st[1] = nx; }
        const unsigned old = xb_add(&bar[XB_XSUB(b.x)], 1u);
        const unsigned gen = old / nloc;
        if (old + 1u == (gen + 1u) * nloc) {
            __builtin_amdgcn_fence(__ATOMIC_RELEASE, "agent");
            asm volatile("s_waitcnt vmcnt(0)" ::: "memory");
            const unsigned og = xb_add(&bar[XB_TOP], 1u);
            const unsigned tg = og / nx;
            if (og + 1u == (tg + 1u) * nx) xb_add(&bar[XB_TOPGEN], 1u);
            else XB_SPIN(xb_ld(&bar[XB_TOPGEN]) == tg, bar);
            __builtin_amdgcn_fence(__ATOMIC_ACQUIRE, "agent");
            xb_add(&bar[XB_XGEN(b.x)], 1u);
            asm volatile("s_waitcnt vmcnt(0)" ::: "memory");
        } else {
            XB_SPIN(xb_ld(&bar[XB_XGEN(b.x)]) == gen, bar);
            __builtin_amdgcn_fence(__ATOMIC_ACQUIRE, "agent");
            asm volatile("s_waitcnt vmcnt(0)" ::: "memory");
        }
    }
    __syncthreads();
}

namespace pg8 {
#define PG8_LAS __attribute__((address_space(3)))
typedef unsigned short bf16_t;
constexpr int BM = 256, BK = 64, HALF = 128, HTB = HALF * BK * 2, STAGE_BYTES = 8 * HTB, NXCD = 8, WGM = 8;
__host__ __device__ __forceinline__ int lds_byte(int r, int c) { const int st = (r >> 4) * 2 + (c >> 5), rr = r & 15, cc = c & 31, ob = rr * 64 + cc * 2; return st * 1024 + (ob ^ (((ob >> 9) & 1) << 5)); }
__host__ __device__ __forceinline__ void stage_rc(int b, int& R, int& C) { const int st = b / 1024, sb = b % 1024, swz = sb ^ (((sb >> 9) & 1) << 5); R = (st >> 1) * 16 + swz / 64; C = (st & 1) * 32 + (swz % 64) / 2; }
__host__ __device__ __forceinline__ int perm32(int rho) { const int n = rho >> 4, i = rho & 15; return 8 * (i >> 2) + 4 * n + (i & 3); }
struct Unit { int pm, pn, bt, part; };
struct Gemm { const bf16_t* A; const bf16_t* Bt; int K; };
struct StaticOrder {
    int nM, nN, nwg, G, c;
    __device__ void init(int M, int N, int G_, int c_) { nM = M / BM; nN = N / BM; nwg = nM * nN; G = G_; c = c_; }
    __device__ bool next(int i, Unit& u) const {
        const long L = (long)i * G + c; if (L >= nwg) return false;
        int wgid = (int)L; { const int q = nwg / NXCD, r = nwg % NXCD, xcd = wgid % NXCD, off = wgid / NXCD; wgid = (xcd < r ? xcd * (q + 1) : r * (q + 1) + (xcd - r) * q) + off; }
        const int nig = WGM * nN, gid = wgid / nig, fm = gid * WGM, gsz = (nM - fm) < WGM ? (nM - fm) : WGM;
        u.pm = fm + ((wgid % nig) % gsz); u.pn = (wgid % nig) / gsz; u.bt = u.pn; u.part = 1; return true;
    }
};
struct MergePairOrder {
    StaticOrder base;
    __device__ bool next(int i, Unit& u) const { Unit b; if (!base.next(i >> 1, b)) return false; u.pm = b.pm; u.pn = b.pn + 4 * (i & 1); u.bt = u.pn; u.part = 1; return true; }
};
struct UpPairOrder {
    StaticOrder base;
    __device__ bool next(int i, Unit& u) const { Unit b; if (!base.next(i >> 1, b)) return false; const int p = i & 1; u.pm = b.pm + 64 * p; u.pn = b.pn; u.bt = b.pn + 4 * p; u.part = p; return true; }
};
struct MoeOrder {
    const PG8_LAS int* tb; int G, c; const int* e2t;
    __device__ bool next(int i, Unit& u) const {
        const int L = i * G + c; if (L >= tb[0] * 4) return false;
        u.pm = L >> 2; u.pn = L & 3; u.bt = tb[64 + u.pm] * 4 + u.pn; u.part = 1; return true;
    }
    __device__ int row_token(int pm, int r) const {
        const int e = tb[64 + pm], p = (pm - tb[1 + e]) * BM + r;
        return p < tb[17 + e] ? ((const __attribute__((address_space(1))) int*)e2t)[e * 16384 + p] : 0;
    }
};
typedef __bf16 bf16x2_c __attribute__((ext_vector_type(2)));
__device__ __forceinline__ unsigned cvt_pk_bf16(float lo, float hi) { const f32x2 v = {lo, hi}; const bf16x2_c b = __builtin_convertvector(v, bf16x2_c); return __builtin_bit_cast(unsigned, b); }

template <class Epi, class Sched, bool ALIGN_EPI = true, bool SP2 = true, bool GATHER = false>
__device__ __forceinline__ void gemm_phase(PG8_LAS unsigned char* lds, const Gemm g, const Sched& S, const Epi& E, const int tid, const int* rowidx = nullptr) {
    static_assert(!GATHER || SP2, "gather is wired into the SP2 schedule only");
    const int wid = __builtin_amdgcn_readfirstlane(tid >> 6), lane = tid & 63, wr = wid >> 2, wc = wid & 3, fr = lane & 15, fq = lane >> 4;
    const int K = g.K, nt = K / BK;
    unsigned voffA[2], voffB[2]; int rowA[2]; unsigned colA[2];
#pragma unroll
    for (int i = 0; i < 2; ++i) { int R, C; stage_rc(tid * 16 + i * 8192, R, C); const int Rb = Epi::PERM ? ((R & ~31) + perm32(R & 31)) : R;
        voffA[i] = (unsigned)(R * K + C) * 2u; voffB[i] = (unsigned)(Rb * K + C) * 2u; rowA[i] = R; colA[i] = (unsigned)C * 2u; }
    unsigned cvo[2][2], nvo[2][2];
#define PG8_VO(dst, pmv) do { _Pragma("unroll") for (int _h = 0; _h < 2; ++_h) _Pragma("unroll") for (int _i = 0; _i < 2; ++_i) dst[_h][_i] = (unsigned)S.row_token((pmv), _h * HALF + rowA[_i]) * (unsigned)(K * 2) + colA[_i]; } while (0)
#define PG8_VOCP(dst, src) do { _Pragma("unroll") for (int _h = 0; _h < 2; ++_h) _Pragma("unroll") for (int _i = 0; _i < 2; ++_i) dst[_h][_i] = src[_h][_i]; } while (0)
    const size_t kstep = (size_t)(BK * 2);
    const size_t hstep = (size_t)HALF * K * 2;
    const size_t tstep = 2 * hstep;
    const unsigned ldsw = (unsigned)wid * 1024u;
    const int aoff = lds_byte(wr * 64 + fr, fq * 8), boff = lds_byte(wc * 32 + fr, fq * 8);
#define PG8_SA(b, h) (((b) * 2 + (h)) * HTB)
#define PG8_SB(b, h) ((4 + (b) * 2 + (h)) * HTB)
#define PG8_STAGE(bufoff, gbase, voff) do { _Pragma("unroll") for (int _i = 0; _i < 2; ++_i) \
        __builtin_amdgcn_global_load_lds((const unsigned*)((const char*)(gbase) + (voff)[_i]), (PG8_LAS unsigned*)(lds + (bufoff) + ldsw + _i * 8192), 16, 0, 0); } while (0)
#define PG8_STAGE_A(bufoff, kb, h, nx) do { if constexpr (GATHER) { const unsigned vo_[2] = {(nx) ? nvo[h][0] : cvo[h][0], (nx) ? nvo[h][1] : cvo[h][1]}; PG8_STAGE(bufoff, kb, vo_); } \
        else { PG8_STAGE(bufoff, (kb) + (h) * hstep, voffA); } } while (0)
#define PG8_LDA(dst, b, h) do { _Pragma("unroll") for (int m = 0; m < 4; ++m) _Pragma("unroll") for (int k = 0; k < 2; ++k) dst[m][k] = *(const PG8_LAS bf16x8*)(lds + PG8_SA(b, h) + aoff + m * 2048 + k * 1024); } while (0)
#define PG8_LDB(dst, b, h) do { _Pragma("unroll") for (int n = 0; n < 2; ++n) _Pragma("unroll") for (int k = 0; k < 2; ++k) dst[n][k] = *(const PG8_LAS bf16x8*)(lds + PG8_SB(b, h) + boff + n * 2048 + k * 1024); } while (0)
#define PG8_MMA(ai, bj, At, Bt) do { __builtin_amdgcn_s_setprio(1); _Pragma("unroll") for (int m = 0; m < 4; ++m) _Pragma("unroll") for (int n = 0; n < 2; ++n) _Pragma("unroll") for (int k = 0; k < 2; ++k) \
        acc[ai][bj][m][n] = __builtin_amdgcn_mfma_f32_16x16x32_bf16(Bt[n][k], At[m][k], acc[ai][bj][m][n], 0, 0, 0); __builtin_amdgcn_s_setprio(0); } while (0)
#define PG8_WAIT_V(n) asm volatile("s_waitcnt vmcnt(" #n ")" ::: "memory")
#define PG8_WAIT_L(n) asm volatile("s_waitcnt lgkmcnt(" #n ")" ::: "memory")
#define PG8_BAR __builtin_amdgcn_s_barrier()
#define PG8_SCHED __builtin_amdgcn_sched_barrier(0)
    Unit cur, nxt; int ui = 0; bool has_next = false;
    if (!S.next(0, cur)) return;
    if constexpr (GATHER) { PG8_VO(cvo, cur.pm); has_next = S.next(1, nxt); if (has_next) PG8_VO(nvo, nxt.pm); else PG8_VOCP(nvo, cvo); }
    f32x4 acc[2][2][4][2];
#pragma unroll
    for (int a = 0; a < 2; ++a)
#pragma unroll
        for (int b = 0; b < 2; ++b)
#pragma unroll
            for (int m = 0; m < 4; ++m)
#pragma unroll
                for (int n = 0; n < 2; ++n) acc[a][b][m][n] = (f32x4){0.f, 0.f, 0.f, 0.f};
    bf16x8 At[4][2], B0[2][2], B1[2][2];
    const char* cA = (const char*)g.A + (GATHER ? (size_t)0 : (size_t)cur.pm * tstep); const char* cB = (const char*)g.Bt + (size_t)cur.bt * tstep;
    if constexpr (SP2) {
        PG8_STAGE(PG8_SB(0, 0), cB, voffB); PG8_STAGE(PG8_SB(0, 1), cB + hstep, voffB); PG8_STAGE_A(PG8_SA(0, 0), cA, 0, false); PG8_STAGE_A(PG8_SA(0, 1), cA, 1, false);
        if (wr == 1) PG8_BAR;
        PG8_WAIT_V(2); PG8_BAR;
        PG8_STAGE(PG8_SB(1, 0), cB + kstep, voffB); PG8_STAGE_A(PG8_SA(1, 0), cA + kstep, 0, false); PG8_STAGE(PG8_SB(1, 1), cB + hstep + kstep, voffB);
        PG8_WAIT_V(6); PG8_BAR;
    } else {
        PG8_STAGE(PG8_SB(0, 0), cB, voffB); PG8_STAGE(PG8_SA(0, 0), cA, voffA); PG8_STAGE(PG8_SB(0, 1), cB + hstep, voffB); PG8_STAGE(PG8_SA(0, 1), cA + hstep, voffA);
        if (wr == 1) PG8_BAR;
        PG8_WAIT_V(4); PG8_BAR;
        PG8_STAGE(PG8_SB(1, 0), cB + kstep, voffB); PG8_STAGE(PG8_SA(1, 0), cA + kstep, voffA); PG8_STAGE(PG8_SB(1, 1), cB + hstep + kstep, voffB);
        PG8_WAIT_V(6); PG8_BAR;
    }
    for (;;) {
        if constexpr (!GATHER) has_next = S.next(ui + 1, nxt);
        const char* nA = (has_next && !GATHER) ? (const char*)g.A + (size_t)nxt.pm * tstep : cA; const char* nB = has_next ? (const char*)g.Bt + (size_t)nxt.bt * tstep : cB;
        for (int t = 0; t < nt; t += 2) {
            const bool last = (t == nt - 2);
            const char* a1 = cA + (size_t)(t + 1) * kstep;
            const char* a2 = last ? nA : cA + (size_t)(t + 2) * kstep; const char* b2 = last ? nB : cB + (size_t)(t + 2) * kstep;
            const char* a3 = a2 + kstep; const char* b3 = b2 + kstep;
            if constexpr (SP2) {
            PG8_LDB(B0, 0, 0); PG8_LDB(B1, 0, 1); PG8_SCHED; PG8_LDA(At, 0, 0); PG8_STAGE_A(PG8_SA(1, 1), a1, 1, false);
            PG8_WAIT_V(8); PG8_WAIT_L(0); PG8_BAR; PG8_MMA(0, 0, At, B0); PG8_MMA(0, 1, At, B1); PG8_BAR; PG8_SCHED;
            PG8_LDA(At, 0, 1); PG8_STAGE(PG8_SB(0, 0), b2, voffB); PG8_STAGE(PG8_SB(0, 1), b2 + hstep, voffB); PG8_STAGE_A(PG8_SA(0, 0), a2, 0, last);
            PG8_WAIT_V(8); PG8_WAIT_L(0); PG8_BAR; PG8_MMA(1, 0, At, B0); PG8_MMA(1, 1, At, B1); PG8_BAR; PG8_SCHED;
            PG8_LDB(B0, 1, 0); PG8_LDB(B1, 1, 1); PG8_SCHED; PG8_LDA(At, 1, 0); PG8_STAGE_A(PG8_SA(0, 1), a2, 1, last);
            PG8_WAIT_V(8); PG8_WAIT_L(0); PG8_BAR; PG8_MMA(0, 0, At, B0); PG8_MMA(0, 1, At, B1); PG8_BAR; PG8_SCHED;
            PG8_LDA(At, 1, 1); PG8_STAGE(PG8_SB(1, 0), b3, voffB); PG8_STAGE(PG8_SB(1, 1), b3 + hstep, voffB); PG8_STAGE_A(PG8_SA(1, 0), a3, 0, last);
            PG8_WAIT_V(8); PG8_WAIT_L(0); PG8_BAR; PG8_MMA(1, 0, At, B0); PG8_MMA(1, 1, At, B1); PG8_BAR; PG8_SCHED;
            } else {
            PG8_LDB(B0, 0, 0); PG8_SCHED; PG8_LDA(At, 0, 0); PG8_STAGE(PG8_SA(1, 1), a1 + hstep, voffA);
            PG8_WAIT_L(8); PG8_BAR; PG8_WAIT_L(0); PG8_MMA(0, 0, At, B0); PG8_BAR; PG8_SCHED;
            PG8_LDB(B1, 0, 1); PG8_STAGE(PG8_SB(0, 0), b2, voffB);
            PG8_BAR; PG8_WAIT_L(0); PG8_MMA(0, 1, At, B1); PG8_BAR;
            PG8_LDA(At, 0, 1); PG8_STAGE(PG8_SA(0, 0), a2, voffA);
            PG8_BAR; PG8_WAIT_L(0); PG8_MMA(1, 0, At, B0); PG8_BAR; PG8_SCHED;
            PG8_STAGE(PG8_SB(0, 1), b2 + hstep, voffB);
            PG8_WAIT_V(6); PG8_BAR; PG8_MMA(1, 1, At, B1); PG8_BAR;
            PG8_LDB(B0, 1, 0); PG8_SCHED; PG8_LDA(At, 1, 0); PG8_STAGE(PG8_SA(0, 1), a2 + hstep, voffA);
            PG8_WAIT_L(8); PG8_BAR; PG8_WAIT_L(0); PG8_MMA(0, 0, At, B0); PG8_BAR; PG8_SCHED;
            PG8_LDB(B1, 1, 1); PG8_STAGE(PG8_SB(1, 0), b3, voffB);
            PG8_BAR; PG8_WAIT_L(0); PG8_MMA(0, 1, At, B1); PG8_BAR;
            PG8_LDA(At, 1, 1); PG8_STAGE(PG8_SA(1, 0), a3, voffA);
            PG8_BAR; PG8_WAIT_L(0); PG8_MMA(1, 0, At, B0); PG8_BAR; PG8_SCHED;
            PG8_STAGE(PG8_SB(1, 1), b3 + hstep, voffB);
            PG8_WAIT_V(6); PG8_BAR; PG8_MMA(1, 1, At, B1); PG8_BAR;
            }
        }
        Unit nn = nxt; bool has_nn = false; unsigned nnvo[2][2];
        if constexpr (GATHER) { has_nn = has_next && S.next(ui + 2, nn); if (has_nn) PG8_VO(nnvo, nn.pm); else PG8_VOCP(nnvo, nvo); }
        if constexpr (ALIGN_EPI) { if (wr == 0) PG8_BAR; }
        bool keep = false;
        if constexpr (Epi::PAIRED) { if (cur.part == 0) { E.mid(acc, cur, wr, wc, fr, fq); keep = true; } }
        if (!keep) E(acc, cur, wr, wc, fr, fq);
        if (!has_next) break;
        if (!keep) {
#pragma unroll
        for (int a = 0; a < 2; ++a)
#pragma unroll
            for (int b = 0; b < 2; ++b)
#pragma unroll
                for (int m = 0; m < 4; ++m)
#pragma unroll
                    for (int n = 0; n < 2; ++n) acc[a][b][m][n] = (f32x4){0.f, 0.f, 0.f, 0.f};
        }
        cur = nxt; cA = nA; cB = nB; ++ui;
        if constexpr (GATHER) { PG8_VOCP(cvo, nvo); PG8_VOCP(nvo, nnvo); nxt = nn; has_next = has_nn; }
        if constexpr (ALIGN_EPI) { if (wr == 1) PG8_BAR; }
    }
    PG8_WAIT_V(0);
    if constexpr (!ALIGN_EPI) { if (wr == 0) PG8_BAR; }
    PG8_BAR;
#undef PG8_SA
#undef PG8_SB
#undef PG8_STAGE
#undef PG8_LDA
#undef PG8_STAGE_A
#undef PG8_VO
#undef PG8_VOCP
#undef PG8_LDB
#undef PG8_MMA
#undef PG8_WAIT_V
#undef PG8_WAIT_L
#undef PG8_BAR
#undef PG8_SCHED
}

template <int ACT  > struct EpiBf16 {
    static constexpr bool PERM = true, PAIRED = false;
    bf16_t* O; int ldc; const float* bias;
    __device__ __forceinline__ void operator()(const f32x4 (&acc)[2][2][4][2], const Unit& u, int wr, int wc, int fr, int fq) const {
        const int row0 = u.pm * BM + wr * 64 + fr; const int col0 = u.pn * BM + wc * 32 + 8 * fq;
        f32x4 bv[2][2];
#pragma unroll
        for (int bj = 0; bj < 2; ++bj)
#pragma unroll
            for (int n = 0; n < 2; ++n) bv[bj][n] = bias ? *(const f32x4*)(bias + col0 + bj * HALF + 4 * n) : (f32x4){0.f, 0.f, 0.f, 0.f};
#pragma unroll
        for (int ai = 0; ai < 2; ++ai)
#pragma unroll
            for (int m = 0; m < 4; ++m) { bf16_t* rowp = O + (size_t)(row0 + ai * HALF + m * 16) * ldc + col0;
#pragma unroll
                for (int bj = 0; bj < 2; ++bj) { f32x4 v0 = acc[ai][bj][m][0] + bv[bj][0], v1 = acc[ai][bj][m][1] + bv[bj][1];
                    if (ACT == 1) {
#pragma unroll
                        for (int j = 0; j < 4; ++j) { v0[j] = __builtin_amdgcn_rcpf(1.f + __expf(-v0[j])); v1[j] = __builtin_amdgcn_rcpf(1.f + __expf(-v1[j])); } }
                    u32x4 w; w.x = cvt_pk_bf16(v0[0], v0[1]); w.y = cvt_pk_bf16(v0[2], v0[3]); w.z = cvt_pk_bf16(v1[0], v1[1]); w.w = cvt_pk_bf16(v1[2], v1[3]);
                    *(u32x4*)(rowp + bj * HALF) = w; } }
    }
};
template <int MODE> struct EpiUp {
    static constexpr bool PERM = true, PAIRED = false;
    const bf16_t* PMg; bf16_t* TMP; bf16_t* MIX;
    __device__ __forceinline__ void operator()(const f32x4 (&acc)[2][2][4][2], const Unit& u, int wr, int wc, int fr, int fq) const {
        const int row0 = u.pm * BM + wr * 64 + fr; const int col0 = u.pn * BM + wc * 32 + 8 * fq;
#pragma unroll
        for (int ai = 0; ai < 2; ++ai)
#pragma unroll
            for (int m = 0; m < 4; ++m) { const size_t row = (size_t)(row0 + ai * HALF + m * 16);
#pragma unroll
                for (int bj = 0; bj < 2; ++bj) { const int col = col0 + bj * HALF;
                    const u32x4 gw = *(const u32x4*)(PMg + row * NMRG + (MODE ? 1024 : 0) + col);
                    float gt[8] = {bflo(gw.x), bfhi(gw.x), bflo(gw.y), bfhi(gw.y), bflo(gw.z), bfhi(gw.z), bflo(gw.w), bfhi(gw.w)};
                    float v[8];
#pragma unroll
                    for (int j = 0; j < 4; ++j) { v[j] = acc[ai][bj][m][0][j] * gt[j]; v[4 + j] = acc[ai][bj][m][1][j] * gt[4 + j]; }
                    if (MODE == 1) { const u32x4 tw = *(const u32x4*)(TMP + row * D + col);
                        v[0] += bflo(tw.x); v[1] += bfhi(tw.x); v[2] += bflo(tw.y); v[3] += bfhi(tw.y); v[4] += bflo(tw.z); v[5] += bfhi(tw.z); v[6] += bflo(tw.w); v[7] += bfhi(tw.w); }
                    u32x4 w; w.x = cvt_pk_bf16(v[0], v[1]); w.y = cvt_pk_bf16(v[2], v[3]); w.z = cvt_pk_bf16(v[4], v[5]); w.w = cvt_pk_bf16(v[6], v[7]);
                    *(u32x4*)((MODE ? MIX : TMP) + row * D + col) = w; } }
    }
};
struct EpiUpPair {
    static constexpr bool PERM = true, PAIRED = true;
    const bf16_t* PMg; bf16_t* MIX;
    __device__ __forceinline__ void mid(f32x4 (&acc)[2][2][4][2], const Unit& u, int wr, int wc, int fr, int fq) const {
        const int row0 = u.pm * BM + wr * 64 + fr; const int col0 = u.pn * BM + wc * 32 + 8 * fq;
#pragma unroll
        for (int ai = 0; ai < 2; ++ai)
#pragma unroll
            for (int m = 0; m < 4; ++m) { const size_t row = (size_t)(row0 + ai * HALF + m * 16);
#pragma unroll
                for (int bj = 0; bj < 2; ++bj) { const int col = col0 + bj * HALF;
                    const u32x4 ga = *(const u32x4*)(PMg + row * NMRG + col), gb = *(const u32x4*)(PMg + row * NMRG + 1024 + col);
                    const float na[8] = {bflo(ga.x), bfhi(ga.x), bflo(ga.y), bfhi(ga.y), bflo(ga.z), bfhi(ga.z), bflo(ga.w), bfhi(ga.w)};
                    const float nb[8] = {bflo(gb.x), bfhi(gb.x), bflo(gb.y), bfhi(gb.y), bflo(gb.z), bfhi(gb.z), bflo(gb.w), bfhi(gb.w)};
#pragma unroll
                    for (int j = 0; j < 4; ++j) { acc[ai][bj][m][0][j] *= na[j] * __builtin_amdgcn_rcpf(nb[j]); acc[ai][bj][m][1][j] *= na[4 + j] * __builtin_amdgcn_rcpf(nb[4 + j]); } } }
    }
    __device__ __forceinline__ void operator()(const f32x4 (&acc)[2][2][4][2], const Unit& u, int wr, int wc, int fr, int fq) const {
        const int row0 = (u.pm - 64) * BM + wr * 64 + fr; const int col0 = u.pn * BM + wc * 32 + 8 * fq;
#pragma unroll
        for (int ai = 0; ai < 2; ++ai)
#pragma unroll
            for (int m = 0; m < 4; ++m) { const size_t row = (size_t)(row0 + ai * HALF + m * 16);
#pragma unroll
                for (int bj = 0; bj < 2; ++bj) { const int col = col0 + bj * HALF;
                    const u32x4 gb = *(const u32x4*)(PMg + row * NMRG + 1024 + col);
                    const float nb[8] = {bflo(gb.x), bfhi(gb.x), bflo(gb.y), bfhi(gb.y), bflo(gb.z), bfhi(gb.z), bflo(gb.w), bfhi(gb.w)};
                    u32x4 w; w.x = cvt_pk_bf16(acc[ai][bj][m][0][0] * nb[0], acc[ai][bj][m][0][1] * nb[1]); w.y = cvt_pk_bf16(acc[ai][bj][m][0][2] * nb[2], acc[ai][bj][m][0][3] * nb[3]);
                    w.z = cvt_pk_bf16(acc[ai][bj][m][1][0] * nb[4], acc[ai][bj][m][1][1] * nb[5]); w.w = cvt_pk_bf16(acc[ai][bj][m][1][2] * nb[6], acc[ai][bj][m][1][3] * nb[7]);
                    *(u32x4*)(MIX + row * D + col) = w; } }
    }
};
struct EpiOut {
    static constexpr bool PERM = true, PAIRED = false;
    const float* Xin; bf16_t* Xout; const float* gate;
    __device__ __forceinline__ void operator()(const f32x4 (&acc)[2][2][4][2], const Unit& u, int wr, int wc, int fr, int fq) const {
        const int row0 = u.pm * BM + wr * 64 + fr, col0 = u.pn * BM + wc * 32 + 8 * fq;
        const float* gp = gate + (size_t)((u.pm * BM) / T) * 6144;
        f32x4 gv[2][2];
#pragma unroll
        for (int bj = 0; bj < 2; ++bj)
#pragma unroll
            for (int n = 0; n < 2; ++n) gv[bj][n] = *(const f32x4*)(gp + col0 + bj * HALF + n * 4);
#pragma unroll
        for (int ai = 0; ai < 2; ++ai)
#pragma unroll
            for (int m = 0; m < 4; ++m) { const size_t ro = (size_t)(row0 + ai * HALF + m * 16) * D + col0;
#pragma unroll
                for (int bj = 0; bj < 2; ++bj) {
                    const f32x4 r0 = *(const f32x4*)(Xin + ro + bj * HALF) + gv[bj][0] * acc[ai][bj][m][0], r1 = *(const f32x4*)(Xin + ro + bj * HALF + 4) + gv[bj][1] * acc[ai][bj][m][1];
                    u32x4 w; w.x = cvt_pk_bf16(r0[0], r0[1]); w.y = cvt_pk_bf16(r0[2], r0[3]); w.z = cvt_pk_bf16(r1[0], r1[1]); w.w = cvt_pk_bf16(r1[2], r1[3]);
                    *(u32x4*)(Xout + ro + bj * HALF) = w; } }
    }
};
struct EpiGateUp {
    static constexpr bool PERM = true, PAIRED = false;
    bf16_t* ACT;
    __device__ __forceinline__ void operator()(const f32x4 (&acc)[2][2][4][2], const Unit& u, int wr, int wc, int fr, int fq) const {
        const int row0 = u.pm * BM + wr * 64 + fr; const int col0 = u.pn * HALF + wc * 32 + 8 * fq;
#pragma unroll
        for (int ai = 0; ai < 2; ++ai)
#pragma unroll
            for (int m = 0; m < 4; ++m) { bf16_t* rowp = ACT + (size_t)(row0 + ai * HALF + m * 16) * DE + col0;
                float v[8];
#pragma unroll
                for (int n = 0; n < 2; ++n)
#pragma unroll
                    for (int j = 0; j < 4; ++j) { const float gq = acc[ai][0][m][n][j], uq = acc[ai][1][m][n][j]; v[4 * n + j] = gq * __builtin_amdgcn_rcpf(1.f + __expf(-gq)) * uq; }
                u32x4 w; w.x = cvt_pk_bf16(v[0], v[1]); w.y = cvt_pk_bf16(v[2], v[3]); w.z = cvt_pk_bf16(v[4], v[5]); w.w = cvt_pk_bf16(v[6], v[7]);
                *(u32x4*)rowp = w; }
    }
};
}

constexpr int NTHR = 512, NWAVE = 8;
constexpr int LDS_BYTES = 147456;
constexpr int LDS_MISC = 143360;
struct Params { const float* in[30]; float* out; unsigned char* ws; int ph_lo, ph_hi, li, pad; };
enum { I_X = 0, I_C, I_WADA, I_BADA, I_NORMG, I_WIN, I_BIN, I_MU, I_W0, I_W2, I_A0, I_A2, I_G2, I_KK, I_KA, I_RK, I_GNG, I_GNB, I_QKG, I_CPOS, I_CW1, I_CW2, I_UPA, I_UPB, I_WOUT, I_RTW, I_RTB, I_EG, I_EU, I_ED };

#define CAS __attribute__((address_space(4)))
#define GAS __attribute__((address_space(1)))
template <class T> __device__ __forceinline__ T* as_global(T* p) { return (T*)(GAS T*)p; }
struct Frame {
    const CAS Params* p; LAS unsigned char* lds; unsigned char* ws; int tid, lane, wave, G, bid;
    __device__ __forceinline__ const float* in(int i) const { return as_global(p->in[i]); }
    __device__ __forceinline__ float* outp() const { return as_global(p->out); }
    __device__ __forceinline__ float* modp(int l, int b) const { return (float*)(ws + WS_SMALL + SM_MOD) + ((size_t)l * 2 + b) * 6144; }
    __device__ __forceinline__ bf16* lw(int l, size_t off) const { return (bf16*)(ws + WS_W + (size_t)l * LW_BYTES + off); }
};

__device__ __forceinline__ Frame relaunder(const Frame& F0) {
    Frame F = F0; int t_ = F0.tid; GAS unsigned char* w_ = (GAS unsigned char*)F0.ws; asm volatile("" : "+v"(t_), "+s"(w_)); F.tid = t_; F.lane = t_ & 63; F.wave = __builtin_amdgcn_readfirstlane(t_ >> 6); F.ws = (unsigned char*)w_; return F;
}
template <class RowMap>
__device__ __forceinline__ void xpose_job(const Frame& F, const float* src, int ld, int K, int c0, int nvalid, int npad, bf16* dst, RowMap rm, int& rot) {
    const int kparts = (K >= 512) ? 4 : 1, kspan = K / kparts, kw = kspan >> 3;
    const int nunit = (npad >> 6) * kparts;
    int start = (F.bid + F.G - (rot % F.G)) % F.G;
    for (int t = start; t < nunit; t += F.G) {
        const int kp = t % kparts, n_i = t / kparts;
        const int n = n_i * 64 + F.lane; const bool valid = n < nvalid;
        const float* sp = src + (size_t)(kp * kspan + F.wave * kw) * ld + c0 + n;
        bf16* dp = dst + (size_t)(rm(n_i) + F.lane) * K + kp * kspan + F.wave * kw;
#pragma unroll 2
        for (int k = 0; k < kw; k += 8) {
            float v[8];
#pragma unroll
            for (int j = 0; j < 8; ++j) v[j] = valid ? sp[(size_t)(k + j) * ld] : 0.f;
            u32x4 w; w.x = pk2(v[0], v[1]); w.y = pk2(v[2], v[3]); w.z = pk2(v[4], v[5]); w.w = pk2(v[6], v[7]);
            *(u32x4*)(dp + k) = w;
        }
    }
    rot += nunit;
}
struct RmId { __device__ int operator()(int n_i) const { return n_i * 64; } };
struct RmGate { int up; __device__ int operator()(int n_i) const { return 256 * (n_i >> 1) + 64 * (n_i & 1) + (up ? 128 : 0); } };

__device__ __forceinline__ double sin_poly(double x) {
    const double x2 = x * x; double term = x, sum = x;
#pragma unroll
    for (int k = 1; k <= 14; ++k) { term *= -x2 / (double)((2 * k) * (2 * k + 1)); sum += term; }
    return sum;
}
__device__ __forceinline__ double cos_poly(double x) {
    const double x2 = x * x; double term = 1.0, sum = 1.0;
#pragma unroll
    for (int k = 1; k <= 14; ++k) { term *= -x2 / (double)((2 * k - 1) * (2 * k)); sum += term; }
    return sum;
}

__device__ __forceinline__ void phase_prologue(const Frame& F) {
    const int tid = F.tid, G = F.G, bid = F.bid;
    {
        const double invf[8] = {1.0, 0.19392274474868576, 0.03760603093086393, 0.007292664737217109, 0.001414213562373095, 0.0002742481756762073, 5.318295896944988e-05, 1.031338537721246e-05};
        float* rope = (float*)(F.ws + WS_SMALL + SM_ROPE);
        for (int idx = bid * NTHR + tid; idx < T * 8; idx += G * NTHR) {
            const int t = idx >> 3, i = idx & 7;
            double fr = 1.0;
#pragma unroll
            for (int q = 0; q < 8; ++q) fr = (i == q) ? invf[q] : fr;
            double a = (double)t * fr; double r = a * 0.15915494309189535; r -= __builtin_floor(r + 0.5);
            const double x = r * 6.283185307179586;
            rope[t * 16 + i] = (float)cos_poly(x); rope[t * 16 + 8 + i] = (float)sin_poly(x);
        }
    }
    {
        LAS float* sc = (LAS float*)F.lds;
        LAS float* red = sc + 2048;
        for (int i = tid; i < 2048; i += NTHR) { const float cv = F.in(I_C)[i]; sc[i] = cv / (1.f + __expf(-cv)); }
        __syncthreads();
        for (int u = bid; u < 192; u += G) {
            const int l = u / 96, c0 = (u % 96) * 64, col = c0 + F.lane;
            const float* wp = F.in(I_WADA) + (size_t)l * D * 6144 + col;
            float a0 = 0.f, a1 = 0.f;
            const int kb = F.wave * 128;
#pragma unroll 8
            for (int k = 0; k < 128; ++k) { const float wv = wp[(size_t)(kb + k) * 6144]; a0 += sc[kb + k] * wv; a1 += sc[1024 + kb + k] * wv; }
            red[(F.wave * 2 + 0) * 64 + F.lane] = a0; red[(F.wave * 2 + 1) * 64 + F.lane] = a1;
            __syncthreads();
            if (tid < 128) { const int b = tid >> 6, ln = tid & 63; float s = 0.f;
#pragma unroll
                for (int w = 0; w < 8; ++w) s += red[(w * 2 + b) * 64 + ln];
                F.modp(l, b)[c0 + ln] = s + F.in(I_BADA)[l * 6144 + c0 + ln]; }
            __syncthreads();
        }
    }
    {
        LAS float* red = (LAS float*)F.lds;
        for (int u = bid; u < 16; u += G) {
            const int li = u >> 2, q = u & 3, c = tid & 255, hf = tid >> 8;
            const float* pos = F.in(I_CPOS) + (size_t)li * 2048 + q * 512 + hf * 256;
            const float* w1 = F.in(I_CW1) + (size_t)li * 2048 * 256 + (size_t)(q * 512 + hf * 256) * 256 + c;
            float a = 0.f;
#pragma unroll 8
            for (int j = 0; j < 256; ++j) a += pos[j] * w1[(size_t)j * 256];
            red[tid] = a; __syncthreads();
            if (tid < 256) ((float*)(F.ws + WS_SMALL + SM_CMPB))[(li * 4 + q) * 256 + tid] = red[tid] + red[tid + 256];
            __syncthreads();
        }
    }
}
__device__ __forceinline__ void phase_convert_weights(const Frame& F) {
    int rot = 0;
#pragma unroll 1
    for (int jj = 0; jj < DEPTH * 13; ++jj) {
        const int l = jj / 13, j = jj - l * 13;
        const float* src; int ld, K, c0 = 0, nvalid, npad; bf16* dst;
        if (j == 0)      { src = F.in(I_WIN) + (size_t)l * D * INC; ld = INC; K = D; nvalid = N1P; npad = N1P; dst = F.lw(l, LW_WIN1); }
        else if (j == 1) { src = F.in(I_WIN) + (size_t)l * D * INC; ld = INC; K = D; c0 = N1; nvalid = NMRG; npad = NMRG; dst = F.lw(l, LW_WM); }
        else if (j == 2) { src = F.in(I_UPA) + (size_t)l * RW * D; ld = D; K = RW; nvalid = D; npad = D; dst = F.lw(l, LW_UPA); }
        else if (j == 3) { src = F.in(I_UPB) + (size_t)l * RW * D; ld = D; K = RW; nvalid = D; npad = D; dst = F.lw(l, LW_UPB); }
        else if (j == 4) { src = F.in(I_WOUT) + (size_t)l * D * D; ld = D; K = D; nvalid = D; npad = D; dst = F.lw(l, LW_OUT); }
        else if (j <= 6) { const int i = j - 5; src = F.in(I_CW1) + (size_t)(l * 2 + i) * 2048 * 256; ld = 256; K = 2048; nvalid = 256; npad = 256; dst = F.lw(l, LW_C1) + (size_t)i * 256 * 2048; }
        else if (j <= 8) { const int i = j - 7; src = F.in(I_CW2) + (size_t)(l * 2 + i) * 256 * 64; ld = 64; K = 256; nvalid = 64; npad = 64; dst = F.lw(l, LW_C2) + (size_t)i * 64 * 256; }
        else if (j == 9) { src = F.in(I_W2) + (size_t)l * 64 * RW; ld = RW; K = 64; nvalid = RW; npad = RW; dst = F.lw(l, LW_L2); }
        else if (j == 10) { src = F.in(I_A2) + (size_t)l * 64 * RW; ld = RW; K = 64; nvalid = RW; npad = RW; dst = F.lw(l, LW_A2); }
        else if (j == 11) { src = F.in(I_G2) + (size_t)l * 128 * RW; ld = RW; K = 128; nvalid = RW; npad = RW; dst = F.lw(l, LW_G2); }
        else { src = F.in(I_WIN) + (size_t)l * D * INC; ld = INC; K = D; c0 = N1P; nvalid = 24; npad = 64; dst = F.lw(l, LW_WG); }
        xpose_job(F, src, ld, K, c0, nvalid, npad, dst, RmId{}, rot);
    }
}
__device__ __forceinline__ void convert_experts(const Frame& F, int l) {
    int rot = 0;
    for (int e = 0; e < NE; ++e) {
        bf16* wgu = (bf16*)(F.ws + WS_WGU) + (size_t)e * 1024 * 1024;
        xpose_job(F, F.in(I_EG) + ((size_t)l * NE + e) * D * DE, DE, D, 0, DE, DE, wgu, RmGate{0}, rot);
        xpose_job(F, F.in(I_EU) + ((size_t)l * NE + e) * D * DE, DE, D, 0, DE, DE, wgu, RmGate{1}, rot);
        xpose_job(F, F.in(I_ED) + ((size_t)l * NE + e) * DE * D, D, DE, 0, D, D, (bf16*)(F.ws + WS_WD) + (size_t)e * 1024 * 512, RmId{}, rot);
    }
}

constexpr int LDS_MOETB = LDS_MISC + 1024;
__device__ __forceinline__ LAS int* moe_tables(const Frame& F, int l) {
    LAS int* tb = (LAS int*)(F.lds + LDS_MOETB);
    if (F.tid < NE) tb[17 + F.tid] = (int)__hip_atomic_load((const unsigned*)(F.ws + WS_CTL) + CW_CNT + 64 * l + F.tid, __ATOMIC_RELAXED, __HIP_MEMORY_SCOPE_AGENT);
    __syncthreads();
    if (F.tid == 0) { int nb = 0;
        for (int e = 0; e < NE; ++e) { tb[1 + e] = nb; nb += (tb[17 + e] + 255) >> 8; }
        tb[0] = nb; }
    __syncthreads();
    if (F.tid < tb[0]) { int e = 0;
#pragma unroll
        for (int q = 1; q < NE; ++q) e += (tb[1 + q] <= F.tid) ? 1 : 0;
        tb[64 + F.tid] = e; }
    __syncthreads();
    return tb;
}

template <bool COMBINE, bool NORM, bool FROM_OUT = false>
__device__ __forceinline__ void phase_norm(const Frame& F, int l, int lc) {
    const float* xin = (COMBINE || FROM_OUT) ? F.outp() : F.in(I_X);
    bf16* H = (bf16*)(F.ws + WS_H);
    const int* texp = (const int*)(F.ws + WS_TOK); const int* tpos = (const int*)(F.ws + WS_TOK + 131072); const float* tw = (const float*)(F.ws + WS_TOK + 2 * 131072);
    const LAS int* tb = COMBINE ? moe_tables(F, lc) : nullptr;
    const bf16* yb = (const bf16*)(F.ws + WS_YBS);
    constexpr int RB = COMBINE ? 2 : 4;
    const int rstride = F.G * NWAVE;
    for (int nb = F.bid * NWAVE + F.wave; nb < NTOK; nb += rstride * RB) {
        f32x4 xv[RB][4]; u32x2 y0[RB][4], y1[RB][4]; float w0[RB], w1[RB];
#pragma unroll
        for (int r = 0; r < RB; ++r) { const int n = (nb + r * rstride < NTOK) ? nb + r * rstride : nb;
#pragma unroll
            for (int j = 0; j < 4; ++j) {
                if (COMBINE) { const u32x2 xr = *(const u32x2*)((const bf16*)(F.ws + WS_XR) + (size_t)n * D + 4 * F.lane + 256 * j); xv[r][j] = (f32x4){bflo(xr.x), bfhi(xr.x), bflo(xr.y), bfhi(xr.y)}; }
                else xv[r][j] = *(const f32x4*)(xin + (size_t)n * D + 4 * F.lane + 256 * j); }
            if (COMBINE) { const int s0 = tb[1 + texp[n * 2]] * 256 + tpos[n * 2], s1 = tb[1 + texp[n * 2 + 1]] * 256 + tpos[n * 2 + 1]; w0[r] = tw[n * 2]; w1[r] = tw[n * 2 + 1];
#pragma unroll
                for (int j = 0; j < 4; ++j) { const int c = 4 * F.lane + 256 * j; y0[r][j] = *(const u32x2*)(yb + (size_t)s0 * D + c); y1[r][j] = *(const u32x2*)(yb + (size_t)s1 * D + c); } }
        }
#pragma unroll
        for (int r = 0; r < RB; ++r) { const int n = (nb + r * rstride < NTOK) ? nb + r * rstride : nb; const int b = n / T;
            if (COMBINE) {
                const float* gf = F.modp(lc, b) + 5120;
#pragma unroll
                for (int j = 0; j < 4; ++j) {
                    const int c = 4 * F.lane + 256 * j;
                    const f32x4 gv = *(const f32x4*)(gf + c);
                    xv[r][j][0] += gv[0] * (w0[r] * bflo(y0[r][j].x) + w1[r] * bflo(y1[r][j].x)); xv[r][j][1] += gv[1] * (w0[r] * bfhi(y0[r][j].x) + w1[r] * bfhi(y1[r][j].x));
                    xv[r][j][2] += gv[2] * (w0[r] * bflo(y0[r][j].y) + w1[r] * bflo(y1[r][j].y)); xv[r][j][3] += gv[3] * (w0[r] * bfhi(y0[r][j].y) + w1[r] * bfhi(y1[r][j].y));
                    *(f32x4*)(F.outp() + (size_t)n * D + c) = xv[r][j];
                }
            }
            if (NORM) {
                float ss = 0.f;
#pragma unroll
                for (int j = 0; j < 4; ++j) ss += xv[r][j][0] * xv[r][j][0] + xv[r][j][1] * xv[r][j][1] + xv[r][j][2] * xv[r][j][2] + xv[r][j][3] * xv[r][j][3];
                ss = sum64(ss);
                const float inv = __builtin_amdgcn_rsqf(ss * (1.f / D) + 1e-6f);
                const float* ng = F.in(I_NORMG) + (size_t)(l * 2 + 0) * D; const float* sh = F.modp(l, b); const float* scp = sh + 1024;
#pragma unroll
                for (int j = 0; j < 4; ++j) {
                    const int c = 4 * F.lane + 256 * j;
                    const f32x4 g = *(const f32x4*)(ng + c), s1 = *(const f32x4*)(scp + c), s0 = *(const f32x4*)(sh + c);
                    float o[4];
#pragma unroll
                    for (int q = 0; q < 4; ++q) o[q] = xv[r][j][q] * inv * g[q] * (1.f + s1[q]) + s0[q];
                    u32x2 w; w.x = pk2(o[0], o[1]); w.y = pk2(o[2], o[3]);
                    *(u32x2*)(H + (size_t)n * D + c) = w;
                }
            }
        }
    }
}

__device__ __forceinline__ f32x16 mfma32(bf16x8 a, bf16x8 b, f32x16 c) { return __builtin_amdgcn_mfma_f32_32x32x16_bf16(a, b, c, 0, 0, 0); }
__device__ __forceinline__ f32x16 zero16() { f32x16 z;
#pragma unroll
    for (int q = 0; q < 16; ++q) z[q] = 0.f; return z; }

__device__ __forceinline__ void st_bf(bf16* p, float v) { *p = (bf16)f2bf(v); }
__device__ __forceinline__ float quad_sum(float v) {
    v += __builtin_bit_cast(float, __builtin_amdgcn_update_dpp(0, __builtin_bit_cast(int, v), 0xB1, 0xF, 0xF, true));
    v += __builtin_bit_cast(float, __builtin_amdgcn_update_dpp(0, __builtin_bit_cast(int, v), 0x4E, 0xF, 0xF, true));
    return v;
}
constexpr int PR_STRIDE = 3600, LA_OFF = 33 * PR_STRIDE, LA_STRIDE = 528;
__device__ __forceinline__ void phase_prep(const Frame& F, int l) {
    const int tid = F.tid, lane = F.lane, wave = F.wave, l31 = lane & 31, hi = lane >> 5;
    const bf16* p1 = (const bf16*)(F.ws + WS_P1);
    bf16* rwR = (bf16*)(F.ws + WS_RW); bf16* rwK = rwR + (size_t)NTOK * RW; bf16* rwV = rwK + (size_t)NTOK * RW; bf16* rwKK = rwV + (size_t)NTOK * RW;
    bf16* rwB = rwKK + (size_t)NTOK * RW; bf16* rwG = rwB + (size_t)NTOK * RW; float* rwD = (float*)(F.ws + WS_RW + 96 * MiB);
    const float* mu = F.in(I_MU) + (size_t)l * RCOLS;
    const bf16* w2t = F.lw(l, LW_L2); const bf16* a2t = F.lw(l, LW_A2); const bf16* g2t = F.lw(l, LW_G2);
    const float* rope = (const float*)(F.ws + WS_SMALL + SM_ROPE);
    const float* qkg = F.in(I_QKG) + (size_t)l * 4 * 64;
    bf16* nsQ = (bf16*)(F.ws + NS_Q); bf16* nsKS = (bf16*)(F.ws + NS_KS); bf16* nsKW = (bf16*)(F.ws + NS_KW); bf16* nsVST = (bf16*)(F.ws + NS_VST); bf16* nsVWT = (bf16*)(F.ws + NS_VWT);
    bf16* nsKC = (bf16*)(F.ws + NS_KC); bf16* nsVC = (bf16*)(F.ws + NS_VC); float* nsG = (float*)(F.ws + NS_GATE);
    LAS unsigned char* lds = F.lds;
    for (int u = F.bid; u < NTOK / 32; u += F.G) {
        const int n0 = u * 32, t0 = n0 % T, bb = n0 / T;
        {
            const Frame Fg = relaunder(F); const int tid = Fg.tid, lane = Fg.lane, wave = Fg.wave, l31 = lane & 31, hi = lane >> 5;
            const bf16* Hh = (const bf16*)(Fg.ws + WS_H) + (size_t)(n0 + l31) * D + 128 * wave + hi * 8; const bf16* Wg = Fg.lw(l, LW_WG) + (size_t)l31 * D + 128 * wave + hi * 8;
            float* nsG = (float*)(Fg.ws + NS_GATE);
            f32x16 d = zero16();
#pragma unroll
            for (int ks = 0; ks < 8; ++ks) d = mfma32(*(const bf16x8*)(Hh + ks * 16), *(const bf16x8*)(Wg + ks * 16), d);
            LAS float* part = (LAS float*)lds + wave * 1024;
#pragma unroll
            for (int q = 0; q < 16; ++q) part[(8 * (q >> 2) + 4 * hi + (q & 3)) * 32 + l31] = d[q];
            __syncthreads();
            for (int i = tid; i < 32 * 24; i += NTHR) { const int tl = i / 24, j = i - tl * 24; float a = F.in(I_BIN)[(size_t)l * INC + N1P + j];
#pragma unroll
                for (int w = 0; w < 8; ++w) a += ((const LAS float*)lds)[w * 1024 + tl * 32 + j];
                nsG[(size_t)(n0 + tl) * 24 + j] = sigmoidf_(a); }
            __syncthreads();
        }
        {
            const Frame Fs = relaunder(F); const int tid = Fs.tid; const bf16* p1 = (const bf16*)(Fs.ws + WS_P1);
            u32x4 sv[15];
#pragma unroll
            for (int it = 0; it < 15; ++it) { const int idx = tid + it * NTHR; const int row = idx / 224, ch = idx - row * 224;
                sv[it] = (u32x4){0u, 0u, 0u, 0u};
                if (idx < 33 * 224 && !(row == 0 && t0 == 0)) sv[it] = *(const u32x4*)(p1 + (size_t)(n0 - 1 + row) * N1P + ch * 8); }
#pragma unroll
            for (int it = 0; it < 15; ++it) { const int idx = tid + it * NTHR; const int row = idx / 224, ch = idx - row * 224;
                if (idx < 33 * 224) *(LAS u32x4*)(lds + row * PR_STRIDE + ch * 16) = sv[it]; }
        }
        __syncthreads();
        {
            const int i = lane >> 1, cs = 32 * wave + 16 * (lane & 1);
            const LAS u32x4* cur = (const LAS u32x4*)(lds + (i + 1) * PR_STRIDE + (1536 + cs) * 2); const LAS u32x4* prv = (const LAS u32x4*)(lds + i * PR_STRIDE + (1536 + cs) * 2);
            const u32x4 c0 = cur[0], c1 = cur[1], q0 = prv[0], q1 = prv[1];
            const unsigned cw[8] = {c0.x, c0.y, c0.z, c0.w, c1.x, c1.y, c1.z, c1.w}, pw[8] = {q0.x, q0.y, q0.z, q0.w, q1.x, q1.y, q1.z, q1.w};
            const float* mup = mu + 1536 + cs;
            unsigned ow[8];
#pragma unroll
            for (int jj = 0; jj < 8; ++jj) {
                const f32x2 m2 = *(const f32x2*)(mup + 2 * jj);
                const float ca = bflo(cw[jj]), cb = bfhi(cw[jj]), pa = bflo(pw[jj]), pb = bfhi(pw[jj]);
                const float sa = ca + (pa - ca) * m2[0], sb = cb + (pb - cb) * m2[1];
                float fa, fb;
                if (wave < 2) { fa = 1.f - 2.f * rcpf_(__expf(2.f * sa) + 1.f); fb = 1.f - 2.f * rcpf_(__expf(2.f * sb) + 1.f); }
                else if (wave < 4) { fa = sa; fb = sb; }
                else { fa = sigmoidf_(sa); fb = sigmoidf_(sb); }
                ow[jj] = pk2(fa, fb);
            }
            LAS u32x4* la = (LAS u32x4*)(lds + LA_OFF + i * LA_STRIDE + cs * 2);
            la[0] = (u32x4){ow[0], ow[1], ow[2], ow[3]}; la[1] = (u32x4){ow[4], ow[5], ow[6], ow[7]};
        }
        __syncthreads();
        {
            f32x16 accw[2], acca[2], accg[2];
            int colv = 64 * wave + l31; asm volatile("" : "+v"(colv));
#pragma unroll
            for (int ct = 0; ct < 2; ++ct) {
#pragma unroll
                for (int q = 0; q < 16; ++q) { accw[ct][q] = 0.f; acca[ct][q] = 0.f; accg[ct][q] = 0.f; }
                const int col = colv + 32 * ct;
                const LAS unsigned char* lap = lds + LA_OFF + l31 * LA_STRIDE + hi * 16;
#pragma unroll
                for (int ks = 0; ks < 4; ++ks) {
                    const bf16x8 a1 = *(const LAS bf16x8*)(lap + ks * 32), a2 = *(const LAS bf16x8*)(lap + 128 + ks * 32);
                    const bf16x8 b1 = *(const bf16x8*)(w2t + (size_t)col * 64 + ks * 16 + hi * 8), b2 = *(const bf16x8*)(a2t + (size_t)col * 64 + ks * 16 + hi * 8);
                    accw[ct] = mfma32(a1, b1, accw[ct]); acca[ct] = mfma32(a2, b2, acca[ct]);
                }
#pragma unroll
                for (int ks = 0; ks < 8; ++ks) {
                    const bf16x8 a3 = *(const LAS bf16x8*)(lap + 256 + ks * 32);
                    const bf16x8 b3 = *(const bf16x8*)(g2t + (size_t)col * 128 + ks * 16 + hi * 8);
                    accg[ct] = mfma32(a3, b3, accg[ct]);
                }
            }
            const int col0 = colv;
            float mur[2], muk[2], muv[2], w0[2], a0[2], kkc[2], kac[2];
#pragma unroll
            for (int ct = 0; ct < 2; ++ct) { const int col = col0 + 32 * ct;
                mur[ct] = mu[col]; muk[ct] = mu[512 + col]; muv[ct] = mu[1024 + col];
                w0[ct] = F.in(I_W0)[l * RW + col]; a0[ct] = F.in(I_A0)[l * RW + col]; kkc[ct] = F.in(I_KK)[l * RW + col]; kac[ct] = F.in(I_KA)[l * RW + col]; }
#pragma unroll
            for (int i = 0; i < 16; ++i) {
                const int ti = 8 * (i >> 2) + 4 * hi + (i & 3);
                const LAS bf16* cur = (const LAS bf16*)(lds + (ti + 1) * PR_STRIDE) + col0; const LAS bf16* prv = (const LAS bf16*)(lds + ti * PR_STRIDE) + col0;
                const size_t o = (size_t)(n0 + ti) * RW + col0;
                float kx[2], av[2];
#pragma unroll
                for (int ct = 0; ct < 2; ++ct) {
                    const float rc = bf2f(cur[32 * ct]), rp = bf2f(prv[32 * ct]), kc = bf2f(cur[512 + 32 * ct]), kp = bf2f(prv[512 + 32 * ct]), vc = bf2f(cur[1024 + 32 * ct]), vp = bf2f(prv[1024 + 32 * ct]);
                    const float rs = rc + (rp - rc) * mur[ct], ks_ = kc + (kp - kc) * muk[ct], vs = vc + (vp - vc) * muv[ct];
                    const float z = w0[ct] + accw[ct][i];
                    const float sp = (z < 0.f ? -z : 0.f) + 0.6931471805599453f * __builtin_amdgcn_logf(1.f + __expf(-__builtin_fabsf(z)));
                    const float wlog = -sp - 0.5f;
                    const float dec = -__expf(wlog);
                    const float a = sigmoidf_(a0[ct] + acca[ct][i]);
                    st_bf(rwR + o + 32 * ct, rs); st_bf(rwV + o + 32 * ct, vs); st_bf(rwG + o + 32 * ct, accg[ct][i]); rwD[o + 32 * ct] = dec; st_bf(rwK + o + 32 * ct, ks_ * (1.f + (a - 1.f) * kac[ct]));
                    kx[ct] = ks_ * kkc[ct]; av[ct] = a;
                }
                float ss = kx[0] * kx[0] + kx[1] * kx[1];
                ss = sum32(ss);
                const float inv = fminf(__builtin_amdgcn_rsqf(ss), 1e12f);
#pragma unroll
                for (int ct = 0; ct < 2; ++ct) { const float kk = kx[ct] * inv; st_bf(rwKK + o + 32 * ct, kk); st_bf(rwB + o + 32 * ct, kk * av[ct]); }
            }
        }
        __syncthreads();
        {
            const Frame Fs = relaunder(F); const int tid = Fs.tid, lane = Fs.lane, wave = Fs.wave; const bf16* p1 = (const bf16*)(Fs.ws + WS_P1);
            int u_ = u; asm volatile("" : "+s"(u_)); const int n0 = u_ * 32, t0 = n0 % T, bb = n0 / T;
            bf16* nsQ = (bf16*)(Fs.ws + NS_Q); bf16* nsKS = (bf16*)(Fs.ws + NS_KS); bf16* nsKW = (bf16*)(Fs.ws + NS_KW); bf16* nsVST = (bf16*)(Fs.ws + NS_VST); bf16* nsVWT = (bf16*)(Fs.ws + NS_VWT);
            bf16* nsKC = (bf16*)(Fs.ws + NS_KC); bf16* nsVC = (bf16*)(Fs.ws + NS_VC); const float* rope = (const float*)(Fs.ws + WS_SMALL + SM_ROPE);
            const int lq = lane & 15, sub = lane >> 4;
            LAS bf16* vts = (LAS bf16*)lds;
            const int tl = wave * 4 + sub, n = n0 + tl, t = t0 + tl;
#pragma unroll
            for (int sb = 0; sb < 20; sb += 5) {
            u32x2 raws[5];
#pragma unroll
            for (int s5 = 0; s5 < 5; ++s5) raws[s5] = *(const u32x2*)(p1 + (size_t)n * N1P + QOFF + 64 * (sb + s5) + 4 * lq);
#pragma unroll
            for (int s5 = 0; s5 < 5; ++s5) {
                const int v = sb + s5;
                const u32x2 raw = raws[s5];
                float x[4] = {bflo(raw.x), bfhi(raw.x), bflo(raw.y), bfhi(raw.y)};
                const int g = v & 1;
                const bool isq = v < 8, isks = (v == 12 || v == 13), iskw = (v == 16 || v == 17);
                if (isq || isks || iskw) {
                    float ss = x[0] * x[0] + x[1] * x[1] + x[2] * x[2] + x[3] * x[3];
                    ss = sum16(ss);
                    const float inv = __builtin_amdgcn_rsqf(ss * (1.f / 64.f) + 1e-6f);
                    const float* gw = qkg + (isq ? 0 : (isks ? 128 : 192)) + 4 * lq;
#pragma unroll
                    for (int j = 0; j < 4; ++j) x[j] = x[j] * inv * gw[j];
                    float px[4];
#pragma unroll
                    for (int j = 0; j < 4; ++j) px[j] = xor_lane<2>(x[j]);
                    if (lq < 4) {
                        const float* rp = rope + (size_t)t * 16 + 4 * (lq & 1);
#pragma unroll
                        for (int j = 0; j < 4; ++j) { const float c = rp[j], sn = rp[8 + j]; x[j] = (lq < 2) ? (x[j] * c - px[j] * sn) : (x[j] * c + px[j] * sn); }
                    }
                    if (isq) {
#pragma unroll
                        for (int j = 0; j < 4; ++j) x[j] *= 0.18033688011112042f;
                    }
                    u32x2 w; w.x = pk2(x[0], x[1]); w.y = pk2(x[2], x[3]);
                    if (isq) *(u32x2*)(nsQ + (size_t)n * 512 + 64 * v + 4 * lq) = w;
                    else if (isks) {
                        const size_t off = (size_t)(bb * 2 + g) * T * 64 + (size_t)(t >> 6) * 4096 + (size_t)(((((t >> 5) & 1) * 4 + (lq >> 2)) * 32 + (t & 31)) * 2 + ((lq >> 1) & 1)) * 8 + 4 * (lq & 1);
                        *(u32x2*)(nsKS + off) = w;
                    } else *(u32x2*)(nsKW + ((size_t)(bb * 2 + g) * T + t) * 64 + 4 * lq) = w;
                } else if (v < 12) {
                    *(u32x2*)((v < 10 ? nsKC : nsVC) + ((size_t)(bb * 2 + g) * T + t) * 64 + 4 * lq) = raw;
                } else {
                    const int slot = (v >= 18 ? 2 : 0) + g;
                    LAS bf16* dp = vts + (slot * 64 + 4 * lq) * 40 + tl;
                    dp[0] = (bf16)(raw.x & 0xffffu); dp[40] = (bf16)(raw.x >> 16); dp[80] = (bf16)(raw.y & 0xffffu); dp[120] = (bf16)(raw.y >> 16);
                }
            }
            }
            __syncthreads();
            {
                const int row = tid >> 1, hf = tid & 1, slot = row >> 6, d = row & 63, g = slot & 1;
                const LAS u32x4* sp = (const LAS u32x4*)(vts + row * 40 + hf * 16);
                const u32x4 a = sp[0], b = sp[1];
                if (slot >> 1) { bf16* dst = nsVWT + ((size_t)(bb * 2 + g) * 64 + d) * T + t0 + hf * 16; *(u32x4*)dst = a; *(u32x4*)(dst + 8) = b; }
                else {
                    const int sq = ((t0 >> 5) & 1) * 2 + hf;
                    bf16* dst = nsVST + (size_t)(bb * 2 + g) * 64 * T + (size_t)(t0 >> 6) * 4096 + (size_t)((((d >> 5) * 4 + sq) * 32 + (d & 31)) * 2) * 8;
                    *(u32x4*)dst = (u32x4){a.x, a.y, b.x, b.y}; *(u32x4*)(dst + 8) = (u32x4){a.z, a.w, b.z, b.w};
                }
            }
        }
        __syncthreads();
    }
}

__device__ __forceinline__ float gelu_tanh(float x) { const float u = 0.7978845608028654f * (x + 0.044715f * x * x * x); const float e = __expf(2.f * u); return 0.5f * x * (2.f - 2.f * __builtin_amdgcn_rcpf(e + 1.f)); }
__device__ __forceinline__ void phase_compress(const Frame& F, int l) {
    const int tid = F.tid, lane = F.lane, wave = F.wave, l31 = lane & 31, hi = lane >> 5;
    LAS unsigned char* lds = F.lds;
    LAS bf16* hid = (LAS bf16*)lds;
    LAS float* outl = (LAS float*)(lds + 32 * 528);
    const float* cbp = (const float*)(F.ws + WS_SMALL + SM_CMPB);
    const float* rope = (const float*)(F.ws + WS_SMALL + SM_ROPE);
    const float* qkg1 = F.in(I_QKG) + (size_t)l * 256 + 64;
    for (int u = F.bid; u < 128; u += F.G) {
        const int i = u >> 6, bg = (u >> 4) & 3, rt = u & 15;
        const bf16* src = (const bf16*)(F.ws + (i ? NS_VC : NS_KC)) + (size_t)bg * T * 64;
        const bf16* w1t = F.lw(l, LW_C1) + (size_t)i * 256 * 2048; const bf16* w2t = F.lw(l, LW_C2) + (size_t)i * 64 * 256;
        int nrow = rt * 32 + l31; if (nrow > NCMP - 1) nrow = NCMP - 1;
        const bf16* ap = src + (size_t)nrow * 1024 + hi * 8; const bf16* bp = w1t + (size_t)(32 * wave + l31) * 2048 + hi * 8;
        f32x16 acc;
#pragma unroll
        for (int q = 0; q < 16; ++q) acc[q] = 0.f;
#pragma unroll 8
        for (int ks = 0; ks < 128; ++ks) acc = mfma32(*(const bf16x8*)(ap + ks * 16), *(const bf16x8*)(bp + ks * 16), acc);
        {
            const int col = 32 * wave + l31; const int li = l * 2 + i;
            const float cb = cbp[(li * 4 + 0) * 256 + col] + cbp[(li * 4 + 1) * 256 + col] + cbp[(li * 4 + 2) * 256 + col] + cbp[(li * 4 + 3) * 256 + col];
#pragma unroll
            for (int q = 0; q < 16; ++q) { const int r = 8 * (q >> 2) + 4 * hi + (q & 3); hid[r * 264 + col] = (bf16)f2bf(gelu_tanh(acc[q] + cb)); }
        }
        __syncthreads();
        if (wave < 2) {
            f32x16 o;
#pragma unroll
            for (int q = 0; q < 16; ++q) o[q] = 0.f;
#pragma unroll
            for (int ks = 0; ks < 16; ++ks) o = mfma32(*(const LAS bf16x8*)(hid + l31 * 264 + ks * 16 + hi * 8), *(const bf16x8*)(w2t + (size_t)(32 * wave + l31) * 256 + ks * 16 + hi * 8), o);
#pragma unroll
            for (int q = 0; q < 16; ++q) { const int r = 8 * (q >> 2) + 4 * hi + (q & 3); outl[r * 65 + 32 * wave + l31] = o[q]; }
        }
        __syncthreads();
        if (i == 0) {
            const int r = tid >> 4, lq = tid & 15, n = rt * 32 + r;
            float x[4];
#pragma unroll
            for (int j = 0; j < 4; ++j) x[j] = outl[r * 65 + 4 * lq + j];
            float ss = x[0] * x[0] + x[1] * x[1] + x[2] * x[2] + x[3] * x[3];
            ss = sum16(ss);
            const float inv = __builtin_amdgcn_rsqf(ss * (1.f / 64.f) + 1e-6f);
#pragma unroll
            for (int j = 0; j < 4; ++j) x[j] = x[j] * inv * qkg1[4 * lq + j];
            float px[4];
#pragma unroll
            for (int j = 0; j < 4; ++j) px[j] = xor_lane<2>(x[j]);
            const int pos = (n < NCMP) ? 16 * n + 31 : 0;
            if (lq < 4) {
                const float* rp = rope + (size_t)pos * 16 + 4 * (lq & 1);
#pragma unroll
                for (int j = 0; j < 4; ++j) { const float c = rp[j], sn = rp[8 + j]; x[j] = (lq < 2) ? (x[j] * c - px[j] * sn) : (x[j] * c + px[j] * sn); }
            }
            if (n >= NCMP) { x[0] = x[1] = x[2] = x[3] = 0.f; }
            u32x2 w; w.x = pk2(x[0], x[1]); w.y = pk2(x[2], x[3]);
            *(u32x2*)((bf16*)(F.ws + NS_KCMP) + ((size_t)bg * NCMPP + n) * 64 + 4 * lq) = w;
        } else {
            const int d = tid >> 3, n4 = (tid & 7) * 4;
            float x[4];
#pragma unroll
            for (int j = 0; j < 4; ++j) { const int n = rt * 32 + n4 + j; x[j] = (n < NCMP) ? outl[(n4 + j) * 65 + d] : 0.f; }
            u32x2 w; w.x = pk2(x[0], x[1]); w.y = pk2(x[2], x[3]);
            *(u32x2*)((bf16*)(F.ws + NS_VCMPT) + ((size_t)bg * 64 + d) * NCMPP + rt * 32 + n4) = w;
        }
        __syncthreads();
    }
}

constexpr int T72 = 144;
__device__ __forceinline__ f32x16 mm64(const LAS unsigned char* A, const LAS unsigned char* Bt, int m0, int n0, int l31, int hi, f32x16 acc) {
#pragma unroll
    for (int ks = 0; ks < 4; ++ks) acc = mfma32(*(const LAS bf16x8*)(A + (m0 + l31) * T72 + ks * 32 + hi * 16), *(const LAS bf16x8*)(Bt + (n0 + l31) * T72 + ks * 32 + hi * 16), acc);
    return acc;
}
__device__ __forceinline__ void st_tile_T_bf(LAS unsigned char* dst, const f32x16& d, int m0, int n0, int l31, int hi) {
#pragma unroll
    for (int g = 0; g < 4; ++g) { u32x2 w; w.x = pk2(d[4 * g], d[4 * g + 1]); w.y = pk2(d[4 * g + 2], d[4 * g + 3]); *(LAS u32x2*)(dst + (n0 + l31) * T72 + (m0 + 8 * g + 4 * hi) * 2) = w; }
}
__device__ __forceinline__ void st_tile_T_f32(LAS unsigned char* dst, const f32x16& d, int m0, int n0, int l31, int hi) {
#pragma unroll
    for (int g = 0; g < 4; ++g) *(LAS f32x4*)(dst + (n0 + l31) * 272 + (m0 + 8 * g + 4 * hi) * 4) = (f32x4){d[4 * g], d[4 * g + 1], d[4 * g + 2], d[4 * g + 3]};
}

constexpr int R1_AN = 0, R1_BN = 9216, R1_KN = 18432, R1_BHT = 27648, R1_KHT = 36864, R1_VT = 46080, R1_ATF = 55296, R1_AAB = 72704, R1_AAK = 90112, R1_RHS2 = 99328, R1_TT = 116736, R1_AOFF = 120832;
__device__ __forceinline__ void rw1_unit(const Frame& F, int u) {
    const int tid = F.tid, lane = F.lane, wave = F.wave, l31 = lane & 31, hi = lane >> 5;
    LAS unsigned char* lds = F.lds;
    const int c = u & 127, bh = u >> 7, b = bh >> 3, h = bh & 7;
    const size_t n0 = (size_t)b * T + 64 * c; const int cb = 64 * h;
    const bf16* rwK = (const bf16*)(F.ws + WS_RW) + (size_t)NTOK * RW; const bf16* rwV = rwK + (size_t)NTOK * RW; const bf16* rwKK = rwV + (size_t)NTOK * RW; const bf16* rwB = rwKK + (size_t)NTOK * RW;
    const float* rwD = (const float*)(F.ws + WS_RW + 96 * MiB);
    {
        float ldv[8]; unsigned kkr[8], br[8], kr[8], vr[8];
#pragma unroll
        for (int q = 0; q < 8; ++q) { const size_t o = (n0 + 8 * wave + q) * RW + cb + lane; ldv[q] = rwD[o]; kkr[q] = rwKK[o]; br[q] = rwB[o]; kr[q] = rwK[o]; vr[q] = rwV[o]; }
        float part = 0.f;
#pragma unroll
        for (int q = 0; q < 8; ++q) part += ldv[q];
        LAS float* psum = (LAS float*)(lds + R1_AAB);
        psum[wave * 64 + lane] = part;
        __syncthreads();
        float pre = 0.f, tot = 0.f;
#pragma unroll
        for (int w = 0; w < 8; ++w) { const float x = psum[w * 64 + lane]; if (w < wave) pre += x; tot += x; }
        float cwv = pre, atf[8]; unsigned bh_[8], kh_[8];
#pragma unroll
        for (int q = 0; q < 8; ++q) {
            const int t = 8 * wave + q;
            const float cwx = cwv; cwv += ldv[q];
            const float kkv = bf2f(kkr[q]), bv = bf2f(br[q]), kv = bf2f(kr[q]);
            const float ex = __expf(cwx), em = __expf(-cwv), eh = __expf(tot - cwv);
            const float an = -kkv * ex;
            *(LAS bf16*)(lds + R1_AN + t * T72 + lane * 2) = (bf16)f2bf(an);
            *(LAS bf16*)(lds + R1_BN + t * T72 + lane * 2) = (bf16)f2bf(bv * em);
            *(LAS bf16*)(lds + R1_KN + t * T72 + lane * 2) = (bf16)f2bf(kv * em);
            atf[q] = an; bh_[q] = f2bf(bv * eh); kh_[q] = f2bf(kv * eh);
        }
        *(LAS u32x4*)(lds + R1_BHT + lane * T72 + wave * 16) = (u32x4){bh_[0] | (bh_[1] << 16), bh_[2] | (bh_[3] << 16), bh_[4] | (bh_[5] << 16), bh_[6] | (bh_[7] << 16)};
        *(LAS u32x4*)(lds + R1_KHT + lane * T72 + wave * 16) = (u32x4){kh_[0] | (kh_[1] << 16), kh_[2] | (kh_[3] << 16), kh_[4] | (kh_[5] << 16), kh_[6] | (kh_[7] << 16)};
        *(LAS u32x4*)(lds + R1_VT + lane * T72 + wave * 16) = (u32x4){vr[0] | (vr[1] << 16), vr[2] | (vr[3] << 16), vr[4] | (vr[5] << 16), vr[6] | (vr[7] << 16)};
        *(LAS f32x4*)(lds + R1_ATF + lane * 272 + wave * 32) = (f32x4){atf[0], atf[1], atf[2], atf[3]};
        *(LAS f32x4*)(lds + R1_ATF + lane * 272 + wave * 32 + 16) = (f32x4){atf[4], atf[5], atf[6], atf[7]};
        if (wave == 0) ((float*)(F.ws + WS_GC))[(size_t)u * 64 + lane] = __expf(tot);
    }
    __syncthreads();
    {
        const int p = wave >> 2, mt = (wave >> 1) & 1, nt = wave & 1;
        f32x16 d = zero16();
        if (mt <= nt) d = mm64(lds + (p ? R1_KN : R1_BN), lds + R1_AN, 32 * mt, 32 * nt, l31, hi, d);
#pragma unroll
        for (int q = 0; q < 16; ++q) { const int tau = 32 * mt + 8 * (q >> 2) + 4 * hi + (q & 3), t = 32 * nt + l31; if (!(tau < t)) d[q] = 0.f; }
        if (p == 0) {
            st_tile_T_f32(lds + R1_AAB, d, 32 * mt, 32 * nt, l31, hi);
#pragma unroll
            for (int q = 0; q < 16; ++q) { const int tau = 32 * mt + 8 * (q >> 2) + 4 * hi + (q & 3), t = 32 * nt + l31; if ((tau >> 4) == (t >> 4)) d[q] = 0.f; }
            st_tile_T_bf(lds + R1_AOFF, d, 32 * mt, 32 * nt, l31, hi);
        } else st_tile_T_bf(lds + R1_AAK, d, 32 * mt, 32 * nt, l31, hi);
    }
    __syncthreads();
    if (wave < 4) { const int mt = wave >> 1, nt = wave & 1; f32x16 d = zero16(); d = mm64(lds + R1_AAK, lds + R1_VT, 32 * mt, 32 * nt, l31, hi, d); st_tile_T_f32(lds + R1_RHS2, d, 32 * mt, 32 * nt, l31, hi); }
    else if (wave == 4) {
        const int blk = lane >> 4, c = lane & 15;
#pragma unroll
        for (int q = 0; q < 4; ++q) *(LAS u32x4*)(lds + R1_TT + lane * 64 + q * 16) = (u32x4){0u, 0u, 0u, 0u};
        float x[16];
#pragma unroll
        for (int r = 0; r < 16; ++r) x[r] = (r == c) ? 1.f : 0.f;
        unsigned ab_ = (unsigned)(size_t)(lds + R1_AAB) + (unsigned)(blk * 16 * 272 + blk * 64); asm volatile("" : "+v"(ab_));
#pragma unroll
        for (int r = 1; r < 16; ++r) {
            float s0 = 0.f;
#pragma unroll
            for (int q = 0; q < (r + 3) / 4; ++q) { const f32x4 a = *(const LAS f32x4*)((const LAS unsigned char*)(size_t)ab_ + r * 272 + q * 16);
                s0 += a[0] * x[4 * q]; if (4 * q + 1 < r) s0 += a[1] * x[4 * q + 1]; if (4 * q + 2 < r) s0 += a[2] * x[4 * q + 2]; if (4 * q + 3 < r) s0 += a[3] * x[4 * q + 3]; }
            x[r] += s0;
            asm volatile("" : "+v"(x[r]));
        }
#pragma unroll
        for (int r = 0; r < 16; ++r) *(LAS bf16*)(lds + R1_TT + ((blk * 16 + r) * 32 + 8 * (c >> 2) + (c & 3)) * 2) = (bf16)f2bf(x[r]);
    } else {
        const int t3 = F.tid - 320;
#pragma unroll
        for (int q = 0; q < 6; ++q) *(LAS u32x4*)(lds + R1_AN + (t3 + 192 * q) * 16) = (u32x4){0u, 0u, 0u, 0u};
    }
    __syncthreads();
    {
        const int cl = lane & 15, qd = lane >> 4, col = 16 * (wave & 3) + cl, isu = wave >> 2;
        const LAS unsigned char* rhs = lds + (isu ? R1_RHS2 : R1_ATF) + col * 272;
        LAS unsigned char* xt = lds + (isu ? R1_BN : R1_AN) + col * T72;
        bf16* gp = (bf16*)(F.ws + (isu ? WS_UPN : WS_WN)) + (size_t)u * 4096 + col;
#pragma unroll
        for (int d = 0; d < 4; ++d) {
            f32x4 acc = *(const LAS f32x4*)(rhs + (16 * d + 4 * qd) * 4);
            if (d > 0) {
#pragma unroll
                for (int ks = 0; ks < (d == 3 ? 2 : 1); ++ks) {
                    const bf16x8 a = *(const LAS bf16x8*)(lds + R1_AOFF + (16 * d + cl) * T72 + (32 * ks + 8 * qd) * 2), bx = *(const LAS bf16x8*)(xt + (32 * ks + 8 * qd) * 2);
                    acc = __builtin_amdgcn_mfma_f32_16x16x32_bf16(a, bx, acc, 0, 0, 0);
                }
            }
            u32x4 bw; bw.x = pk2(acc[0], acc[1]); bw.y = pk2(acc[2], acc[3]); bw.z = 0u; bw.w = 0u;
            const bf16x8 ta = *(const LAS bf16x8*)(lds + R1_TT + ((d * 16 + cl) * 32 + 8 * qd) * 2);
            f32x4 xo = (f32x4){0.f, 0.f, 0.f, 0.f};
            xo = __builtin_amdgcn_mfma_f32_16x16x32_bf16(ta, __builtin_bit_cast(bf16x8, bw), xo, 0, 0, 0);
            u32x2 w; w.x = pk2(xo[0], xo[1]); w.y = pk2(xo[2], xo[3]);
            *(LAS u32x2*)(xt + (16 * d + 4 * qd) * 2) = w;
#pragma unroll
            for (int r = 0; r < 4; ++r) gp[(16 * d + 4 * qd + r) * 64] = (bf16)f2bf(xo[r]);
        }
    }
    __syncthreads();
    {
        const int mt = (wave >> 1) & 1, nt = wave & 1;
        f32x16 d = zero16();
        if (wave < 4) {
            d = mm64(lds + R1_BHT, lds + R1_AN  , 32 * mt, 32 * nt, l31, hi, d);
            unsigned char* img = F.ws + WS_PT + (size_t)u * 16384;
            const int j = 32 * nt + l31, s_ = j >> 4, r_ = j & 15, half = r_ >> 3, hj = (r_ >> 2) & 1, e_ = r_ & 3;
#pragma unroll
            for (int q = 0; q < 16; ++q) { const int jp = 32 * mt + 8 * (q >> 2) + 4 * hi + (q & 3);
                *(bf16*)(img + (((((jp >> 5) * 4 + s_) * 2 + hj) * 32 + (jp & 31)) * 16 + half * 8 + e_ * 2)) = (bf16)f2bf(d[q]); }
        } else {
            d = mm64(lds + R1_BHT, lds + R1_BN  , 32 * mt, 32 * nt, l31, hi, d);
            d = mm64(lds + R1_KHT, lds + R1_VT, 32 * mt, 32 * nt, l31, hi, d);
            unsigned char* img = F.ws + WS_PT + (size_t)u * 16384 + 8192;
#pragma unroll
            for (int g = 0; g < 4; ++g) { u32x2 w; w.x = pk2(d[4 * g], d[4 * g + 1]); w.y = pk2(d[4 * g + 2], d[4 * g + 3]); *(u32x2*)(img + (((((nt * 2 + mt) * 4 + g) * 2 + hi) * 32 + l31) * 8)) = w; }
        }
    }
    __syncthreads();
}

constexpr int R2_SLOT = 16640, R2_NST = 8, R2_QI = 8192, R2_G = 16384;
__device__ __forceinline__ void rw2_issue(LAS unsigned char* slot, const unsigned char* img, const float* gsrc, int lane) {
#pragma unroll
    for (int i = 0; i < 16; ++i) __builtin_amdgcn_global_load_lds((const unsigned*)(img + i * 1024 + lane * 16), (LAS unsigned*)(slot + i * 1024), 16, 0, 0);
    if (lane < 16) __builtin_amdgcn_global_load_lds((const unsigned*)((const unsigned char*)gsrc + lane * 16), (LAS unsigned*)(slot + R2_G), 16, 0, 0);
}
__device__ __forceinline__ void rw2_wg(const Frame& F, int bh) {
    const int lane = F.lane, wave = F.wave, l31 = lane & 31, hi = lane >> 5;
    LAS unsigned char* lds = F.lds;
    LAS unsigned* ctr = (LAS unsigned*)(lds + LDS_MISC + 128);
    if (F.tid < 8) ctr[F.tid] = 0u;
    __syncthreads();
    const unsigned char* IMG = F.ws + WS_PT + (size_t)bh * 128 * 16384; const float* GC = (const float*)(F.ws + WS_GC) + (size_t)bh * 128 * 64;
    if (wave >= 4) {
        const int k = wave - 4;
        rw2_issue(lds + k * R2_SLOT, IMG + (size_t)k * 16384, GC + k * 64, lane);
        rw2_issue(lds + (k + 4) * R2_SLOT, IMG + (size_t)(k + 4) * 16384, GC + (k + 4) * 64, lane);
#pragma unroll 1
        for (int m = 0; m < 32; ++m) {
            const int c = k + 4 * m;
            if (m < 31) asm volatile("s_waitcnt vmcnt(17)" ::: "memory"); else asm volatile("s_waitcnt vmcnt(0)" ::: "memory");
            if (lane == 0) __hip_atomic_store(ctr + k, (unsigned)(m + 1), __ATOMIC_RELEASE, __HIP_MEMORY_SCOPE_WORKGROUP);
            const int cn = c + 8;
            if (cn < 128) {
                for (;;) { const unsigned a = __hip_atomic_load(ctr + 4, __ATOMIC_ACQUIRE, __HIP_MEMORY_SCOPE_WORKGROUP), b2 = __hip_atomic_load(ctr + 5, __ATOMIC_ACQUIRE, __HIP_MEMORY_SCOPE_WORKGROUP);
                    if ((a < b2 ? a : b2) >= (unsigned)(c + 1)) break; __builtin_amdgcn_s_sleep(1); }
                rw2_issue(lds + (cn & 7) * R2_SLOT, IMG + (size_t)cn * 16384, GC + cn * 64, lane);
            } else if (m < 31) {   asm volatile("s_waitcnt vmcnt(0)" ::: "memory"); }
        }
    } else if (wave < 2) {
        const int ih = wave, irow = 32 * ih + l31;
        bf16* S0 = (bf16*)(F.ws + WS_S0);
        f32x16 acc[2]; acc[0] = zero16(); acc[1] = zero16();
#pragma unroll 1
        for (int c = 0; c < 128; ++c) {
            const size_t ub = ((size_t)bh * 128 + c) * 4096;
            const LAS unsigned char* slot = lds + (c & 7) * R2_SLOT;
            bf16x8 xb[4];
#pragma unroll
            for (int jt = 0; jt < 2; ++jt) {
                u32x4 lo, hi4;
                lo.x = pg8::cvt_pk_bf16(acc[jt][0], acc[jt][1]); lo.y = pg8::cvt_pk_bf16(acc[jt][2], acc[jt][3]); lo.z = pg8::cvt_pk_bf16(acc[jt][4], acc[jt][5]); lo.w = pg8::cvt_pk_bf16(acc[jt][6], acc[jt][7]);
                hi4.x = pg8::cvt_pk_bf16(acc[jt][8], acc[jt][9]); hi4.y = pg8::cvt_pk_bf16(acc[jt][10], acc[jt][11]); hi4.z = pg8::cvt_pk_bf16(acc[jt][12], acc[jt][13]); hi4.w = pg8::cvt_pk_bf16(acc[jt][14], acc[jt][15]);
                xb[2 * jt] = __builtin_bit_cast(bf16x8, lo); xb[2 * jt + 1] = __builtin_bit_cast(bf16x8, hi4);
                bf16* sp = S0 + ub + (size_t)irow * 64 + 32 * jt + 4 * hi;
                *(u32x2*)(sp) = (u32x2){lo.x, lo.y}; *(u32x2*)(sp + 8) = (u32x2){lo.z, lo.w}; *(u32x2*)(sp + 16) = (u32x2){hi4.x, hi4.y}; *(u32x2*)(sp + 24) = (u32x2){hi4.z, hi4.w};
            }
            while (__hip_atomic_load(ctr + (c & 3), __ATOMIC_ACQUIRE, __HIP_MEMORY_SCOPE_WORKGROUP) < (unsigned)((c >> 2) + 1)) __builtin_amdgcn_s_sleep(1);
            f32x16 nw[2];
#pragma unroll
            for (int jt = 0; jt < 2; ++jt)
#pragma unroll
                for (int g = 0; g < 4; ++g) {
                    const u32x2 qv = *(const LAS u32x2*)(slot + R2_QI + (((((ih * 2 + jt) * 4 + g) * 2 + hi) * 32 + l31) * 8));
                    const f32x4 gv = *(const LAS f32x4*)(slot + R2_G + (32 * jt + 8 * g + 4 * hi) * 4);
                    nw[jt][4 * g + 0] = bflo(qv.x) + gv[0] * acc[jt][4 * g + 0]; nw[jt][4 * g + 1] = bfhi(qv.x) + gv[1] * acc[jt][4 * g + 1];
                    nw[jt][4 * g + 2] = bflo(qv.y) + gv[2] * acc[jt][4 * g + 2]; nw[jt][4 * g + 3] = bfhi(qv.y) + gv[3] * acc[jt][4 * g + 3];
                }
#pragma unroll
            for (int jt = 0; jt < 2; ++jt)
#pragma unroll
                for (int s_ = 0; s_ < 4; ++s_) {
                    const bf16x8 af = *(const LAS bf16x8*)(slot + ((((jt * 4 + s_) * 2 + hi) * 32 + l31) * 16));
                    nw[jt] = mfma32(af, xb[s_], nw[jt]);
                }
            asm volatile("s_waitcnt lgkmcnt(0)" ::: "memory");
            if (lane == 0) __hip_atomic_store(ctr + 4 + wave, (unsigned)(c + 1), __ATOMIC_RELEASE, __HIP_MEMORY_SCOPE_WORKGROUP);
            acc[0] = nw[0]; acc[1] = nw[1];
        }
    }
}

constexpr int R3_RN = 0, R3_BN = 9216, R3_KN = 18432, R3_WN = 27648, R3_S0 = 36864, R3_VT = 46080, R3_UT = 55296, R3_ARB = 64512, R3_ARK = 73728, R3_YL = 82944;
__device__ __forceinline__ void rw3_unit(const Frame& F, int u, int l) {
    const int tid = F.tid, lane = F.lane, wave = F.wave, l31 = lane & 31, hi = lane >> 5;
    LAS unsigned char* lds = F.lds;
    const int c = u & 127, bh = u >> 7, b = bh >> 3, h = bh & 7;
    const size_t n0 = (size_t)b * T + 64 * c; const int cb = 64 * h;
    const bf16* rwR = (const bf16*)(F.ws + WS_RW); const bf16* rwK = rwR + (size_t)NTOK * RW; const bf16* rwV = rwK + (size_t)NTOK * RW; const bf16* rwB = rwR + (size_t)4 * NTOK * RW;
    const float* rwD = (const float*)(F.ws + WS_RW + 96 * MiB);
    unsigned short upr[16];
    {   const int mt = (wave >> 1) & 1, nt = wave & 1;
        const bf16* up = (const bf16*)(F.ws + WS_UPN) + (size_t)u * 4096 + 32 * nt + l31;
        if (wave < 4) {
#pragma unroll
            for (int q = 0; q < 16; ++q) upr[q] = up[(32 * mt + 8 * (q >> 2) + 4 * hi + (q & 3)) * 64]; } }
    const size_t od = (n0 + (tid >> 3)) * RW + cb + (tid & 7) * 8;
    const u32x4 rw_d = *(const u32x4*)(rwR + od), kw_d = *(const u32x4*)(rwK + od), vw_d = *(const u32x4*)(rwV + od), gw_d = *(const u32x4*)(rwR + (size_t)5 * NTOK * RW + od);
    {
        float ldv[8]; unsigned rr[8], br[8], kr[8], vr[8];
#pragma unroll
        for (int q = 0; q < 8; ++q) { const size_t o = (n0 + 8 * wave + q) * RW + cb + lane; ldv[q] = rwD[o]; rr[q] = rwR[o]; br[q] = rwB[o]; kr[q] = rwK[o]; vr[q] = rwV[o]; }
        const int row = tid >> 3, ch = (tid & 7) * 8;
        const u32x4 wcp = *(const u32x4*)((const bf16*)(F.ws + WS_WN) + (size_t)u * 4096 + row * 64 + ch), scp = *(const u32x4*)((const bf16*)(F.ws + WS_S0) + (size_t)u * 4096 + row * 64 + ch);
        float part = 0.f;
#pragma unroll
        for (int q = 0; q < 8; ++q) part += ldv[q];
        LAS float* psum = (LAS float*)(lds + R3_YL);
        psum[wave * 64 + lane] = part;
        __syncthreads();
        float cwv = 0.f;
#pragma unroll
        for (int w = 0; w < 8; ++w) { const float x = psum[w * 64 + lane]; if (w < wave) cwv += x; }
#pragma unroll
        for (int q = 0; q < 8; ++q) {
            const int t = 8 * wave + q;
            cwv += ldv[q];
            const float ep = __expf(cwv), em = __expf(-cwv);
            *(LAS bf16*)(lds + R3_RN + t * T72 + lane * 2) = (bf16)f2bf(bf2f(rr[q]) * ep);
            *(LAS bf16*)(lds + R3_BN + t * T72 + lane * 2) = (bf16)f2bf(bf2f(br[q]) * em);
            *(LAS bf16*)(lds + R3_KN + t * T72 + lane * 2) = (bf16)f2bf(bf2f(kr[q]) * em);
        }
        *(LAS u32x4*)(lds + R3_VT + lane * T72 + wave * 16) = (u32x4){vr[0] | (vr[1] << 16), vr[2] | (vr[3] << 16), vr[4] | (vr[5] << 16), vr[6] | (vr[7] << 16)};
        *(LAS u32x4*)(lds + R3_WN + row * T72 + ch * 2) = wcp;
        *(LAS u32x4*)(lds + R3_S0 + row * T72 + ch * 2) = scp;
    }
    __syncthreads();
    f32x16 y = zero16();
    {
        const int p = wave >> 2, mt = (wave >> 1) & 1, nt = wave & 1;
        f32x16 d = zero16();
        if (mt <= nt) d = mm64(lds + (p ? R3_KN : R3_BN), lds + R3_RN, 32 * mt, 32 * nt, l31, hi, d);
#pragma unroll
        for (int q = 0; q < 16; ++q) { const int tau = 32 * mt + 8 * (q >> 2) + 4 * hi + (q & 3), t = 32 * nt + l31; if (!(tau <= t)) d[q] = 0.f; }
        st_tile_T_bf(lds + (p ? R3_ARK : R3_ARB), d, 32 * mt, 32 * nt, l31, hi);
        if (wave < 4) {
            f32x16 uu;
#pragma unroll
            for (int q = 0; q < 16; ++q) uu[q] = bf2f(upr[q]);
            uu = mm64(lds + R3_WN, lds + R3_S0, 32 * mt, 32 * nt, l31, hi, uu);
            st_tile_T_bf(lds + R3_UT, uu, 32 * mt, 32 * nt, l31, hi);
        } else y = mm64(lds + R3_RN, lds + R3_S0, 32 * mt, 32 * nt, l31, hi, y);
    }
    __syncthreads();
    if (wave >= 4) {
        const int mt = (wave >> 1) & 1, nt = wave & 1;
        y = mm64(lds + R3_ARB, lds + R3_UT, 32 * mt, 32 * nt, l31, hi, y);
        y = mm64(lds + R3_ARK, lds + R3_VT, 32 * mt, 32 * nt, l31, hi, y);
#pragma unroll
        for (int q = 0; q < 16; ++q) *(LAS float*)(lds + R3_YL + (32 * mt + 8 * (q >> 2) + 4 * hi + (q & 3)) * 272 + (32 * nt + l31) * 4) = y[q];
    }
    __syncthreads();
    {
        const int t = tid >> 3, i8 = (tid & 7) * 8; const size_t o = (n0 + t) * RW + cb + i8;
        const f32x4 y0 = *(const LAS f32x4*)(lds + R3_YL + t * 272 + i8 * 4), y1 = *(const LAS f32x4*)(lds + R3_YL + t * 272 + i8 * 4 + 16);
        const u32x4 rw = rw_d, kw = kw_d, vw = vw_d, gw = gw_d;
        float yy[8] = {y0[0], y0[1], y0[2], y0[3], y1[0], y1[1], y1[2], y1[3]};
        const float r[8] = {bflo(rw.x), bfhi(rw.x), bflo(rw.y), bfhi(rw.y), bflo(rw.z), bfhi(rw.z), bflo(rw.w), bfhi(rw.w)};
        const float k[8] = {bflo(kw.x), bfhi(kw.x), bflo(kw.y), bfhi(kw.y), bflo(kw.z), bfhi(kw.z), bflo(kw.w), bfhi(kw.w)};
        const float v[8] = {bflo(vw.x), bfhi(vw.x), bflo(vw.y), bfhi(vw.y), bflo(vw.z), bfhi(vw.z), bflo(vw.w), bfhi(vw.w)};
        const float g[8] = {bflo(gw.x), bfhi(gw.x), bflo(gw.y), bfhi(gw.y), bflo(gw.z), bfhi(gw.z), bflo(gw.w), bfhi(gw.w)};
        const float* gng = F.in(I_GNG) + l * RW + cb + i8; const float* gnb = F.in(I_GNB) + l * RW + cb + i8; const float* rk = F.in(I_RK) + l * RW + cb + i8;
        float sm = 0.f, bon = 0.f;
#pragma unroll
        for (int j = 0; j < 8; ++j) { sm += yy[j]; bon += r[j] * k[j] * rk[j]; }
        sm = sum8(sm); bon = sum8(bon);
        const float mean = sm * (1.f / 64.f);
        float var = 0.f;
#pragma unroll
        for (int j = 0; j < 8; ++j) { yy[j] -= mean; var += yy[j] * yy[j]; }
        var = sum8(var);
        const float inv = __builtin_amdgcn_rsqf(var * (1.f / 64.f) + 64e-5f);
        float ov[8];
#pragma unroll
        for (int j = 0; j < 8; ++j) ov[j] = (yy[j] * inv * gng[j] + gnb[j] + bon * v[j]) * g[j];
        u32x4 w; w.x = pk2(ov[0], ov[1]); w.y = pk2(ov[2], ov[3]); w.z = pk2(ov[4], ov[5]); w.w = pk2(ov[6], ov[7]);
        *(u32x4*)((bf16*)(F.ws + WS_YA) + o) = w;
    }
    __syncthreads();
}

constexpr int AT_KT = 0, AT_VT = 18432, AT_IMP = 36864, AT_MASK = 69632, AT_OUT = 70656;
struct KvRegs { u32x4 k, v; };
__device__ __forceinline__ KvRegs kv_load(const bf16* kbase, const bf16* vtbase, int vstride, int key0, int tid) {
    KvRegs r; const int row = tid >> 3, ch = (tid & 7) * 8;
    r.k = *(const u32x4*)(kbase + (size_t)(key0 + row) * 64 + ch);
    r.v = *(const u32x4*)(vtbase + (size_t)row * vstride + key0 + ch);
    return r;
}
__device__ __forceinline__ void kv_store(LAS unsigned char* lds, int buf, const KvRegs& r, int tid) {
    const int row = tid >> 3, ch = (tid & 7) * 16;
    *(LAS u32x4*)(lds + AT_KT + buf * 9216 + row * 144 + ch) = r.k;
    {   const int c = tid & 7, s_ = c >> 1, half = c & 1, dt = row >> 5, r31 = row & 31;
        LAS unsigned char* vb = lds + AT_VT + buf * 9216 + ((((dt * 4 + s_) * 2) * 32 + r31) * 16) + half * 8;
        *(LAS u32x2*)vb = (u32x2){r.v.x, r.v.y}; *(LAS u32x2*)(vb + 512) = (u32x2){r.v.z, r.v.w}; }
}
__device__ __forceinline__ void qk_tile(const LAS unsigned char* kt, const bf16x8 (&qf)[4], int l31, int hi, f32x16& s0, f32x16& s1, float init) {
#pragma unroll
    for (int q = 0; q < 16; ++q) { s0[q] = init; s1[q] = init; }
#pragma unroll
    for (int sl = 0; sl < 4; ++sl) {
        const bf16x8 a0 = *(const LAS bf16x8*)(kt + l31 * 144 + sl * 32 + hi * 16), a1 = *(const LAS bf16x8*)(kt + (32 + l31) * 144 + sl * 32 + hi * 16);
        s0 = mfma32(a0, qf[sl], s0); s1 = mfma32(a1, qf[sl], s1);
    }
}
__device__ __forceinline__ void pv_tile(const LAS unsigned char* vt, const f32x16& p0, const f32x16& p1, int l31, int hi, f32x16 (&o)[2]) {
#pragma unroll
    for (int s = 0; s < 4; ++s) {
        const f32x16& pp = (s < 2) ? p0 : p1; const int rb = (s & 1) * 8;
        bf16x8 pb; u32x4 pw;
        pw.x = pg8::cvt_pk_bf16(pp[rb + 0], pp[rb + 1]); pw.y = pg8::cvt_pk_bf16(pp[rb + 2], pp[rb + 3]); pw.z = pg8::cvt_pk_bf16(pp[rb + 4], pp[rb + 5]); pw.w = pg8::cvt_pk_bf16(pp[rb + 6], pp[rb + 7]);
        pb = __builtin_bit_cast(bf16x8, pw);
#pragma unroll
        for (int dt = 0; dt < 2; ++dt) {
            const bf16x8 vf = *(const LAS bf16x8*)(vt + ((((dt * 4 + s) * 2 + hi) * 32 + l31) * 16));
            o[dt] = mfma32(vf, pb, o[dt]);
        }
    }
}
constexpr float NEG_BIG = -1e30f;
__device__ __forceinline__ void mask_lt(f32x16& s0, f32x16& s1, int lim, int hi) {
    const int l2 = lim - 4 * hi;
#pragma unroll
    for (int q = 0; q < 16; ++q) { const int kq = 8 * (q >> 2) + (q & 3); s0[q] = (kq < l2) ? s0[q] : NEG_BIG; s1[q] = (kq + 32 < l2) ? s1[q] : NEG_BIG; }
}
__device__ __forceinline__ void mask_ge(f32x16& s0, f32x16& s1, int lim, int hi) {
    const int l2 = lim - 4 * hi;
#pragma unroll
    for (int q = 0; q < 16; ++q) { const int kq = 8 * (q >> 2) + (q & 3); s0[q] = (kq >= l2) ? s0[q] : NEG_BIG; s1[q] = (kq + 32 >= l2) ? s1[q] : NEG_BIG; }
}
constexpr float SM_OFF = -16.f;
__device__ __forceinline__ void exp_tile(f32x16& s0, f32x16& s1, float& lsum) {
    float ps = 0.f;
#pragma unroll
    for (int q = 0; q < 16; ++q) { s0[q] = __builtin_amdgcn_exp2f(s0[q]); s1[q] = __builtin_amdgcn_exp2f(s1[q]); ps += s0[q] + s1[q]; }
    lsum += ps;
}
__device__ __forceinline__ void attn_unit(const Frame& F_, int unit) {
    const Frame& F = F_;
    const int tid = F.tid, lane = F.lane, wave = F.wave, l31 = lane & 31, hi = lane >> 5;
    const int bg = unit >> 7, qb = unit & 127, b = bg >> 1, g = bg & 1;
    LAS unsigned char* lds = F.lds;
    LAS float* IMP = (LAS float*)(lds + AT_IMP); LAS unsigned* MASK = (LAS unsigned*)(lds + AT_MASK);
    const int ql = 8 * wave + (l31 >> 2), hd = l31 & 3;
    const int tq = ql;
    const size_t nq = (size_t)b * T + 64 * qb + ql;
    bf16x8 qf[4];
    {
        const bf16* qp = (const bf16*)(F.ws + NS_Q) + nq * 512 + g * 256 + hd * 64 + hi * 8;
#pragma unroll
        for (int sl = 0; sl < 4; ++sl) qf[sl] = *(const bf16x8*)(qp + sl * 16);
    }
    const float* gt = (const float*)(F.ws + NS_GATE) + nq * 24 + (g * 4 + hd) * 3;
    LAS float* outl = (LAS float*)(lds + AT_OUT) + wave * 2048 + lane;
    const bf16* kcmp = (const bf16*)(F.ws + NS_KCMP) + (size_t)bg * NCMPP * 64; const bf16* vcmpT = (const bf16*)(F.ws + NS_VCMPT) + (size_t)bg * 64 * NCMPP;
    const int ntc = (4 * qb + 3 + 63) >> 6;
    const int tabs = 64 * qb + tq;
    const int nvis = (tabs >= 31) ? ((tabs - 31) >> 4) + 1 : 0;
    const int tmin_w = 64 * qb + 8 * wave; const int nvis_min = (tmin_w >= 31) ? ((tmin_w - 31) >> 4) + 1 : 0;
    float lc = 0.f;
    f32x16 o[2];
    const bf16* ks_e = (const bf16*)(F.ws + NS_KS) + (size_t)bg * T * 64; const bf16* vsT_e = (const bf16*)(F.ws + NS_VST) + (size_t)bg * 64 * T;
    const bf16* kw_e = (const bf16*)(F.ws + NS_KW) + (size_t)bg * T * 64; const bf16* vwT_e = (const bf16*)(F.ws + NS_VWT) + (size_t)bg * 64 * T;
    const KvRegs pre_c0 = kv_load(kcmp, vcmpT, NCMPP, 0, tid);
    {
        KvRegs pre = pre_c0;
        for (int jt = 0; jt < ntc; ++jt) {
            kv_store(lds, jt & 1, pre, tid);
            if (jt + 1 < ntc) pre = kv_load(kcmp, vcmpT, NCMPP, 64 * (jt + 1), tid);
            __syncthreads();
            f32x16 s0, s1; qk_tile(lds + AT_KT + (jt & 1) * 9216, qf, l31, hi, s0, s1, SM_OFF);
            if (64 * (jt + 1) > nvis_min) { int nv = nvis - 64 * jt; asm volatile("" : "+v"(nv)); mask_lt(s0, s1, nv, hi); }
            exp_tile(s0, s1, lc);
        }
    }
    __syncthreads();
    {
        lc = sum_halves(lc);
        const float invl = (lc > 0.f) ? 1.f / lc : 0.f;
#pragma unroll
        for (int q = 0; q < 16; ++q) { o[0][q] = 0.f; o[1][q] = 0.f; }
        float carry = 0.f;
        KvRegs pre = pre_c0;
        for (int jt = 0; jt < ntc; ++jt) {
            kv_store(lds, jt & 1, pre, tid);
            if (jt + 1 < ntc) pre = kv_load(kcmp, vcmpT, NCMPP, 64 * (jt + 1), tid);
            __syncthreads();
            f32x16 s0, s1; qk_tile(lds + AT_KT + (jt & 1) * 9216, qf, l31, hi, s0, s1, SM_OFF);
            if (64 * (jt + 1) > nvis_min) { int nv = nvis - 64 * jt; asm volatile("" : "+v"(nv)); mask_lt(s0, s1, nv, hi); }
#pragma unroll
            for (int q = 0; q < 16; ++q) { s0[q] = __builtin_amdgcn_exp2f(s0[q]) * invl; s1[q] = __builtin_amdgcn_exp2f(s1[q]) * invl; }
            pv_tile(lds + AT_VT + (jt & 1) * 9216, s0, s1, l31, hi, o);
            float gs[8], ls[8];
#pragma unroll
            for (int kt = 0; kt < 2; ++kt)
#pragma unroll
                for (int j = 0; j < 4; ++j) { const f32x16& pp = kt ? s1 : s0; gs[kt * 4 + j] = quad_sum(pp[4 * j] + pp[4 * j + 1] + pp[4 * j + 2] + pp[4 * j + 3]); ls[kt * 4 + j] = quad_sum(pp[4 * j + 3]); }
            float lx[8];
#pragma unroll
            for (int i = 0; i < 8; ++i) lx[i] = other_half(ls[i], hi);
#pragma unroll
            for (int i = 0; i < 8; ++i) {
                const float add = hi ? lx[i] : (i == 0 ? carry : lx[i - 1]);
                if (hd == 0) IMP[ql * 128 + 16 * jt + 2 * i + hi] = gs[i] + add;
            }
            carry = lx[7];
        }
        const float g0 = gt[0];
#pragma unroll
        for (int q = 0; q < 16; ++q) { outl[q * 64] = g0 * o[0][q]; outl[(16 + q) * 64] = g0 * o[1][q]; }
    }
    __syncthreads();
    {
        const unsigned long long lt_mask = (1ull << lane) - 1ull;
#pragma unroll 1
        for (int qi = 0; qi < 8; ++qi) {
            const int qq = 8 * wave + qi;
            unsigned long long m0, m1;
            if (qb < 16) { m0 = __ballot(lane <= qb); m1 = 0ull; }
            else {
                const int sA = lane, sB = lane + 64;
                const unsigned kA = (sA > qb) ? 0u : ((sA == 0 || sA == qb || sA == qb - 1) ? 0x461c4000u : __builtin_bit_cast(unsigned, IMP[qq * 128 + sA]));
                const unsigned kB = (sB > qb) ? 0u : ((sB == qb || sB == qb - 1) ? 0x461c4000u : __builtin_bit_cast(unsigned, IMP[qq * 128 + sB]));
                unsigned thr = 0u;
#pragma unroll 1
                for (int bitp = 30; bitp >= 0; --bitp) { const unsigned cand = thr | (1u << bitp);
                    const int cnt = __popcll(__ballot(kA >= cand)) + __popcll(__ballot(kB >= cand)); if (cnt >= 16) { thr = cand; if (cnt == 16) break; } }
                const unsigned long long gA = __ballot(kA > thr), gB = __ballot(kB > thr), eA = __ballot(kA == thr), eB = __ballot(kB == thr);
                const int need = 16 - (__popcll(gA) + __popcll(gB));
                const bool selA = (kA > thr) || (kA == thr && __popcll(eA & lt_mask) < need);
                const bool selB = (kB > thr) || (kB == thr && __popcll(eA) + __popcll(eB & lt_mask) < need);
                m0 = __ballot(selA && sA <= qb); m1 = __ballot(selB && sB <= qb);
            }
            if (lane == 0) { MASK[qq * 4 + 0] = (unsigned)m0; MASK[qq * 4 + 1] = (unsigned)(m0 >> 32); MASK[qq * 4 + 2] = (unsigned)m1; MASK[qq * 4 + 3] = (unsigned)(m1 >> 32); }
        }
    }
    __syncthreads();
    unsigned selm[4];
#pragma unroll
    for (int i = 0; i < 4; ++i) selm[i] = MASK[ql * 4 + i];
    {
        const Frame F = relaunder(F_);
        const bf16* ks = (const bf16*)(F.ws + NS_KS) + (size_t)bg * T * 64; const bf16* vsT = (const bf16*)(F.ws + NS_VST) + (size_t)bg * 64 * T;
        float lsum = 0.f;
#pragma unroll
        for (int q = 0; q < 16; ++q) { o[0][q] = 0.f; o[1][q] = 0.f; }
        unsigned wm[4];
#pragma unroll
        for (int i = 0; i < 4; ++i) { unsigned w = 0u;
#pragma unroll
            for (int q = 0; q < 8; ++q) w |= (unsigned)__builtin_amdgcn_readlane((int)selm[i], 4 * q);
            wm[i] = w; }
        unsigned long long wlo = ((unsigned long long)wm[1] << 32) | wm[0], whi = ((unsigned long long)wm[3] << 32) | wm[2];
#define SEL_NEXT(dst) do { if (wlo) { dst = __builtin_ctzll(wlo); wlo &= wlo - 1ull; } else if (whi) { dst = 64 + __builtin_ctzll(whi); whi &= whi - 1ull; } else dst = -1; } while (0)
#define SEL_LOAD(kX, vX, jj) do { const bf16* kp_ = ks + (size_t)(jj) * 4096 + (l31 * 2 + hi) * 8; const bf16* vp_ = vsT + (size_t)(jj) * 4096 + (l31 * 2 + hi) * 8; \
            _Pragma("unroll") for (int sl = 0; sl < 4; ++sl) { kX[2 * sl] = *(const bf16x8*)(kp_ + sl * 512); kX[2 * sl + 1] = *(const bf16x8*)(kp_ + 2048 + sl * 512); } \
            _Pragma("unroll") for (int i = 0; i < 8; ++i) vX[i] = *(const bf16x8*)(vp_ + i * 512); } while (0)
#define SEL_COMPUTE(kX, vX, jj) do { \
            const unsigned bit = (((jj) & 32) ? (((jj) & 64) ? selm[3] : selm[1]) : (((jj) & 64) ? selm[2] : selm[0])) >> ((jj) & 31) & 1u; \
            const float init = bit ? SM_OFF : NEG_BIG; \
            f32x16 s0, s1; \
            _Pragma("unroll") for (int q = 0; q < 16; ++q) { s0[q] = init; s1[q] = init; } \
            _Pragma("unroll") for (int sl = 0; sl < 4; ++sl) { s0 = mfma32(kX[2 * sl], qf[sl], s0); s1 = mfma32(kX[2 * sl + 1], qf[sl], s1); } \
            if ((jj) == qb) { int tql = tq + 1; asm volatile("" : "+v"(tql)); mask_lt(s0, s1, tql, hi); } \
            exp_tile(s0, s1, lsum); \
            _Pragma("unroll") for (int sq = 0; sq < 4; ++sq) { \
                const f32x16& pp = (sq < 2) ? s0 : s1; const int rb = (sq & 1) * 8; \
                u32x4 pw; \
                pw.x = pg8::cvt_pk_bf16(pp[rb + 0], pp[rb + 1]); pw.y = pg8::cvt_pk_bf16(pp[rb + 2], pp[rb + 3]); pw.z = pg8::cvt_pk_bf16(pp[rb + 4], pp[rb + 5]); pw.w = pg8::cvt_pk_bf16(pp[rb + 6], pp[rb + 7]); \
                const bf16x8 pb = __builtin_bit_cast(bf16x8, pw); \
                _Pragma("unroll") for (int dt = 0; dt < 2; ++dt) o[dt] = mfma32(vX[dt * 4 + sq], pb, o[dt]); } } while (0)
        int j; SEL_NEXT(j);
        bf16x8 kA[8], vA[8], kB[8], vB[8];
        if (j >= 0) SEL_LOAD(kA, vA, j);
        while (j >= 0) {
            int jn; SEL_NEXT(jn);
            if (jn >= 0) SEL_LOAD(kB, vB, jn);
            SEL_COMPUTE(kA, vA, j);
            if (jn < 0) break;
            j = jn; SEL_NEXT(jn);
            if (jn >= 0) SEL_LOAD(kA, vA, jn);
            SEL_COMPUTE(kB, vB, j);
            j = jn;
        }
#undef SEL_LOAD
#undef SEL_COMPUTE
#undef SEL_NEXT
        lsum = sum_halves(lsum);
        const float sc = gt[1] / fmaxf(lsum, 1.17549435e-38f);
#pragma unroll
        for (int q = 0; q < 16; ++q) { outl[q * 64] += sc * o[0][q]; outl[(16 + q) * 64] += sc * o[1][q]; }
    }
    __syncthreads();
    {
        const Frame F = relaunder(F_); const int tid = F.tid;
        const bf16* kw = (const bf16*)(F.ws + NS_KW) + (size_t)bg * T * 64; const bf16* vwT = (const bf16*)(F.ws + NS_VWT) + (size_t)bg * 64 * T;
        float lsum = 0.f;
#pragma unroll
        for (int q = 0; q < 16; ++q) { o[0][q] = 0.f; o[1][q] = 0.f; }
        const int j0 = qb >= 8 ? qb - 8 : 0;
        KvRegs pre = kv_load(kw, vwT, T, 64 * j0, tid);
        for (int j = j0; j <= qb; ++j) {
            kv_store(lds, j & 1, pre, tid);
            if (j + 1 <= qb) pre = kv_load(kw, vwT, T, 64 * (j + 1), tid);
            __syncthreads();
            f32x16 s0, s1; qk_tile(lds + AT_KT + (j & 1) * 9216, qf, l31, hi, s0, s1, SM_OFF);
            if (j == qb || j + 8 == qb) {
                int tql = tq + 1; asm volatile("" : "+v"(tql));
                if (j == qb) mask_lt(s0, s1, tql, hi); else mask_ge(s0, s1, tql, hi);
            }
            exp_tile(s0, s1, lsum);
            pv_tile(lds + AT_VT + (j & 1) * 9216, s0, s1, l31, hi, o);
        }
        lsum = sum_halves(lsum);
        const float sc = gt[2] / fmaxf(lsum, 1.17549435e-38f);
        bf16* yb = (bf16*)(F.ws + WS_YB) + nq * 512 + g * 256 + hd * 64;
#pragma unroll
        for (int dt = 0; dt < 2; ++dt)
#pragma unroll
            for (int j = 0; j < 4; ++j) {
                float v4[4];
#pragma unroll
                for (int r = 0; r < 4; ++r) v4[r] = outl[(16 * dt + 4 * j + r) * 64] + sc * o[dt][4 * j + r];
                u32x2 w; w.x = pg8::cvt_pk_bf16(v4[0], v4[1]); w.y = pg8::cvt_pk_bf16(v4[2], v4[3]);
                *(u32x2*)(yb + 32 * dt + 8 * j + 4 * hi) = w;
            }
    }
    __syncthreads();
}
__device__ __forceinline__ void phase_mix(const Frame& F, int l, int rep) {
    unsigned* head = (unsigned*)(F.ws + WS_CTL) + CW_QUEUE + 64 * l + 16 * rep;
    LAS int* slot = (LAS int*)(F.lds + LDS_MISC + 64);
    for (;;) {
        if (F.tid == 0) *slot = (int)__hip_atomic_fetch_add(head, 1u, __ATOMIC_RELAXED, __HIP_MEMORY_SCOPE_AGENT);
        __syncthreads();
        const int it = *slot;
        __syncthreads();
        const Frame Fi = relaunder(F);
        if (it >= 16 + 512) break;
        if (it < 16) { rw2_wg(Fi, it); __syncthreads(); }
        else { const int a = it - 16; attn_unit(Fi, ((a & 3) << 7) | (127 - (a >> 2))); }
    }
}
__device__ __forceinline__ void phase_rw1(const Frame& F, int l) {
    unsigned* head = (unsigned*)(F.ws + WS_CTL) + CW_QUEUE + 64 * l + 32;
    LAS int* slot = (LAS int*)(F.lds + LDS_MISC + 64);
    for (;;) {
        if (F.tid == 0) *slot = (int)__hip_atomic_fetch_add(head, 2u, __ATOMIC_RELAXED, __HIP_MEMORY_SCOPE_AGENT);
        __syncthreads();
        const int u0 = *slot;
        __syncthreads();
        if (u0 >= 2048) break;
        { const Frame Fi = relaunder(F); rw1_unit(Fi, u0); }
        { const Frame Fi = relaunder(F); rw1_unit(Fi, u0 + 1); }
    }
}
__device__ __forceinline__ void phase_rw3(const Frame& F, int l) { for (int u = F.bid; u < 2048; u += F.G) { const Frame Fi = relaunder(F); rw3_unit(Fi, u, l); } }
__device__ __forceinline__ void phase_router(const Frame& F, int l) {
    LAS float* rwt = (LAS float*)F.lds;
    LAS float* lg = (LAS float*)(F.lds + 65536);
    LAS unsigned* lcnt = (LAS unsigned*)(F.lds + 65536 + 2048);
    if (F.tid < 32) lcnt[F.tid] = 0u;
    for (int i = F.tid; i < 16384; i += NTHR) { const int c = i >> 4, e = i & 15; rwt[e * 1024 + c] = F.in(I_RTW)[i]; }
    __syncthreads();
    const bf16* xin = (const bf16*)(F.ws + WS_XR);
    int* texp = (int*)(F.ws + WS_TOK); int* tpos = (int*)(F.ws + WS_TOK + 131072); float* tw = (float*)(F.ws + WS_TOK + 2 * 131072);
    unsigned* cnt = (unsigned*)(F.ws + WS_CTL) + CW_CNT + 64 * l;
    const float* ng = F.in(I_NORMG) + (size_t)(l * 2 + 1) * D;
    LAS float* mylg = lg + F.wave * 64;
    bf16* H2 = (bf16*)(F.ws + WS_H); int* e2t = (int*)(F.ws + WS_E2T);
    for (int n4 = (F.bid * NWAVE + F.wave) * 4; n4 < NTOK; n4 += F.G * NWAVE * 4) {
        const int b = n4 / T; const float* sh = F.modp(l, b) + 3072; const float* scp = sh + 1024;
        float hv[4][16];
#pragma unroll
        for (int tk = 0; tk < 4; ++tk) {
            f32x4 xv[4]; float ss = 0.f;
#pragma unroll
            for (int j = 0; j < 4; ++j) { const u32x2 xr = *(const u32x2*)(xin + (size_t)(n4 + tk) * D + 4 * F.lane + 256 * j); xv[j] = (f32x4){bflo(xr.x), bfhi(xr.x), bflo(xr.y), bfhi(xr.y)}; ss += xv[j][0] * xv[j][0] + xv[j][1] * xv[j][1] + xv[j][2] * xv[j][2] + xv[j][3] * xv[j][3]; }
            ss = sum64(ss);
            const float inv = __builtin_amdgcn_rsqf(ss * (1.f / D) + 1e-6f);
#pragma unroll
            for (int j = 0; j < 4; ++j) { const int c = 4 * F.lane + 256 * j; const f32x4 g = *(const f32x4*)(ng + c), s1 = *(const f32x4*)(scp + c), s0 = *(const f32x4*)(sh + c);
#pragma unroll
                for (int q = 0; q < 4; ++q) hv[tk][4 * j + q] = xv[j][q] * inv * g[q] * (1.f + s1[q]) + s0[q];
                u32x2 w; w.x = pk2(hv[tk][4 * j], hv[tk][4 * j + 1]); w.y = pk2(hv[tk][4 * j + 2], hv[tk][4 * j + 3]);
                *(u32x2*)(H2 + (size_t)(n4 + tk) * D + c) = w; }
        }
        float acc[64];
#pragma unroll
        for (int i = 0; i < 64; ++i) acc[i] = 0.f;
#pragma unroll
        for (int e = 0; e < 16; ++e)
#pragma unroll
            for (int j = 0; j < 4; ++j) { const f32x4 w = *(const LAS f32x4*)(rwt + e * 1024 + 4 * F.lane + 256 * j);
#pragma unroll
                for (int tk = 0; tk < 4; ++tk) acc[tk * 16 + e] += hv[tk][4 * j] * w[0] + hv[tk][4 * j + 1] * w[1] + hv[tk][4 * j + 2] * w[2] + hv[tk][4 * j + 3] * w[3]; }
#define RT_STEP(MSK, XCHG) do { const bool up = (F.lane & (MSK)) != 0; \
            _Pragma("unroll") for (int i = 0; i < (MSK); ++i) { const float keep = up ? acc[i + (MSK)] : acc[i], send = up ? acc[i] : acc[i + (MSK)]; acc[i] = keep + XCHG; } } while (0)
        RT_STEP(32, other_half(send, F.lane >> 5)); RT_STEP(16, xor_lane<16>(send)); RT_STEP(8, xor_lane<8>(send)); RT_STEP(4, xor_lane<4>(send)); RT_STEP(2, xor_lane<2>(send)); RT_STEP(1, xor_lane<1>(send));
#undef RT_STEP
        mylg[F.lane] = acc[0];
        __builtin_amdgcn_fence(__ATOMIC_RELEASE, "workgroup"); __builtin_amdgcn_s_waitcnt(0xc07f); __builtin_amdgcn_fence(__ATOMIC_ACQUIRE, "workgroup");
        if (F.lane < 4) {
            const int tk = F.lane, n = n4 + tk;
            float sc[16], sl[16];
#pragma unroll
            for (int e = 0; e < 16; ++e) { sc[e] = sigmoidf_(mylg[tk * 16 + e]); sl[e] = sc[e] + F.in(I_RTB)[e]; }
            int bestg = 0; float bests = -1e30f;
#pragma unroll
            for (int gq = 0; gq < 4; ++gq) { float m1 = -1e30f, m2 = -1e30f;
#pragma unroll
                for (int j = 0; j < 4; ++j) { const float v = sl[gq * 4 + j]; if (v > m1) { m2 = m1; m1 = v; } else if (v > m2) m2 = v; }
                const float gs = m1 + m2; if (gs > bests) { bests = gs; bestg = gq; } }
            float v1 = -1e30f, v2 = -1e30f; int e1 = 0, e2 = 0; float s1 = 0.f, s2 = 0.f;
#pragma unroll
            for (int gq = 0; gq < 4; ++gq)
#pragma unroll
                for (int j = 0; j < 4; ++j) { if (gq == bestg) { const float v = sl[gq * 4 + j], s = sc[gq * 4 + j]; const int e = gq * 4 + j;
                    if (v > v1) { v2 = v1; e2 = e1; s2 = s1; v1 = v; e1 = e; s1 = s; } else if (v > v2) { v2 = v; e2 = e; s2 = s; } } }
            const float den = s1 + s2;
            texp[n * 2] = e1; texp[n * 2 + 1] = e2; tw[n * 2] = s1 / den; tw[n * 2 + 1] = s2 / den;
            tpos[n * 2] = (int)__hip_atomic_fetch_add(lcnt + e1, 1u, __ATOMIC_RELAXED, __HIP_MEMORY_SCOPE_WORKGROUP);
            tpos[n * 2 + 1] = (int)__hip_atomic_fetch_add(lcnt + e2, 1u, __ATOMIC_RELAXED, __HIP_MEMORY_SCOPE_WORKGROUP);
        }
    }
    __syncthreads();
    if (F.tid < NE) { const unsigned c = lcnt[F.tid]; lcnt[16 + F.tid] = c ? __hip_atomic_fetch_add(cnt + F.tid, c, __ATOMIC_RELAXED, __HIP_MEMORY_SCOPE_AGENT) : 0u; }
    __syncthreads();
    for (int n4 = (F.bid * NWAVE + F.wave) * 4; n4 < NTOK; n4 += F.G * NWAVE * 4)
        if (F.lane < 8) { const int i = (n4 + (F.lane >> 1)) * 2 + (F.lane & 1); const int e = texp[i], p = tpos[i] + (int)lcnt[16 + e]; tpos[i] = p; e2t[e * 16384 + p] = i >> 1; }
}
constexpr int PH_PER_LAYER = 14, N_PHASES = 1 + DEPTH * PH_PER_LAYER + 1;
#define KIND(k) ((k) == 0 ? 0 : ((k) == N_PHASES - 1 ? PH_PER_LAYER + 1 : (((k) - 1) % PH_PER_LAYER) + 1))
#define IN(k) ((KSEL < 0 || KIND(k) == KSEL) && lo <= (k) && (k) < hi)
#define SEAM(k) do { if (IN(k) && IN((k) + 1)) { XcdBarrier b2_ = bar; unsigned* q_ = b2_.bar; unsigned x_ = b2_.x; asm volatile("" : "+s"(q_), "+s"(x_)); b2_.bar = q_; b2_.x = x_; xcd_barrier(b2_); } } while (0)
#define FRESH() do { int t_ = threadIdx.x; asm volatile("" : "+v"(t_)); F.tid = t_; F.lane = t_ & 63; F.wave = __builtin_amdgcn_readfirstlane(t_ >> 6); \
        const CAS Params* k_ = (const CAS Params*)__builtin_amdgcn_kernarg_segment_ptr(); asm volatile("" : "+s"(k_)); F.p = k_; \
        GAS unsigned char* w_ = (GAS unsigned char*)k_->ws; asm volatile("" : "+s"(w_)); F.ws = (unsigned char*)w_; int b_ = blockIdx.x; asm volatile("" : "+s"(b_)); F.bid = b_; int g_ = gridDim.x; asm volatile("" : "+s"(g_)); F.G = g_; } while (0)

template <int KSEL, int l>
__device__ __forceinline__ void layer_phases(Frame& F, const XcdBarrier& bar, const int lo, const int hi) {
    constexpr int pb = 1 + PH_PER_LAYER * l;
        if (IN(pb + 0)) { FRESH(); if (l == 0) { phase_norm<false, true>(F, 0, 0); FRESH(); phase_convert_weights(F); } else phase_norm<true, true>(F, l, l - 1); }
        SEAM(pb + 0);
        if (IN(pb + 1)) { FRESH();
            pg8::Gemm g{(const bf16*)(F.ws + WS_H), F.lw(l, LW_WIN1), D}; pg8::StaticOrder S; S.init(NTOK, N1P, F.G, F.bid);
            pg8::EpiBf16<0> E{(bf16*)(F.ws + WS_P1), N1P, F.in(I_BIN) + (size_t)l * INC};
            pg8::gemm_phase(F.lds, g, S, E, F.tid);
        }
        SEAM(pb + 1);
        if (IN(pb + 2)) { FRESH(); phase_prep(F, l); }
        SEAM(pb + 2);
        if (IN(pb + 3)) { FRESH(); phase_compress(F, l); FRESH(); phase_rw1(F, l); }
        SEAM(pb + 3);
        if (IN(pb + 5)) { FRESH(); phase_mix(F, l, 0); }
        SEAM(pb + 5);
        if (IN(pb + 6)) { FRESH(); phase_rw3(F, l); }
        SEAM(pb + 6);
        if (IN(pb + 7)) { FRESH();
            pg8::Gemm g{(const bf16*)(F.ws + WS_H), F.lw(l, LW_WM), D}; pg8::MergePairOrder S; S.base.init(NTOK, D, F.G, F.bid);
            pg8::EpiBf16<1> E{(bf16*)(F.ws + WS_PM), NMRG, F.in(I_BIN) + (size_t)l * INC + N1};
            pg8::gemm_phase(F.lds, g, S, E, F.tid);
        }
        if (IN(pb + 8)) { FRESH();
            static_assert(WS_YB == WS_YA + (size_t)NTOK * RW * 2 && LW_UPB == LW_UPA + (size_t)D * RW * 2, "y_b follows y_a, W_up_nsa follows W_up_rwkv");
            pg8::UpPairOrder S; S.base.init(NTOK, D, F.G, F.bid);
            pg8::Gemm g{(const bf16*)(F.ws + WS_YA), F.lw(l, LW_UPA), RW}; pg8::EpiUpPair E{(const bf16*)(F.ws + WS_PM), (bf16*)(F.ws + WS_MIX)};
            pg8::gemm_phase(F.lds, g, S, E, F.tid);
        }
        SEAM(pb + 8);
        if (IN(pb + 9)) { FRESH();
            pg8::Gemm g{(const bf16*)(F.ws + WS_MIX), F.lw(l, LW_OUT), D}; pg8::StaticOrder S; S.init(NTOK, D, F.G, F.bid);
            pg8::EpiOut E{l == 0 ? F.in(I_X) : (const float*)F.outp(), (bf16*)(F.ws + WS_XR), F.modp(l, 0) + 2048};
            pg8::gemm_phase(F.lds, g, S, E, F.tid);
        }
        SEAM(pb + 9);
        if (IN(pb + 10)) { FRESH(); phase_router(F, l); __syncthreads(); FRESH(); convert_experts(F, l); }
        SEAM(pb + 10);
        if (IN(pb + 12)) { FRESH(); const LAS int* tb = moe_tables(F, l);
            pg8::Gemm g{(const bf16*)(F.ws + WS_H), (const bf16*)(F.ws + WS_WGU), D}; pg8::MoeOrder S{tb, F.G, F.bid, (const int*)(F.ws + WS_E2T)};
            pg8::EpiGateUp E{(bf16*)(F.ws + WS_ACT)};
            pg8::gemm_phase<pg8::EpiGateUp, pg8::MoeOrder, true, true, true>(F.lds, g, S, E, F.tid);
        }
        SEAM(pb + 12);
        if (IN(pb + 13)) { FRESH(); const LAS int* tb = moe_tables(F, l);
            pg8::Gemm g{(const bf16*)(F.ws + WS_ACT), (const bf16*)(F.ws + WS_WD), DE}; pg8::MoeOrder S{tb, F.G, F.bid, (const int*)(F.ws + WS_E2T)};
            pg8::EpiBf16<0> E{(bf16*)(F.ws + WS_YBS), D, nullptr};
            pg8::gemm_phase(F.lds, g, S, E, F.tid);
        }
        SEAM(pb + 13);
    }

template <int KSEL>
__global__ void __launch_bounds__(NTHR, 2) mk_fwd(Params prm) {
    extern __shared__ __attribute__((aligned(16))) unsigned char lds_raw[];
    Frame F; F.p = (const CAS Params*)__builtin_amdgcn_kernarg_segment_ptr(); F.lds = (LAS unsigned char*)lds_raw; F.ws = F.p->ws; F.tid = threadIdx.x; F.lane = F.tid & 63; F.wave = __builtin_amdgcn_readfirstlane(F.tid >> 6); F.G = gridDim.x; F.bid = blockIdx.x;
    if (F.tid < 64) ((LAS unsigned*)(F.lds + LDS_MISC))[F.tid] = 0u;
    __syncthreads();
    const int lo = F.p->ph_lo, hi = F.p->ph_hi;
    XcdBarrier bar; bar.bar = (unsigned*)(F.ws + WS_CTL) + CW_BAR + F.p->li * XCD_BAR_WORDS; bar.x = 0; bar.st = (volatile LAS unsigned*)(F.lds + LDS_MISC);
    if (hi - lo > 1) bar = xcd_barrier_post((unsigned*)(F.ws + WS_CTL) + CW_BAR + F.p->li * XCD_BAR_WORDS, (volatile LAS unsigned*)(F.lds + LDS_MISC));
    if (IN(0)) { FRESH(); phase_prologue(F); }
    SEAM(0);
    layer_phases<KSEL, 0>(F, bar, lo, hi);
    layer_phases<KSEL, 1>(F, bar, lo, hi);
    if (IN(N_PHASES - 1)) { FRESH(); phase_norm<true, false>(F, 0, DEPTH - 1); }

}

#if MK_N_LAUNCHES == 1
static hipError_t set_lds_attr() { return hipFuncSetAttribute((const void*)mk_fwd<-1>, hipFuncAttributeMaxDynamicSharedMemorySize, LDS_BYTES); }
#else
template <int K> static hipError_t set_lds_attr_k() { hipError_t e = hipFuncSetAttribute((const void*)mk_fwd<K>, hipFuncAttributeMaxDynamicSharedMemorySize, LDS_BYTES); if (e != hipSuccess) return e; if constexpr (K > 0) return set_lds_attr_k<K - 1>(); else return hipSuccess; }
static hipError_t set_lds_attr() { return set_lds_attr_k<PH_PER_LAYER + 1>(); }
template <int K> static void launch_kind_k(int kind, int grid, hipStream_t stream, const Params& p) {
    if (kind == K) { hipLaunchKernelGGL(mk_fwd<K>, dim3(grid), dim3(NTHR), LDS_BYTES, stream, p); return; }
    if constexpr (K > 0) launch_kind_k<K - 1>(kind, grid, stream, p);
}
static void launch_kind(int kind, int grid, hipStream_t stream, const Params& p) { launch_kind_k<PH_PER_LAYER + 1>(kind, grid, stream, p); }
#endif
extern "C" void kernel_launch(void* const* d_in, const int* in_sizes, int n_in, void* d_out, int out_size, void* d_ws, size_t ws_size, hipStream_t stream) {
    static int grid = 0;
    if (grid == 0) {
        if (n_in != 30 || in_sizes[0] != NTOK * D || out_size != NTOK * D || ws_size < WS_END) {
            fprintf(stderr, "kernel_launch: unexpected problem: n_in %d in0 %d out %d ws %zu (need %zu); nothing launched\n", n_in, n_in > 0 ? in_sizes[0] : -1, out_size, ws_size, (size_t)WS_END); grid = -1; return; }
        int dev = 0, cus = 0;
        if (hipGetDevice(&dev) != hipSuccess || hipDeviceGetAttribute(&cus, hipDeviceAttributeMultiprocessorCount, dev) != hipSuccess) { grid = -1; return; }
        if (set_lds_attr() != hipSuccess) { fprintf(stderr, "kernel_launch: hipFuncSetAttribute failed\n"); grid = -1; return; }
        (void)hipGetLastError();
        grid = cus;
    }
    if (grid < 0) return;
    (void)hipMemsetAsync((char*)d_ws + WS_CTL, 0, CTL_BYTES, stream);
    Params p{};
    for (int i = 0; i < 30; ++i) p.in[i] = (const float*)d_in[i];
    p.out = (float*)d_out; p.ws = (unsigned char*)d_ws;
#if MK_N_LAUNCHES == 1
#ifdef MK_CUTS
    { const int cuts[] = {0, MK_CUTS, N_PHASES}; const int nc = (int)(sizeof(cuts) / sizeof(int));
      for (int i = 0; i + 1 < nc; ++i) { p.ph_lo = cuts[i]; p.ph_hi = cuts[i + 1]; p.li = i; hipLaunchKernelGGL(mk_fwd<-1>, dim3(grid), dim3(NTHR), LDS_BYTES, stream, p); } }
#else
    p.ph_lo = 0; p.ph_hi = N_PHASES;
    hipLaunchKernelGGL(mk_fwd<-1>, dim3(grid), dim3(NTHR), LDS_BYTES, stream, p);
#endif
#else
    for (int k = 0; k < N_PHASES; ++k) { p.ph_lo = k; p.ph_hi = k + 1; launch_kind(KIND(k), grid, stream, p); }
#endif
}
```

```cpp
#include <hip/hip_runtime.h>
#include <cstdio>
#include <cstdint>

#ifndef MK_N_LAUNCHES
#define MK_N_LAUNCHES 1
#endif

#define LAS __attribute__((address_space(3)))
typedef unsigned short bf16;
typedef short bf16x8 __attribute__((ext_vector_type(8)));
typedef short bf16x4 __attribute__((ext_vector_type(4)));
typedef float f32x4 __attribute__((ext_vector_type(4)));
typedef float f32x16 __attribute__((ext_vector_type(16)));
typedef float f32x2 __attribute__((ext_vector_type(2)));
typedef unsigned u32x4 __attribute__((ext_vector_type(4)));
typedef unsigned u32x2 __attribute__((ext_vector_type(2)));

constexpr int NB = 2, T = 8192, D = 1024, NTOK = NB * T, DEPTH = 2;
constexpr int RW = 512, RCOLS = 1792;
constexpr int QOFF = 1792, KVOFF = 2304, GOFF = 3072;
constexpr int N1 = 3096, N1P = 3072;
constexpr int NMRG = 2048, INC = 5144;
constexpr int NE = 16, DE = 512, NSLOT = 36864;
constexpr int NCMP = 511, NCMPP = 512;

constexpr size_t MiB = 1u << 20;
constexpr size_t WS_CTL = 0, CTL_BYTES = 1 * MiB;
constexpr size_t WS_SMALL = 1 * MiB;
constexpr size_t SM_MOD = 0;
constexpr size_t SM_ROPE = 128 * 1024;
constexpr size_t SM_CMPB = 704 * 1024;
constexpr size_t SM_BLK = 720 * 1024;
constexpr size_t SM_S2T = 768 * 1024;
constexpr size_t WS_TOK = 2 * MiB;
constexpr size_t WS_W = 3 * MiB;
constexpr size_t LW_WIN1 = 0;
constexpr size_t LW_WM = LW_WIN1 + (size_t)N1P * D * 2;
constexpr size_t LW_UPA = LW_WM + (size_t)NMRG * D * 2;
constexpr size_t LW_UPB = LW_UPA + (size_t)D * RW * 2;
constexpr size_t LW_OUT = LW_UPB + (size_t)D * RW * 2;
constexpr size_t LW_C1 = LW_OUT + (size_t)D * D * 2;
constexpr size_t LW_C2 = LW_C1 + (size_t)2 * 256 * 2048 * 2;
constexpr size_t LW_L2 = LW_C2 + (size_t)2 * 64 * 256 * 2;
constexpr size_t LW_A2 = LW_L2 + (size_t)512 * 64 * 2;
constexpr size_t LW_G2 = LW_A2 + (size_t)512 * 64 * 2;
constexpr size_t LW_WG = LW_G2 + (size_t)512 * 128 * 2;
constexpr size_t LW_BYTES = ((LW_WG + (size_t)64 * 1024 * 2 + MiB - 1) / MiB) * MiB;
constexpr size_t WS_H = WS_W + 2 * LW_BYTES;
constexpr size_t WS_R = WS_H + 32 * MiB;
constexpr size_t WS_P1 = WS_R;
constexpr size_t WS_RW = WS_R + 104 * MiB;
constexpr size_t RWT = (size_t)NTOK * RW * 2;
constexpr size_t WS_NSA = WS_RW + 128 * MiB;
constexpr size_t NS_Q = WS_NSA;
constexpr size_t KVT = (size_t)4 * T * 64 * 2;
constexpr size_t NS_KS = NS_Q + 16 * MiB, NS_KW = NS_KS + KVT, NS_VST = NS_KW + KVT, NS_VWT = NS_VST + KVT, NS_KC = NS_VWT + KVT, NS_VC = NS_KC + KVT;
constexpr size_t NS_KCMP = NS_VC + KVT;
constexpr size_t NS_VCMPT = NS_KCMP + (size_t)4 * 512 * 64 * 2;
constexpr size_t NS_GATE = NS_VCMPT + (size_t)4 * 512 * 64 * 2;
constexpr size_t NS_END = NS_GATE + (size_t)NTOK * 24 * 4;
constexpr size_t WS_Y = WS_R;
constexpr size_t WS_YA = WS_R + 32 * MiB, WS_YB = WS_YA + 16 * MiB;
constexpr size_t WS_WN = WS_R + 64 * MiB;
constexpr size_t WS_UPN = WS_R + 80 * MiB;
constexpr size_t WS_GC = WS_R + 96 * MiB;
constexpr size_t WS_PT = WS_R;
constexpr size_t WS_S0 = WS_RW + 48 * MiB;
constexpr size_t WS_PM = WS_R + 64 * MiB;
constexpr size_t WS_TMP = WS_R + 128 * MiB;
constexpr size_t WS_MIX = WS_R + 160 * MiB;
constexpr size_t WS_E2T = WS_R + 32 * MiB;
constexpr size_t WS_XR = WS_R;
constexpr size_t WS_XB = WS_H;
constexpr size_t WS_ACT = WS_XB + 72 * MiB;
constexpr size_t WS_YBS = WS_ACT + 36 * MiB;
constexpr size_t WS_WGU = WS_YBS + 72 * MiB;
constexpr size_t WS_WD = WS_WGU + 32 * MiB;
constexpr size_t WS_END_MOE = WS_WD + 16 * MiB;
constexpr size_t WS_END = (NS_END > WS_END_MOE ? NS_END : WS_END_MOE);
static_assert(WS_MIX + 32 * MiB <= WS_NSA + 64 * MiB, "map");
static_assert(WS_END <= 370 * MiB, "workspace too large");

constexpr int CW_QUEUE = 256;
constexpr int CW_CNT = 512;
constexpr int CW_BAR = 4096;

typedef __bf16 bf16x2_h __attribute__((ext_vector_type(2)));
__device__ __forceinline__ unsigned pk2(float lo, float hi) { const f32x2 v = {lo, hi}; const bf16x2_h b = __builtin_convertvector(v, bf16x2_h); return __builtin_bit_cast(unsigned, b); }
__device__ __forceinline__ unsigned f2bf(float f) { return pk2(f, 0.f) & 0xffffu; }
__device__ __forceinline__ float bf2f(unsigned h) { return __builtin_bit_cast(float, h << 16); }
__device__ __forceinline__ float bflo(unsigned w) { return __builtin_bit_cast(float, w << 16); }
__device__ __forceinline__ float bfhi(unsigned w) { return __builtin_bit_cast(float, w & 0xffff0000u); }
__device__ __forceinline__ float rcpf_(float x) { return __builtin_amdgcn_rcpf(x); }
__device__ __forceinline__ float sigmoidf_(float x) { return rcpf_(1.f + __expf(-x)); }
template <int CTRL> __device__ __forceinline__ float dpp_mov(float v) { return __builtin_bit_cast(float, __builtin_amdgcn_update_dpp(0, __builtin_bit_cast(int, v), CTRL, 0xF, 0xF, true)); }
template <int M> __device__ __forceinline__ float xor_lane(float v) {
    if constexpr (M == 1) return dpp_mov<0xB1>(v); else if constexpr (M == 2) return dpp_mov<0x4E>(v); else return __shfl_xor(v, M, 64);
}
__device__ __forceinline__ float sum_halves(float v) { return v + __shfl_xor(v, 32, 64); }
__device__ __forceinline__ float max_halves(float v) { return fmaxf(v, __shfl_xor(v, 32, 64)); }
__device__ __forceinline__ float other_half(float v, int hi) { return __shfl_xor(v, 32, 64); }
__device__ __forceinline__ float sum8(float v) { v += dpp_mov<0xB1>(v); v += dpp_mov<0x4E>(v); v += dpp_mov<0x141>(v); return v; }
__device__ __forceinline__ float sum16(float v) { v = sum8(v); v += dpp_mov<0x140>(v); return v; }
__device__ __forceinline__ float sum32(float v) { v = sum16(v); v += xor_lane<16>(v); return v; }
__device__ __forceinline__ float sum64(float v) { return sum_halves(sum32(v)); }

#define XB_TMO      128
#define XB_XCNT(j)  (256  + 64 * (j))
#define XB_XSUB(j)  (1280 + 64 * (j))
#define XB_XGEN(j)  (2304 + 64 * (j))
#define XB_TOP      3328
#define XB_TOPGEN   3392
#define XCD_BAR_WORDS 3456
#define XB_SPIN_CAP (1u << 22)
__device__ __forceinline__ unsigned xb_ld(unsigned* p)              { return __hip_atomic_load(p, __ATOMIC_RELAXED, __HIP_MEMORY_SCOPE_AGENT); }
__device__ __forceinline__ unsigned xb_add(unsigned* p, unsigned v) { return __hip_atomic_fetch_add(p, v, __ATOMIC_RELAXED, __HIP_MEMORY_SCOPE_AGENT); }
__device__ __forceinline__ unsigned xb_xcc_id() { return (unsigned)__builtin_amdgcn_s_getreg((3 << 11) | 20) & 0xFu; }
#define XB_SPIN(cond, bar) do { unsigned _sp = 0; while (cond) { __builtin_amdgcn_s_sleep(1); \
    if ((++_sp & 255u) == 0u) { if (xb_ld(&(bar)[XB_TMO])) break; if (_sp > XB_SPIN_CAP) { atomicAdd(&(bar)[XB_TMO], 1u); break; } } } } while (0)
struct XcdBarrier { unsigned* bar; unsigned x; volatile LAS unsigned* st; };
__device__ __forceinline__ XcdBarrier xcd_barrier_post(unsigned* bar, volatile LAS unsigned* st) {
    XcdBarrier b; b.bar = bar; b.x = xb_xcc_id(); b.st = st;
    if (threadIdx.x == 0) (void)xb_add(&bar[XB_XCNT(b.x)], 1u);
    return b;
}
__device__ __forceinline__ void xcd_barrier_complete(unsigned* bar, unsigned x, unsigned& nloc, unsigned& nx) {
    const unsigned G = gridDim.x * gridDim.y * gridDim.z;
    unsigned sum, cnt, mine, sp = 0u;
    for (;;) {
        sum = 0u; cnt = 0u; mine = 0u;
#pragma unroll
        for (unsigned j = 0; j < 16; ++j) { const unsigned c = xb_ld(&bar[XB_XCNT(j)]); sum += c; cnt += (c > 0u) ? 1u : 0u; mine = (j == x) ? c : mine; }
        if (sum == G) break;
        __builtin_amdgcn_s_sleep(1);
        if ((++sp & 255u) == 0u) { if (xb_ld(&bar[XB_TMO])) break; if (sp > XB_SPIN_CAP) { atomicAdd(&bar[XB_TMO], 1u); break; } }
    }
    nloc = mine > 0u ? mine : 1u; nx = cnt > 0u ? cnt : 1u;
}
__device__ __forceinline__ void xcd_barrier(const XcdBarrier& b) {
    asm volatile("s_waitcnt vmcnt(0)" ::: "memory");
    __syncthreads();
    if (threadIdx.x == 0) {
        unsigned* bar = b.bar;
        __builtin_amdgcn_s_waitcnt(0);
        unsigned nloc = b.st[0], nx = b.st[1];
        if (nloc == 0u) { xcd_barrier_complete(bar, b.x, nloc, nx); b.st[0] = nloc; b.st[1] = nx; }
        const unsigned old = xb_add(&bar[XB_XSUB(b.x)], 1u);
        const unsigned gen = old / nloc;
        if (old + 1u == (gen + 1u) * nloc) {
            __builtin_amdgcn_fence(__ATOMIC_RELEASE, "agent");
            asm volatile("s_waitcnt vmcnt(0)" ::: "memory");
            const unsigned og = xb_add(&bar[XB_TOP], 1u);
            const unsigned tg = og / nx;
            if (og + 1u == (tg + 1u) * nx) xb_add(&bar[XB_TOPGEN], 1u);
            else XB_SPIN(xb_ld(&bar[XB_TOPGEN]) == tg, bar);
            __builtin_amdgcn_fence(__ATOMIC_ACQUIRE, "agent");
            xb_add(&bar[XB_XGEN(b.x)], 1u);
            asm volatile("s_waitcnt vmcnt(0)" ::: "memory");
        } else {
            XB_SPIN(xb_ld(&bar[XB_XGEN(b.x)]) == gen, bar);
            __builtin_amdgcn_fence(__ATOMIC_ACQUIRE, "agent");
            asm volatile("s_waitcnt vmcnt(0)" ::: "memory");
        }
    }
    __syncthreads();
}

namespace pg8 {
#define PG8_LAS __attribute__((address_space(3)))
typedef unsigned short bf16_t;
constexpr int BM = 256, BK = 64, HALF = 128, HTB = HALF * BK * 2, STAGE_BYTES = 8 * HTB, NXCD = 8, WGM = 8;
__host__ __device__ __forceinline__ int lds_byte(int r, int c) { const int st = (r >> 4) * 2 + (c >> 5), rr = r & 15, cc = c & 31, ob = rr * 64 + cc * 2; return st * 1024 + (ob ^ (((ob >> 9) & 1) << 5)); }
__host__ __device__ __forceinline__ void stage_rc(int b, int& R, int& C) { const int st = b / 1024, sb = b % 1024, swz = sb ^ (((sb >> 9) & 1) << 5); R = (st >> 1) * 16 + swz / 64; C = (st & 1) * 32 + (swz % 64) / 2; }
__host__ __device__ __forceinline__ int perm32(int rho) { const int n = rho >> 4, i = rho & 15; return 8 * (i >> 2) + 4 * n + (i & 3); }
struct Unit { int pm, pn, bt, part; };
struct Gemm { const bf16_t* A; const bf16_t* Bt; int K; };
struct StaticOrder {
    int nM, nN, nwg, G, c;
    __device__ void init(int M, int N, int G_, int c_) { nM = M / BM; nN = N / BM; nwg = nM * nN; G = G_; c = c_; }
    __device__ bool next(int i, Unit& u) const {
        const long L = (long)i * G + c; if (L >= nwg) return false;
        int wgid = (int)L; { const int q = nwg / NXCD, r = nwg % NXCD, xcd = wgid % NXCD, off = wgid / NXCD; wgid = (xcd < r ? xcd * (q + 1) : r * (q + 1) + (xcd - r) * q) + off; }
        const int nig = WGM * nN, gid = wgid / nig, fm = gid * WGM, gsz = (nM - fm) < WGM ? (nM - fm) : WGM;
        u.pm = fm + ((wgid % nig) % gsz); u.pn = (wgid % nig) / gsz; u.bt = u.pn; u.part = 1; return true;
    }
};
struct MergePairOrder {
    StaticOrder base;
    __device__ bool next(int i, Unit& u) const { Unit b; if (!base.next(i >> 1, b)) return false; u.pm = b.pm; u.pn = b.pn + 4 * (i & 1); u.bt = u.pn; u.part = 1; return true; }
};
struct UpPairOrder {
    StaticOrder base;
    __device__ bool next(int i, Unit& u) const { Unit b; if (!base.next(i >> 1, b)) return false; const int p = i & 1; u.pm = b.pm + 64 * p; u.pn = b.pn; u.bt = b.pn + 4 * p; u.part = p; return true; }
};
struct MoeOrder {
    const PG8_LAS int* tb; int G, c; const int* e2t;
    __device__ bool next(int i, Unit& u) const {
        const int L = i * G + c; if (L >= tb[0] * 4) return false;
        u.pm = L >> 2; u.pn = L & 3; u.bt = tb[64 + u.pm] * 4 + u.pn; u.part = 1; return true;
    }
    __device__ int row_token(int pm, int r) const {
        const int e = tb[64 + pm], p = (pm - tb[1 + e]) * BM + r;
        return p < tb[17 + e] ? ((const __attribute__((address_space(1))) int*)e2t)[e * 16384 + p] : 0;
    }
};
typedef __bf16 bf16x2_c __attribute__((ext_vector_type(2)));
__device__ __forceinline__ unsigned cvt_pk_bf16(float lo, float hi) { const f32x2 v = {lo, hi}; const bf16x2_c b = __builtin_convertvector(v, bf16x2_c); return __builtin_bit_cast(unsigned, b); }

template <class Epi, class Sched, bool ALIGN_EPI = true, bool SP2 = true, bool GATHER = false>
__device__ __forceinline__ void gemm_phase(PG8_LAS unsigned char* lds, const Gemm g, const Sched& S, const Epi& E, const int tid, const int* rowidx = nullptr) {
    static_assert(!GATHER || SP2, "gather is wired into the SP2 schedule only");
    const int wid = __builtin_amdgcn_readfirstlane(tid >> 6), lane = tid & 63, wr = wid >> 2, wc = wid & 3, fr = lane & 15, fq = lane >> 4;
    const int K = g.K, nt = K / BK;
    unsigned voffA[2], voffB[2]; int rowA[2]; unsigned colA[2];
#pragma unroll
    for (int i = 0; i < 2; ++i) { int R, C; stage_rc(tid * 16 + i * 8192, R, C); const int Rb = Epi::PERM ? ((R & ~31) + perm32(R & 31)) : R;
        voffA[i] = (unsigned)(R * K + C) * 2u; voffB[i] = (unsigned)(Rb * K + C) * 2u; rowA[i] = R; colA[i] = (unsigned)C * 2u; }
    unsigned cvo[2][2], nvo[2][2];
#define PG8_VO(dst, pmv) do { _Pragma("unroll") for (int _h = 0; _h < 2; ++_h) _Pragma("unroll") for (int _i = 0; _i < 2; ++_i) dst[_h][_i] = (unsigned)S.row_token((pmv), _h * HALF + rowA[_i]) * (unsigned)(K * 2) + colA[_i]; } while (0)
#define PG8_VOCP(dst, src) do { _Pragma("unroll") for (int _h = 0; _h < 2; ++_h) _Pragma("unroll") for (int _i = 0; _i < 2; ++_i) dst[_h][_i] = src[_h][_i]; } while (0)
    const size_t kstep = (size_t)(BK * 2);
    const size_t hstep = (size_t)HALF * K * 2;
    const size_t tstep = 2 * hstep;
    const unsigned ldsw = (unsigned)wid * 1024u;
    const int aoff = lds_byte(wr * 64 + fr, fq * 8), boff = lds_byte(wc * 32 + fr, fq * 8);
#define PG8_SA(b, h) (((b) * 2 + (h)) * HTB)
#define PG8_SB(b, h) ((4 + (b) * 2 + (h)) * HTB)
#define PG8_STAGE(bufoff, gbase, voff) do { _Pragma("unroll") for (int _i = 0; _i < 2; ++_i) \
        __builtin_amdgcn_global_load_lds((const unsigned*)((const char*)(gbase) + (voff)[_i]), (PG8_LAS unsigned*)(lds + (bufoff) + ldsw + _i * 8192), 16, 0, 0); } while (0)
#define PG8_STAGE_A(bufoff, kb, h, nx) do { if constexpr (GATHER) { const unsigned vo_[2] = {(nx) ? nvo[h][0] : cvo[h][0], (nx) ? nvo[h][1] : cvo[h][1]}; PG8_STAGE(bufoff, kb, vo_); } \
        else { PG8_STAGE(bufoff, (kb) + (h) * hstep, voffA); } } while (0)
#define PG8_LDA(dst, b, h) do { _Pragma("unroll") for (int m = 0; m < 4; ++m) _Pragma("unroll") for (int k = 0; k < 2; ++k) dst[m][k] = *(const PG8_LAS bf16x8*)(lds + PG8_SA(b, h) + aoff + m * 2048 + k * 1024); } while (0)
#define PG8_LDB(dst, b, h) do { _Pragma("unroll") for (int n = 0; n < 2; ++n) _Pragma("unroll") for (int k = 0; k < 2; ++k) dst[n][k] = *(const PG8_LAS bf16x8*)(lds + PG8_SB(b, h) + boff + n * 2048 + k * 1024); } while (0)
#define PG8_MMA(ai, bj, At, Bt) do { __builtin_amdgcn_s_setprio(1); _Pragma("unroll") for (int m = 0; m < 4; ++m) _Pragma("unroll") for (int n = 0; n < 2; ++n) _Pragma("unroll") for (int k = 0; k < 2; ++k) \
        acc[ai][bj][m][n] = __builtin_amdgcn_mfma_f32_16x16x32_bf16(Bt[n][k], At[m][k], acc[ai][bj][m][n], 0, 0, 0); __builtin_amdgcn_s_setprio(0); } while (0)
#define PG8_WAIT_V(n) asm volatile("s_waitcnt vmcnt(" #n ")" ::: "memory")
#define PG8_WAIT_L(n) asm volatile("s_waitcnt lgkmcnt(" #n ")" ::: "memory")
#define PG8_BAR __builtin_amdgcn_s_barrier()
#define PG8_SCHED __builtin_amdgcn_sched_barrier(0)
    Unit cur, nxt; int ui = 0; bool has_next = false;
    if (!S.next(0, cur)) return;
    if constexpr (GATHER) { PG8_VO(cvo, cur.pm); has_next = S.next(1, nxt); if (has_next) PG8_VO(nvo, nxt.pm); else PG8_VOCP(nvo, cvo); }
    f32x4 acc[2][2][4][2];
#pragma unroll
    for (int a = 0; a < 2; ++a)
#pragma unroll
        for (int b = 0; b < 2; ++b)
#pragma unroll
            for (int m = 0; m < 4; ++m)
#pragma unroll
                for (int n = 0; n < 2; ++n) acc[a][b][m][n] = (f32x4){0.f, 0.f, 0.f, 0.f};
    bf16x8 At[4][2], B0[2][2], B1[2][2];
    const char* cA = (const char*)g.A + (GATHER ? (size_t)0 : (size_t)cur.pm * tstep); const char* cB = (const char*)g.Bt + (size_t)cur.bt * tstep;
    if constexpr (SP2) {
        PG8_STAGE(PG8_SB(0, 0), cB, voffB); PG8_STAGE(PG8_SB(0, 1), cB + hstep, voffB); PG8_STAGE_A(PG8_SA(0, 0), cA, 0, false); PG8_STAGE_A(PG8_SA(0, 1), cA, 1, false);
        if (wr == 1) PG8_BAR;
        PG8_WAIT_V(2); PG8_BAR;
        PG8_STAGE(PG8_SB(1, 0), cB + kstep, voffB); PG8_STAGE_A(PG8_SA(1, 0), cA + kstep, 0, false); PG8_STAGE(PG8_SB(1, 1), cB + hstep + kstep, voffB);
        PG8_WAIT_V(6); PG8_BAR;
    } else {
        PG8_STAGE(PG8_SB(0, 0), cB, voffB); PG8_STAGE(PG8_SA(0, 0), cA, voffA); PG8_STAGE(PG8_SB(0, 1), cB + hstep, voffB); PG8_STAGE(PG8_SA(0, 1), cA + hstep, voffA);
        if (wr == 1) PG8_BAR;
        PG8_WAIT_V(4); PG8_BAR;
        PG8_STAGE(PG8_SB(1, 0), cB + kstep, voffB); PG8_STAGE(PG8_SA(1, 0), cA + kstep, voffA); PG8_STAGE(PG8_SB(1, 1), cB + hstep + kstep, voffB);
        PG8_WAIT_V(6); PG8_BAR;
    }
    for (;;) {
        if constexpr (!GATHER) has_next = S.next(ui + 1, nxt);
        const char* nA = (has_next && !GATHER) ? (const char*)g.A + (size_t)nxt.pm * tstep : cA; const char* nB = has_next ? (const char*)g.Bt + (size_t)nxt.bt * tstep : cB;
        for (int t = 0; t < nt; t += 2) {
            const bool last = (t == nt - 2);
            const char* a1 = cA + (size_t)(t + 1) * kstep;
            const char* a2 = last ? nA : cA + (size_t)(t + 2) * kstep; const char* b2 = last ? nB : cB + (size_t)(t + 2) * kstep;
            const char* a3 = a2 + kstep; const char* b3 = b2 + kstep;
            if constexpr (SP2) {
            PG8_LDB(B0, 0, 0); PG8_LDB(B1, 0, 1); PG8_SCHED; PG8_LDA(At, 0, 0); PG8_STAGE_A(PG8_SA(1, 1), a1, 1, false);
            PG8_WAIT_V(8); PG8_WAIT_L(0); PG8_BAR; PG8_MMA(0, 0, At, B0); PG8_MMA(0, 1, At, B1); PG8_BAR; PG8_SCHED;
            PG8_LDA(At, 0, 1); PG8_STAGE(PG8_SB(0, 0), b2, voffB); PG8_STAGE(PG8_SB(0, 1), b2 + hstep, voffB); PG8_STAGE_A(PG8_SA(0, 0), a2, 0, last);
            PG8_WAIT_V(8); PG8_WAIT_L(0); PG8_BAR; PG8_MMA(1, 0, At, B0); PG8_MMA(1, 1, At, B1); PG8_BAR; PG8_SCHED;
            PG8_LDB(B0, 1, 0); PG8_LDB(B1, 1, 1); PG8_SCHED; PG8_LDA(At, 1, 0); PG8_STAGE_A(PG8_SA(0, 1), a2, 1, last);
            PG8_WAIT_V(8); PG8_WAIT_L(0); PG8_BAR; PG8_MMA(0, 0, At, B0); PG8_MMA(0, 1, At, B1); PG8_BAR; PG8_SCHED;
            PG8_LDA(At, 1, 1); PG8_STAGE(PG8_SB(1, 0), b3, voffB); PG8_STAGE(PG8_SB(1, 1), b3 + hstep, voffB); PG8_STAGE_A(PG8_SA(1, 0), a3, 0, last);
            PG8_WAIT_V(8); PG8_WAIT_L(0); PG8_BAR; PG8_MMA(1, 0, At, B0); PG8_MMA(1, 1, At, B1); PG8_BAR; PG8_SCHED;
            } else {
            PG8_LDB(B0, 0, 0); PG8_SCHED; PG8_LDA(At, 0, 0); PG8_STAGE(PG8_SA(1, 1), a1 + hstep, voffA);
            PG8_WAIT_L(8); PG8_BAR; PG8_WAIT_L(0); PG8_MMA(0, 0, At, B0); PG8_BAR; PG8_SCHED;
            PG8_LDB(B1, 0, 1); PG8_STAGE(PG8_SB(0, 0), b2, voffB);
            PG8_BAR; PG8_WAIT_L(0); PG8_MMA(0, 1, At, B1); PG8_BAR;
            PG8_LDA(At, 0, 1); PG8_STAGE(PG8_SA(0, 0), a2, voffA);
            PG8_BAR; PG8_WAIT_L(0); PG8_MMA(1, 0, At, B0); PG8_BAR; PG8_SCHED;
            PG8_STAGE(PG8_SB(0, 1), b2 + hstep, voffB);
            PG8_WAIT_V(6); PG8_BAR; PG8_MMA(1, 1, At, B1); PG8_BAR;
            PG8_LDB(B0, 1, 0); PG8_SCHED; PG8_LDA(At, 1, 0); PG8_STAGE(PG8_SA(0, 1), a2 + hstep, voffA);
            PG8_WAIT_L(8); PG8_BAR; PG8_WAIT_L(0); PG8_MMA(0, 0, At, B0); PG8_BAR; PG8_SCHED;
            PG8_LDB(B1, 1, 1); PG8_STAGE(PG8_SB(1, 0), b3, voffB);
            PG8_BAR; PG8_WAIT_L(0); PG8_MMA(0, 1, At, B1); PG8_BAR;
            PG8_LDA(At, 1, 1); PG8_STAGE(PG8_SA(1, 0), a3, voffA);
            PG8_BAR; PG8_WAIT_L(0); PG8_MMA(1, 0, At, B0); PG8_BAR; PG8_SCHED;
            PG8_STAGE(PG8_SB(1, 1), b3 + hstep, voffB);
            PG8_WAIT_V(6); PG8_BAR; PG8_MMA(1, 1, At, B1); PG8_BAR;
            }
        }
        Unit nn = nxt; bool has_nn = false; unsigned nnvo[2][2];
        if constexpr (GATHER) { has_nn = has_next && S.next(ui + 2, nn); if (has_nn) PG8_VO(nnvo, nn.pm); else PG8_VOCP(nnvo, nvo); }
        if constexpr (ALIGN_EPI) { if (wr == 0) PG8_BAR; }
        bool keep = false;
        if constexpr (Epi::PAIRED) { if (cur.part == 0) { E.mid(acc, cur, wr, wc, fr, fq); keep = true; } }
        if (!keep) E(acc, cur, wr, wc, fr, fq);
        if (!has_next) break;
        if (!keep) {
#pragma unroll
        for (int a = 0; a < 2; ++a)
#pragma unroll
            for (int b = 0; b < 2; ++b)
#pragma unroll
                for (int m = 0; m < 4; ++m)
#pragma unroll
                    for (int n = 0; n < 2; ++n) acc[a][b][m][n] = (f32x4){0.f, 0.f, 0.f, 0.f};
        }
        cur = nxt; cA = nA; cB = nB; ++ui;
        if constexpr (GATHER) { PG8_VOCP(cvo, nvo); PG8_VOCP(nvo, nnvo); nxt = nn; has_next = has_nn; }
        if constexpr (ALIGN_EPI) { if (wr == 1) PG8_BAR; }
    }
    PG8_WAIT_V(0);
    if constexpr (!ALIGN_EPI) { if (wr == 0) PG8_BAR; }
    PG8_BAR;
#undef PG8_SA
#undef PG8_SB
#undef PG8_STAGE
#undef PG8_LDA
#undef PG8_STAGE_A
#undef PG8_VO
#undef PG8_VOCP
#undef PG8_LDB
#undef PG8_MMA
#undef PG8_WAIT_V
#undef PG8_WAIT_L
#undef PG8_BAR
#undef PG8_SCHED
}

template <int ACT  > struct EpiBf16 {
    static constexpr bool PERM = true, PAIRED = false;
    bf16_t* O; int ldc; const float* bias;
    __device__ __forceinline__ void operator()(const f32x4 (&acc)[2][2][4][2], const Unit& u, int wr, int wc, int fr, int fq) const {
        const int row0 = u.pm * BM + wr * 64 + fr; const int col0 = u.pn * BM + wc * 32 + 8 * fq;
        f32x4 bv[2][2];
#pragma unroll
        for (int bj = 0; bj < 2; ++bj)
#pragma unroll
            for (int n = 0; n < 2; ++n) bv[bj][n] = bias ? *(const f32x4*)(bias + col0 + bj * HALF + 4 * n) : (f32x4){0.f, 0.f, 0.f, 0.f};
#pragma unroll
        for (int ai = 0; ai < 2; ++ai)
#pragma unroll
            for (int m = 0; m < 4; ++m) { bf16_t* rowp = O + (size_t)(row0 + ai * HALF + m * 16) * ldc + col0;
#pragma unroll
                for (int bj = 0; bj < 2; ++bj) { f32x4 v0 = acc[ai][bj][m][0] + bv[bj][0], v1 = acc[ai][bj][m][1] + bv[bj][1];
                    if (ACT == 1) {
#pragma unroll
                        for (int j = 0; j < 4; ++j) { v0[j] = __builtin_amdgcn_rcpf(1.f + __expf(-v0[j])); v1[j] = __builtin_amdgcn_rcpf(1.f + __expf(-v1[j])); } }
                    u32x4 w; w.x = cvt_pk_bf16(v0[0], v0[1]); w.y = cvt_pk_bf16(v0[2], v0[3]); w.z = cvt_pk_bf16(v1[0], v1[1]); w.w = cvt_pk_bf16(v1[2], v1[3]);
                    *(u32x4*)(rowp + bj * HALF) = w; } }
    }
};
template <int MODE> struct EpiUp {
    static constexpr bool PERM = true, PAIRED = false;
    const bf16_t* PMg; bf16_t* TMP; bf16_t* MIX;
    __device__ __forceinline__ void operator()(const f32x4 (&acc)[2][2][4][2], const Unit& u, int wr, int wc, int fr, int fq) const {
        const int row0 = u.pm * BM + wr * 64 + fr; const int col0 = u.pn * BM + wc * 32 + 8 * fq;
#pragma unroll
        for (int ai = 0; ai < 2; ++ai)
#pragma unroll
            for (int m = 0; m < 4; ++m) { const size_t row = (size_t)(row0 + ai * HALF + m * 16);
#pragma unroll
                for (int bj = 0; bj < 2; ++bj) { const int col = col0 + bj * HALF;
                    const u32x4 gw = *(const u32x4*)(PMg + row * NMRG + (MODE ? 1024 : 0) + col);
                    float gt[8] = {bflo(gw.x), bfhi(gw.x), bflo(gw.y), bfhi(gw.y), bflo(gw.z), bfhi(gw.z), bflo(gw.w), bfhi(gw.w)};
                    float v[8];
#pragma unroll
                    for (int j = 0; j < 4; ++j) { v[j] = acc[ai][bj][m][0][j] * gt[j]; v[4 + j] = acc[ai][bj][m][1][j] * gt[4 + j]; }
                    if (MODE == 1) { const u32x4 tw = *(const u32x4*)(TMP + row * D + col);
                        v[0] += bflo(tw.x); v[1] += bfhi(tw.x); v[2] += bflo(tw.y); v[3] += bfhi(tw.y); v[4] += bflo(tw.z); v[5] += bfhi(tw.z); v[6] += bflo(tw.w); v[7] += bfhi(tw.w); }
                    u32x4 w; w.x = cvt_pk_bf16(v[0], v[1]); w.y = cvt_pk_bf16(v[2], v[3]); w.z = cvt_pk_bf16(v[4], v[5]); w.w = cvt_pk_bf16(v[6], v[7]);
                    *(u32x4*)((MODE ? MIX : TMP) + row * D + col) = w; } }
    }
};
struct EpiUpPair {
    static constexpr bool PERM = true, PAIRED = true;
    const bf16_t* PMg; bf16_t* MIX;
    __device__ __forceinline__ void mid(f32x4 (&acc)[2][2][4][2], const Unit& u, int wr, int wc, int fr, int fq) const {
        const int row0 = u.pm * BM + wr * 64 + fr; const int col0 = u.pn * BM + wc * 32 + 8 * fq;
#pragma unroll
        for (int ai = 0; ai < 2; ++ai)
#pragma unroll
            for (int m = 0; m < 4; ++m) { const size_t row = (size_t)(row0 + ai * HALF + m * 16);
#pragma unroll
                for (int bj = 0; bj < 2; ++bj) { const int col = col0 + bj * HALF;
                    const u32x4 ga = *(const u32x4*)(PMg + row * NMRG + col), gb = *(const u32x4*)(PMg + row * NMRG + 1024 + col);
                    const float na[8] = {bflo(ga.x), bfhi(ga.x), bflo(ga.y), bfhi(ga.y), bflo(ga.z), bfhi(ga.z), bflo(ga.w), bfhi(ga.w)};
                    const float nb[8] = {bflo(gb.x), bfhi(gb.x), bflo(gb.y), bfhi(gb.y), bflo(gb.z), bfhi(gb.z), bflo(gb.w), bfhi(gb.w)};
#pragma unroll
                    for (int j = 0; j < 4; ++j) { acc[ai][bj][m][0][j] *= na[j] * __builtin_amdgcn_rcpf(nb[j]); acc[ai][bj][m][1][j] *= na[4 + j] * __builtin_amdgcn_rcpf(nb[4 + j]); } } }
    }
    __device__ __forceinline__ void operator()(const f32x4 (&acc)[2][2][4][2], const Unit& u, int wr, int wc, int fr, int fq) const {
        const int row0 = (u.pm - 64) * BM + wr * 64 + fr; const int col0 = u.pn * BM + wc * 32 + 8 * fq;
#pragma unroll
        for (int ai = 0; ai < 2; ++ai)
#pragma unroll
            for (int m = 0; m < 4; ++m) { const size_t row = (size_t)(row0 + ai * HALF + m * 16);
#pragma unroll
                for (int bj = 0; bj < 2; ++bj) { const int col = col0 + bj * HALF;
                    const u32x4 gb = *(const u32x4*)(PMg + row * NMRG + 1024 + col);
                    const float nb[8] = {bflo(gb.x), bfhi(gb.x), bflo(gb.y), bfhi(gb.y), bflo(gb.z), bfhi(gb.z), bflo(gb.w), bfhi(gb.w)};
                    u32x4 w; w.x = cvt_pk_bf16(acc[ai][bj][m][0][0] * nb[0], acc[ai][bj][m][0][1] * nb[1]); w.y = cvt_pk_bf16(acc[ai][bj][m][0][2] * nb[2], acc[ai][bj][m][0][3] * nb[3]);
                    w.z = cvt_pk_bf16(acc[ai][bj][m][1][0] * nb[4], acc[ai][bj][m][1][1] * nb[5]); w.w = cvt_pk_bf16(acc[ai][bj][m][1][2] * nb[6], acc[ai][bj][m][1][3] * nb[7]);
                    *(u32x4*)(MIX + row * D + col) = w; } }
    }
};
struct EpiOut {
    static constexpr bool PERM = true, PAIRED = false;
    const float* Xin; bf16_t* Xout; const float* gate;
    __device__ __forceinline__ void operator()(const f32x4 (&acc)[2][2][4][2], const Unit& u, int wr, int wc, int fr, int fq) const {
        const int row0 = u.pm * BM + wr * 64 + fr, col0 = u.pn * BM + wc * 32 + 8 * fq;
        const float* gp = gate + (size_t)((u.pm * BM) / T) * 6144;
        f32x4 gv[2][2];
#pragma unroll
        for (int bj = 0; bj < 2; ++bj)
#pragma unroll
            for (int n = 0; n < 2; ++n) gv[bj][n] = *(const f32x4*)(gp + col0 + bj * HALF + n * 4);
#pragma unroll
        for (int ai = 0; ai < 2; ++ai)
#pragma unroll
            for (int m = 0; m < 4; ++m) { const size_t ro = (size_t)(row0 + ai * HALF + m * 16) * D + col0;
#pragma unroll
                for (int bj = 0; bj < 2; ++bj) {
                    const f32x4 r0 = *(const f32x4*)(Xin + ro + bj * HALF) + gv[bj][0] * acc[ai][bj][m][0], r1 = *(const f32x4*)(Xin + ro + bj * HALF + 4) + gv[bj][1] * acc[ai][bj][m][1];
                    u32x4 w; w.x = cvt_pk_bf16(r0[0], r0[1]); w.y = cvt_pk_bf16(r0[2], r0[3]); w.z = cvt_pk_bf16(r1[0], r1[1]); w.w = cvt_pk_bf16(r1[2], r1[3]);
                    *(u32x4*)(Xout + ro + bj * HALF) = w; } }
    }
};
struct EpiGateUp {
    static constexpr bool PERM = true, PAIRED = false;
    bf16_t* ACT;
    __device__ __forceinline__ void operator()(const f32x4 (&acc)[2][2][4][2], const Unit& u, int wr, int wc, int fr, int fq) const {
        const int row0 = u.pm * BM + wr * 64 + fr; const int col0 = u.pn * HALF + wc * 32 + 8 * fq;
#pragma unroll
        for (int ai = 0; ai < 2; ++ai)
#pragma unroll
            for (int m = 0; m < 4; ++m) { bf16_t* rowp = ACT + (size_t)(row0 + ai * HALF + m * 16) * DE + col0;
                float v[8];
#pragma unroll
                for (int n = 0; n < 2; ++n)
#pragma unroll
                    for (int j = 0; j < 4; ++j) { const float gq = acc[ai][0][m][n][j], uq = acc[ai][1][m][n][j]; v[4 * n + j] = gq * __builtin_amdgcn_rcpf(1.f + __expf(-gq)) * uq; }
                u32x4 w; w.x = cvt_pk_bf16(v[0], v[1]); w.y = cvt_pk_bf16(v[2], v[3]); w.z = cvt_pk_bf16(v[4], v[5]); w.w = cvt_pk_bf16(v[6], v[7]);
                *(u32x4*)rowp = w; }
    }
};
}

constexpr int NTHR = 512, NWAVE = 8;
constexpr int LDS_BYTES = 147456;
constexpr int LDS_MISC = 143360;
struct Params { const float* in[30]; float* out; unsigned char* ws; int ph_lo, ph_hi, li, pad; };
enum { I_X = 0, I_C, I_WADA, I_BADA, I_NORMG, I_WIN, I_BIN, I_MU, I_W0, I_W2, I_A0, I_A2, I_G2, I_KK, I_KA, I_RK, I_GNG, I_GNB, I_QKG, I_CPOS, I_CW1, I_CW2, I_UPA, I_UPB, I_WOUT, I_RTW, I_RTB, I_EG, I_EU, I_ED };

#define CAS __attribute__((address_space(4)))
#define GAS __attribute__((address_space(1)))
template <class T> __device__ __forceinline__ T* as_global(T* p) { return (T*)(GAS T*)p; }
struct Frame {
    const CAS Params* p; LAS unsigned char* lds; unsigned char* ws; int tid, lane, wave, G, bid;
    __device__ __forceinline__ const float* in(int i) const { return as_global(p->in[i]); }
    __device__ __forceinline__ float* outp() const { return as_global(p->out); }
    __device__ __forceinline__ float* modp(int l, int b) const { return (float*)(ws + WS_SMALL + SM_MOD) + ((size_t)l * 2 + b) * 6144; }
    __device__ __forceinline__ bf16* lw(int l, size_t off) const { return (bf16*)(ws + WS_W + (size_t)l * LW_BYTES + off); }
};

__device__ __forceinline__ Frame relaunder(const Frame& F0) {
    Frame F = F0; int t_ = F0.tid; GAS unsigned char* w_ = (GAS unsigned char*)F0.ws; asm volatile("" : "+v"(t_), "+s"(w_)); F.tid = t_; F.lane = t_ & 63; F.wave = __builtin_amdgcn_readfirstlane(t_ >> 6); F.ws = (unsigned char*)w_; return F;
}
template <class RowMap>
__device__ __forceinline__ void xpose_job(const Frame& F, const float* src, int ld, int K, int c0, int nvalid, int npad, bf16* dst, RowMap rm, int& rot) {
    const int kparts = (K >= 512) ? 4 : 1, kspan = K / kparts, kw = kspan >> 3;
    const int nunit = (npad >> 6) * kparts;
    int start = (F.bid + F.G - (rot % F.G)) % F.G;
    for (int t = start; t < nunit; t += F.G) {
        const int kp = t % kparts, n_i = t / kparts;
        const int n = n_i * 64 + F.lane; const bool valid = n < nvalid;
        const float* sp = src + (size_t)(kp * kspan + F.wave * kw) * ld + c0 + n;
        bf16* dp = dst + (size_t)(rm(n_i) + F.lane) * K + kp * kspan + F.wave * kw;
#pragma unroll 2
        for (int k = 0; k < kw; k += 8) {
            float v[8];
#pragma unroll
            for (int j = 0; j < 8; ++j) v[j] = valid ? sp[(size_t)(k + j) * ld] : 0.f;
            u32x4 w; w.x = pk2(v[0], v[1]); w.y = pk2(v[2], v[3]); w.z = pk2(v[4], v[5]); w.w = pk2(v[6], v[7]);
            *(u32x4*)(dp + k) = w;
        }
    }
    rot += nunit;
}
struct RmId { __device__ int operator()(int n_i) const { return n_i * 64; } };
struct RmGate { int up; __device__ int operator()(int n_i) const { return 256 * (n_i >> 1) + 64 * (n_i & 1) + (up ? 128 : 0); } };

__device__ __forceinline__ double sin_poly(double x) {
    const double x2 = x * x; double term = x, sum = x;
#pragma unroll
    for (int k = 1; k <= 14; ++k) { term *= -x2 / (double)((2 * k) * (2 * k + 1)); sum += term; }
    return sum;
}
__device__ __forceinline__ double cos_poly(double x) {
    const double x2 = x * x; double term = 1.0, sum = 1.0;
#pragma unroll
    for (int k = 1; k <= 14; ++k) { term *= -x2 / (double)((2 * k - 1) * (2 * k)); sum += term; }
    return sum;
}

__device__ __forceinline__ void phase_prologue(const Frame& F) {
    const int tid = F.tid, G = F.G, bid = F.bid;
    {
        const double invf[8] = {1.0, 0.19392274474868576, 0.03760603093086393, 0.007292664737217109, 0.001414213562373095, 0.0002742481756762073, 5.318295896944988e-05, 1.031338537721246e-05};
        float* rope = (float*)(F.ws + WS_SMALL + SM_ROPE);
        for (int idx = bid * NTHR + tid; idx < T * 8; idx += G * NTHR) {
            const int t = idx >> 3, i = idx & 7;
            double fr = 1.0;
#pragma unroll
            for (int q = 0; q < 8; ++q) fr = (i == q) ? invf[q] : fr;
            double a = (double)t * fr; double r = a * 0.15915494309189535; r -= __builtin_floor(r + 0.5);
            const double x = r * 6.283185307179586;
            rope[t * 16 + i] = (float)cos_poly(x); rope[t * 16 + 8 + i] = (float)sin_poly(x);
        }
    }
    {
        LAS float* sc = (LAS float*)F.lds;
        LAS float* red = sc + 2048;
        for (int i = tid; i < 2048; i += NTHR) { const float cv = F.in(I_C)[i]; sc[i] = cv / (1.f + __expf(-cv)); }
        __syncthreads();
        for (int u = bid; u < 192; u += G) {
            const int l = u / 96, c0 = (u % 96) * 64, col = c0 + F.lane;
            const float* wp = F.in(I_WADA) + (size_t)l * D * 6144 + col;
            float a0 = 0.f, a1 = 0.f;
            const int kb = F.wave * 128;
#pragma unroll 8
            for (int k = 0; k < 128; ++k) { const float wv = wp[(size_t)(kb + k) * 6144]; a0 += sc[kb + k] * wv; a1 += sc[1024 + kb + k] * wv; }
            red[(F.wave * 2 + 0) * 64 + F.lane] = a0; red[(F.wave * 2 + 1) * 64 + F.lane] = a1;
            __syncthreads();
            if (tid < 128) { const int b = tid >> 6, ln = tid & 63; float s = 0.f;
#pragma unroll
                for (int w = 0; w < 8; ++w) s += red[(w * 2 + b) * 64 + ln];
                F.modp(l, b)[c0 + ln] = s + F.in(I_BADA)[l * 6144 + c0 + ln]; }
            __syncthreads();
        }
    }
    {
        LAS float* red = (LAS float*)F.lds;
        for (int u = bid; u < 16; u += G) {
            const int li = u >> 2, q = u & 3, c = tid & 255, hf = tid >> 8;
            const float* pos = F.in(I_CPOS) + (size_t)li * 2048 + q * 512 + hf * 256;
            const float* w1 = F.in(I_CW1) + (size_t)li * 2048 * 256 + (size_t)(q * 512 + hf * 256) * 256 + c;
            float a = 0.f;
#pragma unroll 8
            for (int j = 0; j < 256; ++j) a += pos[j] * w1[(size_t)j * 256];
            red[tid] = a; __syncthreads();
            if (tid < 256) ((float*)(F.ws + WS_SMALL + SM_CMPB))[(li * 4 + q) * 256 + tid] = red[tid] + red[tid + 256];
            __syncthreads();
        }
    }
}
__device__ __forceinline__ void phase_convert_weights(const Frame& F) {
    int rot = 0;
#pragma unroll 1
    for (int jj = 0; jj < DEPTH * 13; ++jj) {
        const int l = jj / 13, j = jj - l * 13;
        const float* src; int ld, K, c0 = 0, nvalid, npad; bf16* dst;
        if (j == 0)      { src = F.in(I_WIN) + (size_t)l * D * INC; ld = INC; K = D; nvalid = N1P; npad = N1P; dst = F.lw(l, LW_WIN1); }
        else if (j == 1) { src = F.in(I_WIN) + (size_t)l * D * INC; ld = INC; K = D; c0 = N1; nvalid = NMRG; npad = NMRG; dst = F.lw(l, LW_WM); }
        else if (j == 2) { src = F.in(I_UPA) + (size_t)l * RW * D; ld = D; K = RW; nvalid = D; npad = D; dst = F.lw(l, LW_UPA); }
        else if (j == 3) { src = F.in(I_UPB) + (size_t)l * RW * D; ld = D; K = RW; nvalid = D; npad = D; dst = F.lw(l, LW_UPB); }
        else if (j == 4) { src = F.in(I_WOUT) + (size_t)l * D * D; ld = D; K = D; nvalid = D; npad = D; dst = F.lw(l, LW_OUT); }
        else if (j <= 6) { const int i = j - 5; src = F.in(I_CW1) + (size_t)(l * 2 + i) * 2048 * 256; ld = 256; K = 2048; nvalid = 256; npad = 256; dst = F.lw(l, LW_C1) + (size_t)i * 256 * 2048; }
        else if (j <= 8) { const int i = j - 7; src = F.in(I_CW2) + (size_t)(l * 2 + i) * 256 * 64; ld = 64; K = 256; nvalid = 64; npad = 64; dst = F.lw(l, LW_C2) + (size_t)i * 64 * 256; }
        else if (j == 9) { src = F.in(I_W2) + (size_t)l * 64 * RW; ld = RW; K = 64; nvalid = RW; npad = RW; dst = F.lw(l, LW_L2); }
        else if (j == 10) { src = F.in(I_A2) + (size_t)l * 64 * RW; ld = RW; K = 64; nvalid = RW; npad = RW; dst = F.lw(l, LW_A2); }
        else if (j == 11) { src = F.in(I_G2) + (size_t)l * 128 * RW; ld = RW; K = 128; nvalid = RW; npad = RW; dst = F.lw(l, LW_G2); }
        else { src = F.in(I_WIN) + (size_t)l * D * INC; ld = INC; K = D; c0 = N1P; nvalid = 24; npad = 64; dst = F.lw(l, LW_WG); }
        xpose_job(F, src, ld, K, c0, nvalid, npad, dst, RmId{}, rot);
    }
}
__device__ __forceinline__ void convert_experts(const Frame& F, int l) {
    int rot = 0;
    for (int e = 0; e < NE; ++e) {
        bf16* wgu = (bf16*)(F.ws + WS_WGU) + (size_t)e * 1024 * 1024;
        xpose_job(F, F.in(I_EG) + ((size_t)l * NE + e) * D * DE, DE, D, 0, DE, DE, wgu, RmGate{0}, rot);
        xpose_job(F, F.in(I_EU) + ((size_t)l * NE + e) * D * DE, DE, D, 0, DE, DE, wgu, RmGate{1}, rot);
        xpose_job(F, F.in(I_ED) + ((size_t)l * NE + e) * DE * D, D, DE, 0, D, D, (bf16*)(F.ws + WS_WD) + (size_t)e * 1024 * 512, RmId{}, rot);
    }
}

constexpr int LDS_MOETB = LDS_MISC + 1024;
__device__ __forceinline__ LAS int* moe_tables(const Frame& F, int l) {
    LAS int* tb = (LAS int*)(F.lds + LDS_MOETB);
    if (F.tid < NE) tb[17 + F.tid] = (int)__hip_atomic_load((const unsigned*)(F.ws + WS_CTL) + CW_CNT + 64 * l + F.tid, __ATOMIC_RELAXED, __HIP_MEMORY_SCOPE_AGENT);
    __syncthreads();
    if (F.tid == 0) { int nb = 0;
        for (int e = 0; e < NE; ++e) { tb[1 + e] = nb; nb += (tb[17 + e] + 255) >> 8; }
        tb[0] = nb; }
    __syncthreads();
    if (F.tid < tb[0]) { int e = 0;
#pragma unroll
        for (int q = 1; q < NE; ++q) e += (tb[1 + q] <= F.tid) ? 1 : 0;
        tb[64 + F.tid] = e; }
    __syncthreads();
    return tb;
}

template <bool COMBINE, bool NORM, bool FROM_OUT = false>
__device__ __forceinline__ void phase_norm(const Frame& F, int l, int lc) {
    const float* xin = (COMBINE || FROM_OUT) ? F.outp() : F.in(I_X);
    bf16* H = (bf16*)(F.ws + WS_H);
    const int* texp = (const int*)(F.ws + WS_TOK); const int* tpos = (const int*)(F.ws + WS_TOK + 131072); const float* tw = (const float*)(F.ws + WS_TOK + 2 * 131072);
    const LAS int* tb = COMBINE ? moe_tables(F, lc) : nullptr;
    const bf16* yb = (const bf16*)(F.ws + WS_YBS);
    constexpr int RB = COMBINE ? 2 : 4;
    const int rstride = F.G * NWAVE;
    for (int nb = F.bid * NWAVE + F.wave; nb < NTOK; nb += rstride * RB) {
        f32x4 xv[RB][4]; u32x2 y0[RB][4], y1[RB][4]; float w0[RB], w1[RB];
#pragma unroll
        for (int r = 0; r < RB; ++r) { const int n = (nb + r * rstride < NTOK) ? nb + r * rstride : nb;
#pragma unroll
            for (int j = 0; j < 4; ++j) {
                if (COMBINE) { const u32x2 xr = *(const u32x2*)((const bf16*)(F.ws + WS_XR) + (size_t)n * D + 4 * F.lane + 256 * j); xv[r][j] = (f32x4){bflo(xr.x), bfhi(xr.x), bflo(xr.y), bfhi(xr.y)}; }
                else xv[r][j] = *(const f32x4*)(xin + (size_t)n * D + 4 * F.lane + 256 * j); }
            if (COMBINE) { const int s0 = tb[1 + texp[n * 2]] * 256 + tpos[n * 2], s1 = tb[1 + texp[n * 2 + 1]] * 256 + tpos[n * 2 + 1]; w0[r] = tw[n * 2]; w1[r] = tw[n * 2 + 1];
#pragma unroll
                for (int j = 0; j < 4; ++j) { const int c = 4 * F.lane + 256 * j; y0[r][j] = *(const u32x2*)(yb + (size_t)s0 * D + c); y1[r][j] = *(const u32x2*)(yb + (size_t)s1 * D + c); } }
        }
#pragma unroll
        for (int r = 0; r < RB; ++r) { const int n = (nb + r * rstride < NTOK) ? nb + r * rstride : nb; const int b = n / T;
            if (COMBINE) {
                const float* gf = F.modp(lc, b) + 5120;
#pragma unroll
                for (int j = 0; j < 4; ++j) {
                    const int c = 4 * F.lane + 256 * j;
                    const f32x4 gv = *(const f32x4*)(gf + c);
                    xv[r][j][0] += gv[0] * (w0[r] * bflo(y0[r][j].x) + w1[r] * bflo(y1[r][j].x)); xv[r][j][1] += gv[1] * (w0[r] * bfhi(y0[r][j].x) + w1[r] * bfhi(y1[r][j].x));
                    xv[r][j][2] += gv[2] * (w0[r] * bflo(y0[r][j].y) + w1[r] * bflo(y1[r][j].y)); xv[r][j][3] += gv[3] * (w0[r] * bfhi(y0[r][j].y) + w1[r] * bfhi(y1[r][j].y));
                    *(f32x4*)(F.outp() + (size_t)n * D + c) = xv[r][j];
                }
            }
            if (NORM) {
                float ss = 0.f;
#pragma unroll
                for (int j = 0; j < 4; ++j) ss += xv[r][j][0] * xv[r][j][0] + xv[r][j][1] * xv[r][j][1] + xv[r][j][2] * xv[r][j][2] + xv[r][j][3] * xv[r][j][3];
                ss = sum64(ss);
                const float inv = __builtin_amdgcn_rsqf(ss * (1.f / D) + 1e-6f);
                const float* ng = F.in(I_NORMG) + (size_t)(l * 2 + 0) * D; const float* sh = F.modp(l, b); const float* scp = sh + 1024;
#pragma unroll
                for (int j = 0; j < 4; ++j) {
                    const int c = 4 * F.lane + 256 * j;
                    const f32x4 g = *(const f32x4*)(ng + c), s1 = *(const f32x4*)(scp + c), s0 = *(const f32x4*)(sh + c);
                    float o[4];
#pragma unroll
                    for (int q = 0; q < 4; ++q) o[q] = xv[r][j][q] * inv * g[q] * (1.f + s1[q]) + s0[q];
                    u32x2 w; w.x = pk2(o[0], o[1]); w.y = pk2(o[2], o[3]);
                    *(u32x2*)(H + (size_t)n * D + c) = w;
                }
            }
        }
    }
}

__device__ __forceinline__ f32x16 mfma32(bf16x8 a, bf16x8 b, f32x16 c) { return __builtin_amdgcn_mfma_f32_32x32x16_bf16(a, b, c, 0, 0, 0); }
__device__ __forceinline__ f32x16 zero16() { f32x16 z;
#pragma unroll
    for (int q = 0; q < 16; ++q) z[q] = 0.f; return z; }

__device__ __forceinline__ void st_bf(bf16* p, float v) { *p = (bf16)f2bf(v); }
__device__ __forceinline__ float quad_sum(float v) {
    v += __builtin_bit_cast(float, __builtin_amdgcn_update_dpp(0, __builtin_bit_cast(int, v), 0xB1, 0xF, 0xF, true));
    v += __builtin_bit_cast(float, __builtin_amdgcn_update_dpp(0, __builtin_bit_cast(int, v), 0x4E, 0xF, 0xF, true));
    return v;
}
constexpr int PR_STRIDE = 3600, LA_OFF = 33 * PR_STRIDE, LA_STRIDE = 528;
__device__ __forceinline__ void phase_prep(const Frame& F, int l) {
    const int tid = F.tid, lane = F.lane, wave = F.wave, l31 = lane & 31, hi = lane >> 5;
    const bf16* p1 = (const bf16*)(F.ws + WS_P1);
    bf16* rwR = (bf16*)(F.ws + WS_RW); bf16* rwK = rwR + (size_t)NTOK * RW; bf16* rwV = rwK + (size_t)NTOK * RW; bf16* rwKK = rwV + (size_t)NTOK * RW;
    bf16* rwB = rwKK + (size_t)NTOK * RW; bf16* rwG = rwB + (size_t)NTOK * RW; float* rwD = (float*)(F.ws + WS_RW + 96 * MiB);
    const float* mu = F.in(I_MU) + (size_t)l * RCOLS;
    const bf16* w2t = F.lw(l, LW_L2); const bf16* a2t = F.lw(l, LW_A2); const bf16* g2t = F.lw(l, LW_G2);
    const float* rope = (const float*)(F.ws + WS_SMALL + SM_ROPE);
    const float* qkg = F.in(I_QKG) + (size_t)l * 4 * 64;
    bf16* nsQ = (bf16*)(F.ws + NS_Q); bf16* nsKS = (bf16*)(F.ws + NS_KS); bf16* nsKW = (bf16*)(F.ws + NS_KW); bf16* nsVST = (bf16*)(F.ws + NS_VST); bf16* nsVWT = (bf16*)(F.ws + NS_VWT);
    bf16* nsKC = (bf16*)(F.ws + NS_KC); bf16* nsVC = (bf16*)(F.ws + NS_VC); float* nsG = (float*)(F.ws + NS_GATE);
    LAS unsigned char* lds = F.lds;
    for (int u = F.bid; u < NTOK / 32; u += F.G) {
        const int n0 = u * 32, t0 = n0 % T, bb = n0 / T;
        u32x4 sv[15];
        {   const Frame Fs = relaunder(F); const int tid = Fs.tid; const bf16* p1 = (const bf16*)(Fs.ws + WS_P1);
#pragma unroll
            for (int it = 0; it < 15; ++it) { const int idx = tid + it * NTHR; const int row = idx / 224, ch = idx - row * 224;
                sv[it] = (u32x4){0u, 0u, 0u, 0u};
                if (idx < 33 * 224 && !(row == 0 && t0 == 0)) sv[it] = *(const u32x4*)(p1 + (size_t)(n0 - 1 + row) * N1P + ch * 8); } }
        {
            const Frame Fg = relaunder(F); const int tid = Fg.tid, lane = Fg.lane, wave = Fg.wave, l31 = lane & 31, hi = lane >> 5;
            const bf16* Hh = (const bf16*)(Fg.ws + WS_H) + (size_t)(n0 + l31) * D + 128 * wave + hi * 8; const bf16* Wg = Fg.lw(l, LW_WG) + (size_t)l31 * D + 128 * wave + hi * 8;
            float* nsG = (float*)(Fg.ws + NS_GATE);
            f32x16 d = zero16();
#pragma unroll
            for (int ks = 0; ks < 8; ++ks) d = mfma32(*(const bf16x8*)(Hh + ks * 16), *(const bf16x8*)(Wg + ks * 16), d);
            LAS float* part = (LAS float*)lds + wave * 1024;
#pragma unroll
            for (int q = 0; q < 16; ++q) part[(8 * (q >> 2) + 4 * hi + (q & 3)) * 32 + l31] = d[q];
            __syncthreads();
            for (int i = tid; i < 32 * 24; i += NTHR) { const int tl = i / 24, j = i - tl * 24; float a = F.in(I_BIN)[(size_t)l * INC + N1P + j];
#pragma unroll
                for (int w = 0; w < 8; ++w) a += ((const LAS float*)lds)[w * 1024 + tl * 32 + j];
                nsG[(size_t)(n0 + tl) * 24 + j] = sigmoidf_(a); }
            __syncthreads();
        }
        {
            const Frame Fs = relaunder(F); const int tid = Fs.tid;
#pragma unroll
            for (int it = 0; it < 15; ++it) { const int idx = tid + it * NTHR; const int row = idx / 224, ch = idx - row * 224;
                if (idx < 33 * 224) *(LAS u32x4*)(lds + row * PR_STRIDE + ch * 16) = sv[it]; }
        }
        __syncthreads();
        {
            const int i = lane >> 1, cs = 32 * wave + 16 * (lane & 1);
            const LAS u32x4* cur = (const LAS u32x4*)(lds + (i + 1) * PR_STRIDE + (1536 + cs) * 2); const LAS u32x4* prv = (const LAS u32x4*)(lds + i * PR_STRIDE + (1536 + cs) * 2);
            const u32x4 c0 = cur[0], c1 = cur[1], q0 = prv[0], q1 = prv[1];
            const unsigned cw[8] = {c0.x, c0.y, c0.z, c0.w, c1.x, c1.y, c1.z, c1.w}, pw[8] = {q0.x, q0.y, q0.z, q0.w, q1.x, q1.y, q1.z, q1.w};
            const float* mup = mu + 1536 + cs;
            unsigned ow[8];
#pragma unroll
            for (int jj = 0; jj < 8; ++jj) {
                const f32x2 m2 = *(const f32x2*)(mup + 2 * jj);
                const float ca = bflo(cw[jj]), cb = bfhi(cw[jj]), pa = bflo(pw[jj]), pb = bfhi(pw[jj]);
                const float sa = ca + (pa - ca) * m2[0], sb = cb + (pb - cb) * m2[1];
                float fa, fb;
                if (wave < 2) { fa = 1.f - 2.f * rcpf_(__expf(2.f * sa) + 1.f); fb = 1.f - 2.f * rcpf_(__expf(2.f * sb) + 1.f); }
                else if (wave < 4) { fa = sa; fb = sb; }
                else { fa = sigmoidf_(sa); fb = sigmoidf_(sb); }
                ow[jj] = pk2(fa, fb);
            }
            LAS u32x4* la = (LAS u32x4*)(lds + LA_OFF + i * LA_STRIDE + cs * 2);
            la[0] = (u32x4){ow[0], ow[1], ow[2], ow[3]}; la[1] = (u32x4){ow[4], ow[5], ow[6], ow[7]};
        }
        __syncthreads();
        {
            f32x16 accw[2], acca[2], accg[2];
            int colv = 64 * wave + l31; asm volatile("" : "+v"(colv));
#pragma unroll
            for (int ct = 0; ct < 2; ++ct) {
#pragma unroll
                for (int q = 0; q < 16; ++q) { accw[ct][q] = 0.f; acca[ct][q] = 0.f; accg[ct][q] = 0.f; }
                const int col = colv + 32 * ct;
                const LAS unsigned char* lap = lds + LA_OFF + l31 * LA_STRIDE + hi * 16;
#pragma unroll
                for (int ks = 0; ks < 4; ++ks) {
                    const bf16x8 a1 = *(const LAS bf16x8*)(lap + ks * 32), a2 = *(const LAS bf16x8*)(lap + 128 + ks * 32);
                    const bf16x8 b1 = *(const bf16x8*)(w2t + (size_t)col * 64 + ks * 16 + hi * 8), b2 = *(const bf16x8*)(a2t + (size_t)col * 64 + ks * 16 + hi * 8);
                    accw[ct] = mfma32(a1, b1, accw[ct]); acca[ct] = mfma32(a2, b2, acca[ct]);
                }
#pragma unroll
                for (int ks = 0; ks < 8; ++ks) {
                    const bf16x8 a3 = *(const LAS bf16x8*)(lap + 256 + ks * 32);
                    const bf16x8 b3 = *(const bf16x8*)(g2t + (size_t)col * 128 + ks * 16 + hi * 8);
                    accg[ct] = mfma32(a3, b3, accg[ct]);
                }
            }
            const int col0 = colv;
            float mur[2], muk[2], muv[2], w0[2], a0[2], kkc[2], kac[2];
#pragma unroll
            for (int ct = 0; ct < 2; ++ct) { const int col = col0 + 32 * ct;
                mur[ct] = mu[col]; muk[ct] = mu[512 + col]; muv[ct] = mu[1024 + col];
                w0[ct] = F.in(I_W0)[l * RW + col]; a0[ct] = F.in(I_A0)[l * RW + col]; kkc[ct] = F.in(I_KK)[l * RW + col]; kac[ct] = F.in(I_KA)[l * RW + col]; }
#pragma unroll
            for (int i = 0; i < 16; ++i) {
                const int ti = 8 * (i >> 2) + 4 * hi + (i & 3);
                const LAS bf16* cur = (const LAS bf16*)(lds + (ti + 1) * PR_STRIDE) + col0; const LAS bf16* prv = (const LAS bf16*)(lds + ti * PR_STRIDE) + col0;
                const size_t o = (size_t)(n0 + ti) * RW + col0;
                float kx[2], av[2];
#pragma unroll
                for (int ct = 0; ct < 2; ++ct) {
                    const float rc = bf2f(cur[32 * ct]), rp = bf2f(prv[32 * ct]), kc = bf2f(cur[512 + 32 * ct]), kp = bf2f(prv[512 + 32 * ct]), vc = bf2f(cur[1024 + 32 * ct]), vp = bf2f(prv[1024 + 32 * ct]);
                    const float rs = rc + (rp - rc) * mur[ct], ks_ = kc + (kp - kc) * muk[ct], vs = vc + (vp - vc) * muv[ct];
                    const float z = w0[ct] + accw[ct][i];
                    const float sp = (z < 0.f ? -z : 0.f) + 0.6931471805599453f * __builtin_amdgcn_logf(1.f + __expf(-__builtin_fabsf(z)));
                    const float wlog = -sp - 0.5f;
                    const float dec = -__expf(wlog);
                    const float a = sigmoidf_(a0[ct] + acca[ct][i]);
                    st_bf(rwR + o + 32 * ct, rs); st_bf(rwV + o + 32 * ct, vs); st_bf(rwG + o + 32 * ct, accg[ct][i]); rwD[o + 32 * ct] = dec; st_bf(rwK + o + 32 * ct, ks_ * (1.f + (a - 1.f) * kac[ct]));
                    kx[ct] = ks_ * kkc[ct]; av[ct] = a;
                }
                float ss = kx[0] * kx[0] + kx[1] * kx[1];
                ss = sum32(ss);
                const float inv = fminf(__builtin_amdgcn_rsqf(ss), 1e12f);
#pragma unroll
                for (int ct = 0; ct < 2; ++ct) { const float kk = kx[ct] * inv; st_bf(rwKK + o + 32 * ct, kk); st_bf(rwB + o + 32 * ct, kk * av[ct]); }
            }
        }
        __syncthreads();
        {
            const Frame Fs = relaunder(F); const int tid = Fs.tid, lane = Fs.lane, wave = Fs.wave; const bf16* p1 = (const bf16*)(Fs.ws + WS_P1);
            int u_ = u; asm volatile("" : "+s"(u_)); const int n0 = u_ * 32, t0 = n0 % T, bb = n0 / T;
            bf16* nsQ = (bf16*)(Fs.ws + NS_Q); bf16* nsKS = (bf16*)(Fs.ws + NS_KS); bf16* nsKW = (bf16*)(Fs.ws + NS_KW); bf16* nsVST = (bf16*)(Fs.ws + NS_VST); bf16* nsVWT = (bf16*)(Fs.ws + NS_VWT);
            bf16* nsKC = (bf16*)(Fs.ws + NS_KC); bf16* nsVC = (bf16*)(Fs.ws + NS_VC); const float* rope = (const float*)(Fs.ws + WS_SMALL + SM_ROPE);
            const int lq = lane & 15, sub = lane >> 4;
            LAS bf16* vts = (LAS bf16*)lds;
            const int tl = wave * 4 + sub, n = n0 + tl, t = t0 + tl;
#pragma unroll
            for (int sb = 0; sb < 20; sb += 5) {
            u32x2 raws[5];
#pragma unroll
            for (int s5 = 0; s5 < 5; ++s5) raws[s5] = *(const u32x2*)(p1 + (size_t)n * N1P + QOFF + 64 * (sb + s5) + 4 * lq);
#pragma unroll
            for (int s5 = 0; s5 < 5; ++s5) {
                const int v = sb + s5;
                const u32x2 raw = raws[s5];
                float x[4] = {bflo(raw.x), bfhi(raw.x), bflo(raw.y), bfhi(raw.y)};
                const int g = v & 1;
                const bool isq = v < 8, isks = (v == 12 || v == 13), iskw = (v == 16 || v == 17);
                if (isq || isks || iskw) {
                    float ss = x[0] * x[0] + x[1] * x[1] + x[2] * x[2] + x[3] * x[3];
                    ss = sum16(ss);
                    const float inv = __builtin_amdgcn_rsqf(ss * (1.f / 64.f) + 1e-6f);
                    const float* gw = qkg + (isq ? 0 : (isks ? 128 : 192)) + 4 * lq;
#pragma unroll
                    for (int j = 0; j < 4; ++j) x[j] = x[j] * inv * gw[j];
                    float px[4];
#pragma unroll
                    for (int j = 0; j < 4; ++j) px[j] = xor_lane<2>(x[j]);
                    if (lq < 4) {
                        const float* rp = rope + (size_t)t * 16 + 4 * (lq & 1);
#pragma unroll
                        for (int j = 0; j < 4; ++j) { const float c = rp[j], sn = rp[8 + j]; x[j] = (lq < 2) ? (x[j] * c - px[j] * sn) : (x[j] * c + px[j] * sn); }
                    }
                    if (isq) {
#pragma unroll
                        for (int j = 0; j < 4; ++j) x[j] *= 0.18033688011112042f;
                    }
                    u32x2 w; w.x = pk2(x[0], x[1]); w.y = pk2(x[2], x[3]);
                    if (isq) *(u32x2*)(nsQ + (size_t)n * 512 + 64 * v + 4 * lq) = w;
                    else if (isks) {
                        const size_t off = (size_t)(bb * 2 + g) * T * 64 + (size_t)(t >> 6) * 4096 + (size_t)(((((t >> 5) & 1) * 4 + (lq >> 2)) * 32 + (t & 31)) * 2 + ((lq >> 1) & 1)) * 8 + 4 * (lq & 1);
                        *(u32x2*)(nsKS + off) = w;
                    } else *(u32x2*)(nsKW + ((size_t)(bb * 2 + g) * T + t) * 64 + 4 * lq) = w;
                } else if (v < 12) {
                    *(u32x2*)((v < 10 ? nsKC : nsVC) + ((size_t)(bb * 2 + g) * T + t) * 64 + 4 * lq) = raw;
                } else {
                    const int slot = (v >= 18 ? 2 : 0) + g;
                    LAS bf16* dp = vts + (slot * 64 + 4 * lq) * 40 + tl;
                    dp[0] = (bf16)(raw.x & 0xffffu); dp[40] = (bf16)(raw.x >> 16); dp[80] = (bf16)(raw.y & 0xffffu); dp[120] = (bf16)(raw.y >> 16);
                }
            }
            }
            __syncthreads();
            {
                const int row = tid >> 1, hf = tid & 1, slot = row >> 6, d = row & 63, g = slot & 1;
                const LAS u32x4* sp = (const LAS u32x4*)(vts + row * 40 + hf * 16);
                const u32x4 a = sp[0], b = sp[1];
                if (slot >> 1) { bf16* dst = nsVWT + ((size_t)(bb * 2 + g) * 64 + d) * T + t0 + hf * 16; *(u32x4*)dst = a; *(u32x4*)(dst + 8) = b; }
                else {
                    const int sq = ((t0 >> 5) & 1) * 2 + hf;
                    bf16* dst = nsVST + (size_t)(bb * 2 + g) * 64 * T + (size_t)(t0 >> 6) * 4096 + (size_t)((((d >> 5) * 4 + sq) * 32 + (d & 31)) * 2) * 8;
                    *(u32x4*)dst = (u32x4){a.x, a.y, b.x, b.y}; *(u32x4*)(dst + 8) = (u32x4){a.z, a.w, b.z, b.w};
                }
            }
        }
        __syncthreads();
    }
}

__device__ __forceinline__ float gelu_tanh(float x) { const float u = 0.7978845608028654f * (x + 0.044715f * x * x * x); const float e = __expf(2.f * u); return 0.5f * x * (2.f - 2.f * __builtin_amdgcn_rcpf(e + 1.f)); }
__device__ __forceinline__ void phase_compress(const Frame& F, int l) {
    const int tid = F.tid, lane = F.lane, wave = F.wave, l31 = lane & 31, hi = lane >> 5;
    LAS unsigned char* lds = F.lds;
    LAS bf16* hid = (LAS bf16*)lds;
    LAS float* outl = (LAS float*)(lds + 32 * 528);
    const float* cbp = (const float*)(F.ws + WS_SMALL + SM_CMPB);
    const float* rope = (const float*)(F.ws + WS_SMALL + SM_ROPE);
    const float* qkg1 = F.in(I_QKG) + (size_t)l * 256 + 64;
    for (int u = F.bid; u < 128; u += F.G) {
        const int i = u >> 6, bg = (u >> 4) & 3, rt = u & 15;
        const bf16* src = (const bf16*)(F.ws + (i ? NS_VC : NS_KC)) + (size_t)bg * T * 64;
        const bf16* w1t = F.lw(l, LW_C1) + (size_t)i * 256 * 2048; const bf16* w2t = F.lw(l, LW_C2) + (size_t)i * 64 * 256;
        int nrow = rt * 32 + l31; if (nrow > NCMP - 1) nrow = NCMP - 1;
        const bf16* ap = src + (size_t)nrow * 1024 + hi * 8; const bf16* bp = w1t + (size_t)(32 * wave + l31) * 2048 + hi * 8;
        f32x16 acc;
#pragma unroll
        for (int q = 0; q < 16; ++q) acc[q] = 0.f;
#pragma unroll 8
        for (int ks = 0; ks < 128; ++ks) acc = mfma32(*(const bf16x8*)(ap + ks * 16), *(const bf16x8*)(bp + ks * 16), acc);
        {
            const int col = 32 * wave + l31; const int li = l * 2 + i;
            const float cb = cbp[(li * 4 + 0) * 256 + col] + cbp[(li * 4 + 1) * 256 + col] + cbp[(li * 4 + 2) * 256 + col] + cbp[(li * 4 + 3) * 256 + col];
#pragma unroll
            for (int q = 0; q < 16; ++q) { const int r = 8 * (q >> 2) + 4 * hi + (q & 3); hid[r * 264 + col] = (bf16)f2bf(gelu_tanh(acc[q] + cb)); }
        }
        __syncthreads();
        if (wave < 2) {
            f32x16 o;
#pragma unroll
            for (int q = 0; q < 16; ++q) o[q] = 0.f;
#pragma unroll
            for (int ks = 0; ks < 16; ++ks) o = mfma32(*(const LAS bf16x8*)(hid + l31 * 264 + ks * 16 + hi * 8), *(const bf16x8*)(w2t + (size_t)(32 * wave + l31) * 256 + ks * 16 + hi * 8), o);
#pragma unroll
            for (int q = 0; q < 16; ++q) { const int r = 8 * (q >> 2) + 4 * hi + (q & 3); outl[r * 65 + 32 * wave + l31] = o[q]; }
        }
        __syncthreads();
        if (i == 0) {
            const int r = tid >> 4, lq = tid & 15, n = rt * 32 + r;
            float x[4];
#pragma unroll
            for (int j = 0; j < 4; ++j) x[j] = outl[r * 65 + 4 * lq + j];
            float ss = x[0] * x[0] + x[1] * x[1] + x[2] * x[2] + x[3] * x[3];
            ss = sum16(ss);
            const float inv = __builtin_amdgcn_rsqf(ss * (1.f / 64.f) + 1e-6f);
#pragma unroll
            for (int j = 0; j < 4; ++j) x[j] = x[j] * inv * qkg1[4 * lq + j];
            float px[4];
#pragma unroll
            for (int j = 0; j < 4; ++j) px[j] = xor_lane<2>(x[j]);
            const int pos = (n < NCMP) ? 16 * n + 31 : 0;
            if (lq < 4) {
                const float* rp = rope + (size_t)pos * 16 + 4 * (lq & 1);
#pragma unroll
                for (int j = 0; j < 4; ++j) { const float c = rp[j], sn = rp[8 + j]; x[j] = (lq < 2) ? (x[j] * c - px[j] * sn) : (x[j] * c + px[j] * sn); }
            }
            if (n >= NCMP) { x[0] = x[1] = x[2] = x[3] = 0.f; }
            u32x2 w; w.x = pk2(x[0], x[1]); w.y = pk2(x[2], x[3]);
            *(u32x2*)((bf16*)(F.ws + NS_KCMP) + ((size_t)bg * NCMPP + n) * 64 + 4 * lq) = w;
        } else {
            const int d = tid >> 3, n4 = (tid & 7) * 4;
            float x[4];
#pragma unroll
            for (int j = 0; j < 4; ++j) { const int n = rt * 32 + n4 + j; x[j] = (n < NCMP) ? outl[(n4 + j) * 65 + d] : 0.f; }
            u32x2 w; w.x = pk2(x[0], x[1]); w.y = pk2(x[2], x[3]);
            *(u32x2*)((bf16*)(F.ws + NS_VCMPT) + ((size_t)bg * 64 + d) * NCMPP + rt * 32 + n4) = w;
        }
        __syncthreads();
    }
}

constexpr int T72 = 144;
__device__ __forceinline__ f32x16 mm64(const LAS unsigned char* A, const LAS unsigned char* Bt, int m0, int n0, int l31, int hi, f32x16 acc) {
#pragma unroll
    for (int ks = 0; ks < 4; ++ks) acc = mfma32(*(const LAS bf16x8*)(A + (m0 + l31) * T72 + ks * 32 + hi * 16), *(const LAS bf16x8*)(Bt + (n0 + l31) * T72 + ks * 32 + hi * 16), acc);
    return acc;
}
__device__ __forceinline__ void st_tile_T_bf(LAS unsigned char* dst, const f32x16& d, int m0, int n0, int l31, int hi) {
#pragma unroll
    for (int g = 0; g < 4; ++g) { u32x2 w; w.x = pk2(d[4 * g], d[4 * g + 1]); w.y = pk2(d[4 * g + 2], d[4 * g + 3]); *(LAS u32x2*)(dst + (n0 + l31) * T72 + (m0 + 8 * g + 4 * hi) * 2) = w; }
}
__device__ __forceinline__ void st_tile_T_f32(LAS unsigned char* dst, const f32x16& d, int m0, int n0, int l31, int hi) {
#pragma unroll
    for (int g = 0; g < 4; ++g) *(LAS f32x4*)(dst + (n0 + l31) * 272 + (m0 + 8 * g + 4 * hi) * 4) = (f32x4){d[4 * g], d[4 * g + 1], d[4 * g + 2], d[4 * g + 3]};
}

constexpr int R1_AN = 0, R1_BN = 9216, R1_KN = 18432, R1_BHT = 27648, R1_KHT = 36864, R1_VT = 46080, R1_ATF = 55296, R1_AAB = 72704, R1_AAK = 90112, R1_RHS2 = 99328, R1_TT = 116736, R1_AOFF = 120832;
__device__ __forceinline__ void rw1_unit(const Frame& F, int u) {
    const int tid = F.tid, lane = F.lane, wave = F.wave, l31 = lane & 31, hi = lane >> 5;
    LAS unsigned char* lds = F.lds;
    const int c = u & 127, bh = u >> 7, b = bh >> 3, h = bh & 7;
    const size_t n0 = (size_t)b * T + 64 * c; const int cb = 64 * h;
    const bf16* rwK = (const bf16*)(F.ws + WS_RW) + (size_t)NTOK * RW; const bf16* rwV = rwK + (size_t)NTOK * RW; const bf16* rwKK = rwV + (size_t)NTOK * RW; const bf16* rwB = rwKK + (size_t)NTOK * RW;
    const float* rwD = (const float*)(F.ws + WS_RW + 96 * MiB);
    {
        float ldv[8]; unsigned kkr[8], br[8], kr[8], vr[8];
#pragma unroll
        for (int q = 0; q < 8; ++q) { const size_t o = (n0 + 8 * wave + q) * RW + cb + lane; ldv[q] = rwD[o]; kkr[q] = rwKK[o]; br[q] = rwB[o]; kr[q] = rwK[o]; vr[q] = rwV[o]; }
        float part = 0.f;
#pragma unroll
        for (int q = 0; q < 8; ++q) part += ldv[q];
        LAS float* psum = (LAS float*)(lds + R1_AAB);
        psum[wave * 64 + lane] = part;
        __syncthreads();
        float pre = 0.f, tot = 0.f;
#pragma unroll
        for (int w = 0; w < 8; ++w) { const float x = psum[w * 64 + lane]; if (w < wave) pre += x; tot += x; }
        float cwv = pre, atf[8]; unsigned bh_[8], kh_[8];
#pragma unroll
        for (int q = 0; q < 8; ++q) {
            const int t = 8 * wave + q;
            const float cwx = cwv; cwv += ldv[q];
            const float kkv = bf2f(kkr[q]), bv = bf2f(br[q]), kv = bf2f(kr[q]);
            const float ex = __expf(cwx), em = __expf(-cwv), eh = __expf(tot - cwv);
            const float an = -kkv * ex;
            *(LAS bf16*)(lds + R1_AN + t * T72 + lane * 2) = (bf16)f2bf(an);
            *(LAS bf16*)(lds + R1_BN + t * T72 + lane * 2) = (bf16)f2bf(bv * em);
            *(LAS bf16*)(lds + R1_KN + t * T72 + lane * 2) = (bf16)f2bf(kv * em);
            atf[q] = an; bh_[q] = f2bf(bv * eh); kh_[q] = f2bf(kv * eh);
        }
        *(LAS u32x4*)(lds + R1_BHT + lane * T72 + wave * 16) = (u32x4){bh_[0] | (bh_[1] << 16), bh_[2] | (bh_[3] << 16), bh_[4] | (bh_[5] << 16), bh_[6] | (bh_[7] << 16)};
        *(LAS u32x4*)(lds + R1_KHT + lane * T72 + wave * 16) = (u32x4){kh_[0] | (kh_[1] << 16), kh_[2] | (kh_[3] << 16), kh_[4] | (kh_[5] << 16), kh_[6] | (kh_[7] << 16)};
        *(LAS u32x4*)(lds + R1_VT + lane * T72 + wave * 16) = (u32x4){vr[0] | (vr[1] << 16), vr[2] | (vr[3] << 16), vr[4] | (vr[5] << 16), vr[6] | (vr[7] << 16)};
        *(LAS f32x4*)(lds + R1_ATF + lane * 272 + wave * 32) = (f32x4){atf[0], atf[1], atf[2], atf[3]};
        *(LAS f32x4*)(lds + R1_ATF + lane * 272 + wave * 32 + 16) = (f32x4){atf[4], atf[5], atf[6], atf[7]};
        if (wave == 0) ((float*)(F.ws + WS_GC))[(size_t)u * 64 + lane] = __expf(tot);
    }
    __syncthreads();
    {
        const int p = wave >> 2, mt = (wave >> 1) & 1, nt = wave & 1;
        f32x16 d = zero16();
        if (mt <= nt) d = mm64(lds + (p ? R1_KN : R1_BN), lds + R1_AN, 32 * mt, 32 * nt, l31, hi, d);
#pragma unroll
        for (int q = 0; q < 16; ++q) { const int tau = 32 * mt + 8 * (q >> 2) + 4 * hi + (q & 3), t = 32 * nt + l31; if (!(tau < t)) d[q] = 0.f; }
        if (p == 0) {
            st_tile_T_f32(lds + R1_AAB, d, 32 * mt, 32 * nt, l31, hi);
#pragma unroll
            for (int q = 0; q < 16; ++q) { const int tau = 32 * mt + 8 * (q >> 2) + 4 * hi + (q & 3), t = 32 * nt + l31; if ((tau >> 4) == (t >> 4)) d[q] = 0.f; }
            st_tile_T_bf(lds + R1_AOFF, d, 32 * mt, 32 * nt, l31, hi);
        } else st_tile_T_bf(lds + R1_AAK, d, 32 * mt, 32 * nt, l31, hi);
    }
    __syncthreads();
    if (wave < 4) { const int mt = wave >> 1, nt = wave & 1; f32x16 d = zero16(); d = mm64(lds + R1_AAK, lds + R1_VT, 32 * mt, 32 * nt, l31, hi, d); st_tile_T_f32(lds + R1_RHS2, d, 32 * mt, 32 * nt, l31, hi); }
    else if (wave == 4) {
        const int blk = lane >> 4, c = lane & 15;
#pragma unroll
        for (int q = 0; q < 4; ++q) *(LAS u32x4*)(lds + R1_TT + lane * 64 + q * 16) = (u32x4){0u, 0u, 0u, 0u};
        float x[16];
#pragma unroll
        for (int r = 0; r < 16; ++r) x[r] = (r == c) ? 1.f : 0.f;
        unsigned ab_ = (unsigned)(size_t)(lds + R1_AAB) + (unsigned)(blk * 16 * 272 + blk * 64); asm volatile("" : "+v"(ab_));
#pragma unroll
        for (int r = 1; r < 16; ++r) {
            float s0 = 0.f;
#pragma unroll
            for (int q = 0; q < (r + 3) / 4; ++q) { const f32x4 a = *(const LAS f32x4*)((const LAS unsigned char*)(size_t)ab_ + r * 272 + q * 16);
                s0 += a[0] * x[4 * q]; if (4 * q + 1 < r) s0 += a[1] * x[4 * q + 1]; if (4 * q + 2 < r) s0 += a[2] * x[4 * q + 2]; if (4 * q + 3 < r) s0 += a[3] * x[4 * q + 3]; }
            x[r] += s0;
            asm volatile("" : "+v"(x[r]));
        }
#pragma unroll
        for (int r = 0; r < 16; ++r) *(LAS bf16*)(lds + R1_TT + ((blk * 16 + r) * 32 + 8 * (c >> 2) + (c & 3)) * 2) = (bf16)f2bf(x[r]);
    } else {
        const int t3 = F.tid - 320;
#pragma unroll
        for (int q = 0; q < 6; ++q) *(LAS u32x4*)(lds + R1_AN + (t3 + 192 * q) * 16) = (u32x4){0u, 0u, 0u, 0u};
    }
    __syncthreads();
    {
        const int cl = lane & 15, qd = lane >> 4, col = 16 * (wave & 3) + cl, isu = wave >> 2;
        const LAS unsigned char* rhs = lds + (isu ? R1_RHS2 : R1_ATF) + col * 272;
        LAS unsigned char* xt = lds + (isu ? R1_BN : R1_AN) + col * T72;
        bf16* gp = (bf16*)(F.ws + (isu ? WS_UPN : WS_WN)) + (size_t)u * 4096 + col;
#pragma unroll
        for (int d = 0; d < 4; ++d) {
            f32x4 acc = *(const LAS f32x4*)(rhs + (16 * d + 4 * qd) * 4);
            if (d > 0) {
#pragma unroll
                for (int ks = 0; ks < (d == 3 ? 2 : 1); ++ks) {
                    const bf16x8 a = *(const LAS bf16x8*)(lds + R1_AOFF + (16 * d + cl) * T72 + (32 * ks + 8 * qd) * 2), bx = *(const LAS bf16x8*)(xt + (32 * ks + 8 * qd) * 2);
                    acc = __builtin_amdgcn_mfma_f32_16x16x32_bf16(a, bx, acc, 0, 0, 0);
                }
            }
            u32x4 bw; bw.x = pk2(acc[0], acc[1]); bw.y = pk2(acc[2], acc[3]); bw.z = 0u; bw.w = 0u;
            const bf16x8 ta = *(const LAS bf16x8*)(lds + R1_TT + ((d * 16 + cl) * 32 + 8 * qd) * 2);
            f32x4 xo = (f32x4){0.f, 0.f, 0.f, 0.f};
            xo = __builtin_amdgcn_mfma_f32_16x16x32_bf16(ta, __builtin_bit_cast(bf16x8, bw), xo, 0, 0, 0);
            u32x2 w; w.x = pk2(xo[0], xo[1]); w.y = pk2(xo[2], xo[3]);
            *(LAS u32x2*)(xt + (16 * d + 4 * qd) * 2) = w;
#pragma unroll
            for (int r = 0; r < 4; ++r) gp[(16 * d + 4 * qd + r) * 64] = (bf16)f2bf(xo[r]);
        }
    }
    __syncthreads();
    {
        const int mt = (wave >> 1) & 1, nt = wave & 1;
        f32x16 d = zero16();
        if (wave < 4) {
            d = mm64(lds + R1_BHT, lds + R1_AN  , 32 * mt, 32 * nt, l31, hi, d);
            unsigned char* img = F.ws + WS_PT + (size_t)u * 16384;
            const int j = 32 * nt + l31, s_ = j >> 4, r_ = j & 15, half = r_ >> 3, hj = (r_ >> 2) & 1, e_ = r_ & 3;
#pragma unroll
            for (int q = 0; q < 16; ++q) { const int jp = 32 * mt + 8 * (q >> 2) + 4 * hi + (q & 3);
                *(bf16*)(img + (((((jp >> 5) * 4 + s_) * 2 + hj) * 32 + (jp & 31)) * 16 + half * 8 + e_ * 2)) = (bf16)f2bf(d[q]); }
        } else {
            d = mm64(lds + R1_BHT, lds + R1_BN  , 32 * mt, 32 * nt, l31, hi, d);
            d = mm64(lds + R1_KHT, lds + R1_VT, 32 * mt, 32 * nt, l31, hi, d);
            unsigned char* img = F.ws + WS_PT + (size_t)u * 16384 + 8192;
#pragma unroll
            for (int g = 0; g < 4; ++g) { u32x2 w; w.x = pk2(d[4 * g], d[4 * g + 1]); w.y = pk2(d[4 * g + 2], d[4 * g + 3]); *(u32x2*)(img + (((((nt * 2 + mt) * 4 + g) * 2 + hi) * 32 + l31) * 8)) = w; }
        }
    }
    __syncthreads();
}

constexpr int R2_SLOT = 16640, R2_NST = 8, R2_QI = 8192, R2_G = 16384;
__device__ __forceinline__ void rw2_issue(LAS unsigned char* slot, const unsigned char* img, const float* gsrc, int lane) {
#pragma unroll
    for (int i = 0; i < 16; ++i) __builtin_amdgcn_global_load_lds((const unsigned*)(img + i * 1024 + lane * 16), (LAS unsigned*)(slot + i * 1024), 16, 0, 0);
    if (lane < 16) __builtin_amdgcn_global_load_lds((const unsigned*)((const unsigned char*)gsrc + lane * 16), (LAS unsigned*)(slot + R2_G), 16, 0, 0);
}
__device__ __forceinline__ void rw2_wg(const Frame& F, int bh) {
    const int lane = F.lane, wave = F.wave, l31 = lane & 31, hi = lane >> 5;
    LAS unsigned char* lds = F.lds;
    LAS unsigned* ctr = (LAS unsigned*)(lds + LDS_MISC + 128);
    if (F.tid < 8) ctr[F.tid] = 0u;
    __syncthreads();
    const unsigned char* IMG = F.ws + WS_PT + (size_t)bh * 128 * 16384; const float* GC = (const float*)(F.ws + WS_GC) + (size_t)bh * 128 * 64;
    if (wave >= 4) {
        const int k = wave - 4;
        rw2_issue(lds + k * R2_SLOT, IMG + (size_t)k * 16384, GC + k * 64, lane);
        rw2_issue(lds + (k + 4) * R2_SLOT, IMG + (size_t)(k + 4) * 16384, GC + (k + 4) * 64, lane);
#pragma unroll 1
        for (int m = 0; m < 32; ++m) {
            const int c = k + 4 * m;
            if (m < 31) asm volatile("s_waitcnt vmcnt(17)" ::: "memory"); else asm volatile("s_waitcnt vmcnt(0)" ::: "memory");
            if (lane == 0) __hip_atomic_store(ctr + k, (unsigned)(m + 1), __ATOMIC_RELEASE, __HIP_MEMORY_SCOPE_WORKGROUP);
            const int cn = c + 8;
            if (cn < 128) {
                for (;;) { const unsigned a = __hip_atomic_load(ctr + 4, __ATOMIC_ACQUIRE, __HIP_MEMORY_SCOPE_WORKGROUP), b2 = __hip_atomic_load(ctr + 5, __ATOMIC_ACQUIRE, __HIP_MEMORY_SCOPE_WORKGROUP);
                    if ((a < b2 ? a : b2) >= (unsigned)(c + 1)) break; __builtin_amdgcn_s_sleep(1); }
                rw2_issue(lds + (cn & 7) * R2_SLOT, IMG + (size_t)cn * 16384, GC + cn * 64, lane);
            } else if (m < 31) {   asm volatile("s_waitcnt vmcnt(0)" ::: "memory"); }
        }
    } else if (wave < 2) {
        const int ih = wave, irow = 32 * ih + l31;
        bf16* S0 = (bf16*)(F.ws + WS_S0);
        f32x16 acc[2]; acc[0] = zero16(); acc[1] = zero16();
#pragma unroll 1
        for (int c = 0; c < 128; ++c) {
            const size_t ub = ((size_t)bh * 128 + c) * 4096;
            const LAS unsigned char* slot = lds + (c & 7) * R2_SLOT;
            bf16x8 xb[4];
#pragma unroll
            for (int jt = 0; jt < 2; ++jt) {
                u32x4 lo, hi4;
                lo.x = pg8::cvt_pk_bf16(acc[jt][0], acc[jt][1]); lo.y = pg8::cvt_pk_bf16(acc[jt][2], acc[jt][3]); lo.z = pg8::cvt_pk_bf16(acc[jt][4], acc[jt][5]); lo.w = pg8::cvt_pk_bf16(acc[jt][6], acc[jt][7]);
                hi4.x = pg8::cvt_pk_bf16(acc[jt][8], acc[jt][9]); hi4.y = pg8::cvt_pk_bf16(acc[jt][10], acc[jt][11]); hi4.z = pg8::cvt_pk_bf16(acc[jt][12], acc[jt][13]); hi4.w = pg8::cvt_pk_bf16(acc[jt][14], acc[jt][15]);
                xb[2 * jt] = __builtin_bit_cast(bf16x8, lo); xb[2 * jt + 1] = __builtin_bit_cast(bf16x8, hi4);
                bf16* sp = S0 + ub + (size_t)irow * 64 + 32 * jt + 4 * hi;
                *(u32x2*)(sp) = (u32x2){lo.x, lo.y}; *(u32x2*)(sp + 8) = (u32x2){lo.z, lo.w}; *(u32x2*)(sp + 16) = (u32x2){hi4.x, hi4.y}; *(u32x2*)(sp + 24) = (u32x2){hi4.z, hi4.w};
            }
            while (__hip_atomic_load(ctr + (c & 3), __ATOMIC_ACQUIRE, __HIP_MEMORY_SCOPE_WORKGROUP) < (unsigned)((c >> 2) + 1)) __builtin_amdgcn_s_sleep(1);
            f32x16 nw[2];
#pragma unroll
            for (int jt = 0; jt < 2; ++jt)
#pragma unroll
                for (int g = 0; g < 4; ++g) {
                    const u32x2 qv = *(const LAS u32x2*)(slot + R2_QI + (((((ih * 2 + jt) * 4 + g) * 2 + hi) * 32 + l31) * 8));
                    const f32x4 gv = *(const LAS f32x4*)(slot + R2_G + (32 * jt + 8 * g + 4 * hi) * 4);
                    nw[jt][4 * g + 0] = bflo(qv.x) + gv[0] * acc[jt][4 * g + 0]; nw[jt][4 * g + 1] = bfhi(qv.x) + gv[1] * acc[jt][4 * g + 1];
                    nw[jt][4 * g + 2] = bflo(qv.y) + gv[2] * acc[jt][4 * g + 2]; nw[jt][4 * g + 3] = bfhi(qv.y) + gv[3] * acc[jt][4 * g + 3];
                }
#pragma unroll
            for (int jt = 0; jt < 2; ++jt)
#pragma unroll
                for (int s_ = 0; s_ < 4; ++s_) {
                    const bf16x8 af = *(const LAS bf16x8*)(slot + ((((jt * 4 + s_) * 2 + hi) * 32 + l31) * 16));
                    nw[jt] = mfma32(af, xb[s_], nw[jt]);
                }
            asm volatile("s_waitcnt lgkmcnt(0)" ::: "memory");
            if (lane == 0) __hip_atomic_store(ctr + 4 + wave, (unsigned)(c + 1), __ATOMIC_RELEASE, __HIP_MEMORY_SCOPE_WORKGROUP);
            acc[0] = nw[0]; acc[1] = nw[1];
        }
    }
}

constexpr int R3_RN = 0, R3_BN = 9216, R3_KN = 18432, R3_WN = 27648, R3_S0 = 36864, R3_VT = 46080, R3_UT = 55296, R3_ARB = 64512, R3_ARK = 73728, R3_YL = 82944;
__device__ __forceinline__ void rw3_unit(const Frame& F, int u, int l) {
    const int tid = F.tid, lane = F.lane, wave = F.wave, l31 = lane & 31, hi = lane >> 5;
    LAS unsigned char* lds = F.lds;
    const int c = u & 127, bh = u >> 7, b = bh >> 3, h = bh & 7;
    const size_t n0 = (size_t)b * T + 64 * c; const int cb = 64 * h;
    const bf16* rwR = (const bf16*)(F.ws + WS_RW); const bf16* rwK = rwR + (size_t)NTOK * RW; const bf16* rwV = rwK + (size_t)NTOK * RW; const bf16* rwB = rwR + (size_t)4 * NTOK * RW;
    const float* rwD = (const float*)(F.ws + WS_RW + 96 * MiB);
    unsigned short upr[16];
    {   const int mt = (wave >> 1) & 1, nt = wave & 1;
        const bf16* up = (const bf16*)(F.ws + WS_UPN) + (size_t)u * 4096 + 32 * nt + l31;
        if (wave < 4) {
#pragma unroll
            for (int q = 0; q < 16; ++q) upr[q] = up[(32 * mt + 8 * (q >> 2) + 4 * hi + (q & 3)) * 64]; } }
    const size_t od = (n0 + (tid >> 3)) * RW + cb + (tid & 7) * 8;
    const u32x4 rw_d = *(const u32x4*)(rwR + od), kw_d = *(const u32x4*)(rwK + od), vw_d = *(const u32x4*)(rwV + od), gw_d = *(const u32x4*)(rwR + (size_t)5 * NTOK * RW + od);
    {
        float ldv[8]; unsigned rr[8], br[8], kr[8], vr[8];
#pragma unroll
        for (int q = 0; q < 8; ++q) { const size_t o = (n0 + 8 * wave + q) * RW + cb + lane; ldv[q] = rwD[o]; rr[q] = rwR[o]; br[q] = rwB[o]; kr[q] = rwK[o]; vr[q] = rwV[o]; }
        const int row = tid >> 3, ch = (tid & 7) * 8;
        const u32x4 wcp = *(const u32x4*)((const bf16*)(F.ws + WS_WN) + (size_t)u * 4096 + row * 64 + ch), scp = *(const u32x4*)((const bf16*)(F.ws + WS_S0) + (size_t)u * 4096 + row * 64 + ch);
        float part = 0.f;
#pragma unroll
        for (int q = 0; q < 8; ++q) part += ldv[q];
        LAS float* psum = (LAS float*)(lds + R3_YL);
        psum[wave * 64 + lane] = part;
        __syncthreads();
        float cwv = 0.f;
#pragma unroll
        for (int w = 0; w < 8; ++w) { const float x = psum[w * 64 + lane]; if (w < wave) cwv += x; }
#pragma unroll
        for (int q = 0; q < 8; ++q) {
            const int t = 8 * wave + q;
            cwv += ldv[q];
            const float ep = __expf(cwv), em = __expf(-cwv);
            *(LAS bf16*)(lds + R3_RN + t * T72 + lane * 2) = (bf16)f2bf(bf2f(rr[q]) * ep);
            *(LAS bf16*)(lds + R3_BN + t * T72 + lane * 2) = (bf16)f2bf(bf2f(br[q]) * em);
            *(LAS bf16*)(lds + R3_KN + t * T72 + lane * 2) = (bf16)f2bf(bf2f(kr[q]) * em);
        }
        *(LAS u32x4*)(lds + R3_VT + lane * T72 + wave * 16) = (u32x4){vr[0] | (vr[1] << 16), vr[2] | (vr[3] << 16), vr[4] | (vr[5] << 16), vr[6] | (vr[7] << 16)};
        *(LAS u32x4*)(lds + R3_WN + row * T72 + ch * 2) = wcp;
        *(LAS u32x4*)(lds + R3_S0 + row * T72 + ch * 2) = scp;
    }
    __syncthreads();
    f32x16 y = zero16();
    {
        const int p = wave >> 2, mt = (wave >> 1) & 1, nt = wave & 1;
        f32x16 d = zero16();
        if (mt <= nt) d = mm64(lds + (p ? R3_KN : R3_BN), lds + R3_RN, 32 * mt, 32 * nt, l31, hi, d);
#pragma unroll
        for (int q = 0; q < 16; ++q) { const int tau = 32 * mt + 8 * (q >> 2) + 4 * hi + (q & 3), t = 32 * nt + l31; if (!(tau <= t)) d[q] = 0.f; }
        st_tile_T_bf(lds + (p ? R3_ARK : R3_ARB), d, 32 * mt, 32 * nt, l31, hi);
        if (wave < 4) {
            f32x16 uu;
#pragma unroll
            for (int q = 0; q < 16; ++q) uu[q] = bf2f(upr[q]);
            uu = mm64(lds + R3_WN, lds + R3_S0, 32 * mt, 32 * nt, l31, hi, uu);
            st_tile_T_bf(lds + R3_UT, uu, 32 * mt, 32 * nt, l31, hi);
        } else y = mm64(lds + R3_RN, lds + R3_S0, 32 * mt, 32 * nt, l31, hi, y);
    }
    __syncthreads();
    if (wave >= 4) {
        const int mt = (wave >> 1) & 1, nt = wave & 1;
        y = mm64(lds + R3_ARB, lds + R3_UT, 32 * mt, 32 * nt, l31, hi, y);
        y = mm64(lds + R3_ARK, lds + R3_VT, 32 * mt, 32 * nt, l31, hi, y);
#pragma unroll
        for (int q = 0; q < 16; ++q) *(LAS float*)(lds + R3_YL + (32 * mt + 8 * (q >> 2) + 4 * hi + (q & 3)) * 272 + (32 * nt + l31) * 4) = y[q];
    }
    __syncthreads();
    {
        const int t = tid >> 3, i8 = (tid & 7) * 8; const size_t o = (n0 + t) * RW + cb + i8;
        const f32x4 y0 = *(const LAS f32x4*)(lds + R3_YL + t * 272 + i8 * 4), y1 = *(const LAS f32x4*)(lds + R3_YL + t * 272 + i8 * 4 + 16);
        const u32x4 rw = rw_d, kw = kw_d, vw = vw_d, gw = gw_d;
        float yy[8] = {y0[0], y0[1], y0[2], y0[3], y1[0], y1[1], y1[2], y1[3]};
        const float r[8] = {bflo(rw.x), bfhi(rw.x), bflo(rw.y), bfhi(rw.y), bflo(rw.z), bfhi(rw.z), bflo(rw.w), bfhi(rw.w)};
        const float k[8] = {bflo(kw.x), bfhi(kw.x), bflo(kw.y), bfhi(kw.y), bflo(kw.z), bfhi(kw.z), bflo(kw.w), bfhi(kw.w)};
        const float v[8] = {bflo(vw.x), bfhi(vw.x), bflo(vw.y), bfhi(vw.y), bflo(vw.z), bfhi(vw.z), bflo(vw.w), bfhi(vw.w)};
        const float g[8] = {bflo(gw.x), bfhi(gw.x), bflo(gw.y), bfhi(gw.y), bflo(gw.z), bfhi(gw.z), bflo(gw.w), bfhi(gw.w)};
        const float* gng = F.in(I_GNG) + l * RW + cb + i8; const float* gnb = F.in(I_GNB) + l * RW + cb + i8; const float* rk = F.in(I_RK) + l * RW + cb + i8;
        float sm = 0.f, bon = 0.f;
#pragma unroll
        for (int j = 0; j < 8; ++j) { sm += yy[j]; bon += r[j] * k[j] * rk[j]; }
        sm = sum8(sm); bon = sum8(bon);
        const float mean = sm * (1.f / 64.f);
        float var = 0.f;
#pragma unroll
        for (int j = 0; j < 8; ++j) { yy[j] -= mean; var += yy[j] * yy[j]; }
        var = sum8(var);
        const float inv = __builtin_amdgcn_rsqf(var * (1.f / 64.f) + 64e-5f);
        float ov[8];
#pragma unroll
        for (int j = 0; j < 8; ++j) ov[j] = (yy[j] * inv * gng[j] + gnb[j] + bon * v[j]) * g[j];
        u32x4 w; w.x = pk2(ov[0], ov[1]); w.y = pk2(ov[2], ov[3]); w.z = pk2(ov[4], ov[5]); w.w = pk2(ov[6], ov[7]);
        *(u32x4*)((bf16*)(F.ws + WS_YA) + o) = w;
    }
    __syncthreads();
}

constexpr int AT_KT = 0, AT_VT = 18432, AT_IMP = 36864, AT_MASK = 69632, AT_OUT = 70656;
struct KvRegs { u32x4 k, v; };
__device__ __forceinline__ KvRegs kv_load(const bf16* kbase, const bf16* vtbase, int vstride, int key0, int tid) {
    KvRegs r; const int row = tid >> 3, ch = (tid & 7) * 8;
    r.k = *(const u32x4*)(kbase + (size_t)(key0 + row) * 64 + ch);
    r.v = *(const u32x4*)(vtbase + (size_t)row * vstride + key0 + ch);
    return r;
}
__device__ __forceinline__ void kv_store(LAS unsigned char* lds, int buf, const KvRegs& r, int tid) {
    const int row = tid >> 3, ch = (tid & 7) * 16;
    *(LAS u32x4*)(lds + AT_KT + buf * 9216 + row * 144 + ch) = r.k;
    {   const int c = tid & 7, s_ = c >> 1, half = c & 1, dt = row >> 5, r31 = row & 31;
        LAS unsigned char* vb = lds + AT_VT + buf * 9216 + ((((dt * 4 + s_) * 2) * 32 + r31) * 16) + half * 8;
        *(LAS u32x2*)vb = (u32x2){r.v.x, r.v.y}; *(LAS u32x2*)(vb + 512) = (u32x2){r.v.z, r.v.w}; }
}
__device__ __forceinline__ void qk_tile(const LAS unsigned char* kt, const bf16x8 (&qf)[4], int l31, int hi, f32x16& s0, f32x16& s1, float init) {
#pragma unroll
    for (int q = 0; q < 16; ++q) { s0[q] = init; s1[q] = init; }
#pragma unroll
    for (int sl = 0; sl < 4; ++sl) {
        const bf16x8 a0 = *(const LAS bf16x8*)(kt + l31 * 144 + sl * 32 + hi * 16), a1 = *(const LAS bf16x8*)(kt + (32 + l31) * 144 + sl * 32 + hi * 16);
        s0 = mfma32(a0, qf[sl], s0); s1 = mfma32(a1, qf[sl], s1);
    }
}
__device__ __forceinline__ void pv_tile(const LAS unsigned char* vt, const f32x16& p0, const f32x16& p1, int l31, int hi, f32x16 (&o)[2]) {
#pragma unroll
    for (int s = 0; s < 4; ++s) {
        const f32x16& pp = (s < 2) ? p0 : p1; const int rb = (s & 1) * 8;
        bf16x8 pb; u32x4 pw;
        pw.x = pg8::cvt_pk_bf16(pp[rb + 0], pp[rb + 1]); pw.y = pg8::cvt_pk_bf16(pp[rb + 2], pp[rb + 3]); pw.z = pg8::cvt_pk_bf16(pp[rb + 4], pp[rb + 5]); pw.w = pg8::cvt_pk_bf16(pp[rb + 6], pp[rb + 7]);
        pb = __builtin_bit_cast(bf16x8, pw);
#pragma unroll
        for (int dt = 0; dt < 2; ++dt) {
            const bf16x8 vf = *(const LAS bf16x8*)(vt + ((((dt * 4 + s) * 2 + hi) * 32 + l31) * 16));
            o[dt] = mfma32(vf, pb, o[dt]);
        }
    }
}
constexpr float NEG_BIG = -1e30f;
__device__ __forceinline__ void mask_lt(f32x16& s0, f32x16& s1, int lim, int hi) {
    const int l2 = lim - 4 * hi;
#pragma unroll
    for (int q = 0; q < 16; ++q) { const int kq = 8 * (q >> 2) + (q & 3); s0[q] = (kq < l2) ? s0[q] : NEG_BIG; s1[q] = (kq + 32 < l2) ? s1[q] : NEG_BIG; }
}
__device__ __forceinline__ void mask_ge(f32x16& s0, f32x16& s1, int lim, int hi) {
    const int l2 = lim - 4 * hi;
#pragma unroll
    for (int q = 0; q < 16; ++q) { const int kq = 8 * (q >> 2) + (q & 3); s0[q] = (kq >= l2) ? s0[q] : NEG_BIG; s1[q] = (kq + 32 >= l2) ? s1[q] : NEG_BIG; }
}
constexpr float SM_OFF = -16.f;
__device__ __forceinline__ void exp_tile(f32x16& s0, f32x16& s1, float& lsum) {
    float ps = 0.f;
#pragma unroll
    for (int q = 0; q < 16; ++q) { s0[q] = __builtin_amdgcn_exp2f(s0[q]); s1[q] = __builtin_amdgcn_exp2f(s1[q]); ps += s0[q] + s1[q]; }
    lsum += ps;
}
__device__ __forceinline__ void attn_unit(const Frame& F_, int unit) {
    const Frame& F = F_;
    const int tid = F.tid, lane = F.lane, wave = F.wave, l31 = lane & 31, hi = lane >> 5;
    const int bg = unit >> 7, qb = unit & 127, b = bg >> 1, g = bg & 1;
    LAS unsigned char* lds = F.lds;
    LAS float* IMP = (LAS float*)(lds + AT_IMP); LAS unsigned* MASK = (LAS unsigned*)(lds + AT_MASK);
    const int ql = 8 * wave + (l31 >> 2), hd = l31 & 3;
    const int tq = ql;
    const size_t nq = (size_t)b * T + 64 * qb + ql;
    bf16x8 qf[4];
    {
        const bf16* qp = (const bf16*)(F.ws + NS_Q) + nq * 512 + g * 256 + hd * 64 + hi * 8;
#pragma unroll
        for (int sl = 0; sl < 4; ++sl) qf[sl] = *(const bf16x8*)(qp + sl * 16);
    }
    const float* gt = (const float*)(F.ws + NS_GATE) + nq * 24 + (g * 4 + hd) * 3;
    LAS float* outl = (LAS float*)(lds + AT_OUT) + wave * 2048 + lane;
    const bf16* kcmp = (const bf16*)(F.ws + NS_KCMP) + (size_t)bg * NCMPP * 64; const bf16* vcmpT = (const bf16*)(F.ws + NS_VCMPT) + (size_t)bg * 64 * NCMPP;
    const int ntc = (4 * qb + 3 + 63) >> 6;
    const int tabs = 64 * qb + tq;
    const int nvis = (tabs >= 31) ? ((tabs - 31) >> 4) + 1 : 0;
    const int tmin_w = 64 * qb + 8 * wave; const int nvis_min = (tmin_w >= 31) ? ((tmin_w - 31) >> 4) + 1 : 0;
    float lc = 0.f;
    f32x16 o[2];
    const bf16* ks_e = (const bf16*)(F.ws + NS_KS) + (size_t)bg * T * 64; const bf16* vsT_e = (const bf16*)(F.ws + NS_VST) + (size_t)bg * 64 * T;
    const bf16* kw_e = (const bf16*)(F.ws + NS_KW) + (size_t)bg * T * 64; const bf16* vwT_e = (const bf16*)(F.ws + NS_VWT) + (size_t)bg * 64 * T;
    const KvRegs pre_c0 = kv_load(kcmp, vcmpT, NCMPP, 0, tid);
    {
        KvRegs pre = pre_c0;
        for (int jt = 0; jt < ntc; ++jt) {
            kv_store(lds, jt & 1, pre, tid);
            if (jt + 1 < ntc) pre = kv_load(kcmp, vcmpT, NCMPP, 64 * (jt + 1), tid);
            __syncthreads();
            f32x16 s0, s1; qk_tile(lds + AT_KT + (jt & 1) * 9216, qf, l31, hi, s0, s1, SM_OFF);
            if (64 * (jt + 1) > nvis_min) { int nv = nvis - 64 * jt; asm volatile("" : "+v"(nv)); mask_lt(s0, s1, nv, hi); }
            exp_tile(s0, s1, lc);
        }
    }
    __syncthreads();
    {
        lc = sum_halves(lc);
        const float invl = (lc > 0.f) ? 1.f / lc : 0.f;
#pragma unroll
        for (int q = 0; q < 16; ++q) { o[0][q] = 0.f; o[1][q] = 0.f; }
        float carry = 0.f;
        KvRegs pre = pre_c0;
        for (int jt = 0; jt < ntc; ++jt) {
            kv_store(lds, jt & 1, pre, tid);
            if (jt + 1 < ntc) pre = kv_load(kcmp, vcmpT, NCMPP, 64 * (jt + 1), tid);
            __syncthreads();
            f32x16 s0, s1; qk_tile(lds + AT_KT + (jt & 1) * 9216, qf, l31, hi, s0, s1, SM_OFF);
            if (64 * (jt + 1) > nvis_min) { int nv = nvis - 64 * jt; asm volatile("" : "+v"(nv)); mask_lt(s0, s1, nv, hi); }
#pragma unroll
            for (int q = 0; q < 16; ++q) { s0[q] = __builtin_amdgcn_exp2f(s0[q]) * invl; s1[q] = __builtin_amdgcn_exp2f(s1[q]) * invl; }
            pv_tile(lds + AT_VT + (jt & 1) * 9216, s0, s1, l31, hi, o);
            float gs[8], ls[8];
#pragma unroll
            for (int kt = 0; kt < 2; ++kt)
#pragma unroll
                for (int j = 0; j < 4; ++j) { const f32x16& pp = kt ? s1 : s0; gs[kt * 4 + j] = quad_sum(pp[4 * j] + pp[4 * j + 1] + pp[4 * j + 2] + pp[4 * j + 3]); ls[kt * 4 + j] = quad_sum(pp[4 * j + 3]); }
            float lx[8];
#pragma unroll
            for (int i = 0; i < 8; ++i) lx[i] = other_half(ls[i], hi);
#pragma unroll
            for (int i = 0; i < 8; ++i) {
                const float add = hi ? lx[i] : (i == 0 ? carry : lx[i - 1]);
                if (hd == 0) IMP[ql * 128 + 16 * jt + 2 * i + hi] = gs[i] + add;
            }
            carry = lx[7];
        }
        const float g0 = gt[0];
#pragma unroll
        for (int q = 0; q < 16; ++q) { outl[q * 64] = g0 * o[0][q]; outl[(16 + q) * 64] = g0 * o[1][q]; }
    }
    __syncthreads();
    {
        const unsigned long long lt_mask = (1ull << lane) - 1ull;
#pragma unroll 1
        for (int qi = 0; qi < 8; ++qi) {
            const int qq = 8 * wave + qi;
            unsigned long long m0, m1;
            if (qb < 16) { m0 = __ballot(lane <= qb); m1 = 0ull; }
            else {
                const int sA = lane, sB = lane + 64;
                const unsigned kA = (sA > qb) ? 0u : ((sA == 0 || sA == qb || sA == qb - 1) ? 0x461c4000u : __builtin_bit_cast(unsigned, IMP[qq * 128 + sA]));
                const unsigned kB = (sB > qb) ? 0u : ((sB == qb || sB == qb - 1) ? 0x461c4000u : __builtin_bit_cast(unsigned, IMP[qq * 128 + sB]));
                unsigned thr = 0u;
#pragma unroll 1
                for (int bitp = 30; bitp >= 0; --bitp) { const unsigned cand = thr | (1u << bitp);
                    const int cnt = __popcll(__ballot(kA >= cand)) + __popcll(__ballot(kB >= cand)); if (cnt >= 16) { thr = cand; if (cnt == 16) break; } }
                const unsigned long long gA = __ballot(kA > thr), gB = __ballot(kB > thr), eA = __ballot(kA == thr), eB = __ballot(kB == thr);
                const int need = 16 - (__popcll(gA) + __popcll(gB));
                const bool selA = (kA > thr) || (kA == thr && __popcll(eA & lt_mask) < need);
                const bool selB = (kB > thr) || (kB == thr && __popcll(eA) + __popcll(eB & lt_mask) < need);
                m0 = __ballot(selA && sA <= qb); m1 = __ballot(selB && sB <= qb);
            }
            if (lane == 0) { MASK[qq * 4 + 0] = (unsigned)m0; MASK[qq * 4 + 1] = (unsigned)(m0 >> 32); MASK[qq * 4 + 2] = (unsigned)m1; MASK[qq * 4 + 3] = (unsigned)(m1 >> 32); }
        }
    }
    __syncthreads();
    unsigned selm[4];
#pragma unroll
    for (int i = 0; i < 4; ++i) selm[i] = MASK[ql * 4 + i];
    {
        const Frame F = relaunder(F_);
        const bf16* ks = (const bf16*)(F.ws + NS_KS) + (size_t)bg * T * 64; const bf16* vsT = (const bf16*)(F.ws + NS_VST) + (size_t)bg * 64 * T;
        float lsum = 0.f;
#pragma unroll
        for (int q = 0; q < 16; ++q) { o[0][q] = 0.f; o[1][q] = 0.f; }
        unsigned wm[4];
#pragma unroll
        for (int i = 0; i < 4; ++i) { unsigned w = 0u;
#pragma unroll
            for (int q = 0; q < 8; ++q) w |= (unsigned)__builtin_amdgcn_readlane((int)selm[i], 4 * q);
            wm[i] = w; }
        unsigned long long wlo = ((unsigned long long)wm[1] << 32) | wm[0], whi = ((unsigned long long)wm[3] << 32) | wm[2];
#define SEL_NEXT(dst) do { if (wlo) { dst = __builtin_ctzll(wlo); wlo &= wlo - 1ull; } else if (whi) { dst = 64 + __builtin_ctzll(whi); whi &= whi - 1ull; } else dst = -1; } while (0)
#define SEL_LOAD(kX, vX, jj) do { const bf16* kp_ = ks + (size_t)(jj) * 4096 + (l31 * 2 + hi) * 8; const bf16* vp_ = vsT + (size_t)(jj) * 4096 + (l31 * 2 + hi) * 8; \
            _Pragma("unroll") for (int sl = 0; sl < 4; ++sl) { kX[2 * sl] = *(const bf16x8*)(kp_ + sl * 512); kX[2 * sl + 1] = *(const bf16x8*)(kp_ + 2048 + sl * 512); } \
            _Pragma("unroll") for (int i = 0; i < 8; ++i) vX[i] = *(const bf16x8*)(vp_ + i * 512); } while (0)
#define SEL_COMPUTE(kX, vX, jj) do { \
            const unsigned bit = (((jj) & 32) ? (((jj) & 64) ? selm[3] : selm[1]) : (((jj) & 64) ? selm[2] : selm[0])) >> ((jj) & 31) & 1u; \
            const float init = bit ? SM_OFF : NEG_BIG; \
            f32x16 s0, s1; \
            _Pragma("unroll") for (int q = 0; q < 16; ++q) { s0[q] = init; s1[q] = init; } \
            _Pragma("unroll") for (int sl = 0; sl < 4; ++sl) { s0 = mfma32(kX[2 * sl], qf[sl], s0); s1 = mfma32(kX[2 * sl + 1], qf[sl], s1); } \
            if ((jj) == qb) { int tql = tq + 1; asm volatile("" : "+v"(tql)); mask_lt(s0, s1, tql, hi); } \
            exp_tile(s0, s1, lsum); \
            _Pragma("unroll") for (int sq = 0; sq < 4; ++sq) { \
                const f32x16& pp = (sq < 2) ? s0 : s1; const int rb = (sq & 1) * 8; \
                u32x4 pw; \
                pw.x = pg8::cvt_pk_bf16(pp[rb + 0], pp[rb + 1]); pw.y = pg8::cvt_pk_bf16(pp[rb + 2], pp[rb + 3]); pw.z = pg8::cvt_pk_bf16(pp[rb + 4], pp[rb + 5]); pw.w = pg8::cvt_pk_bf16(pp[rb + 6], pp[rb + 7]); \
                const bf16x8 pb = __builtin_bit_cast(bf16x8, pw); \
                _Pragma("unroll") for (int dt = 0; dt < 2; ++dt) o[dt] = mfma32(vX[dt * 4 + sq], pb, o[dt]); } } while (0)
        int j; SEL_NEXT(j);
        bf16x8 kA[8], vA[8], kB[8], vB[8];
        if (j >= 0) SEL_LOAD(kA, vA, j);
        while (j >= 0) {
            int jn; SEL_NEXT(jn);
            if (jn >= 0) SEL_LOAD(kB, vB, jn);
            SEL_COMPUTE(kA, vA, j);
            if (jn < 0) break;
            j = jn; SEL_NEXT(jn);
            if (jn >= 0) SEL_LOAD(kA, vA, jn);
            SEL_COMPUTE(kB, vB, j);
            j = jn;
        }
#undef SEL_LOAD
#undef SEL_COMPUTE
#undef SEL_NEXT
        lsum = sum_halves(lsum);
        const float sc = gt[1] / fmaxf(lsum, 1.17549435e-38f);
#pragma unroll
        for (int q = 0; q < 16; ++q) { outl[q * 64] += sc * o[0][q]; outl[(16 + q) * 64] += sc * o[1][q]; }
    }
    __syncthreads();
    {
        const Frame F = relaunder(F_); const int tid = F.tid;
        const bf16* kw = (const bf16*)(F.ws + NS_KW) + (size_t)bg * T * 64; const bf16* vwT = (const bf16*)(F.ws + NS_VWT) + (size_t)bg * 64 * T;
        float lsum = 0.f;
#pragma unroll
        for (int q = 0; q < 16; ++q) { o[0][q] = 0.f; o[1][q] = 0.f; }
        const int j0 = qb >= 8 ? qb - 8 : 0;
        KvRegs pre = kv_load(kw, vwT, T, 64 * j0, tid);
        for (int j = j0; j <= qb; ++j) {
            kv_store(lds, j & 1, pre, tid);
            if (j + 1 <= qb) pre = kv_load(kw, vwT, T, 64 * (j + 1), tid);
            __syncthreads();
            f32x16 s0, s1; qk_tile(lds + AT_KT + (j & 1) * 9216, qf, l31, hi, s0, s1, SM_OFF);
            if (j == qb || j + 8 == qb) {
                int tql = tq + 1; asm volatile("" : "+v"(tql));
                if (j == qb) mask_lt(s0, s1, tql, hi); else mask_ge(s0, s1, tql, hi);
            }
            exp_tile(s0, s1, lsum);
            pv_tile(lds + AT_VT + (j & 1) * 9216, s0, s1, l31, hi, o);
        }
        lsum = sum_halves(lsum);
        const float sc = gt[2] / fmaxf(lsum, 1.17549435e-38f);
        bf16* yb = (bf16*)(F.ws + WS_YB) + nq * 512 + g * 256 + hd * 64;
#pragma unroll
        for (int dt = 0; dt < 2; ++dt)
#pragma unroll
            for (int j = 0; j < 4; ++j) {
                float v4[4];
#pragma unroll
                for (int r = 0; r < 4; ++r) v4[r] = outl[(16 * dt + 4 * j + r) * 64] + sc * o[dt][4 * j + r];
                u32x2 w; w.x = pg8::cvt_pk_bf16(v4[0], v4[1]); w.y = pg8::cvt_pk_bf16(v4[2], v4[3]);
                *(u32x2*)(yb + 32 * dt + 8 * j + 4 * hi) = w;
            }
    }
    __syncthreads();
}
__device__ __forceinline__ void phase_mix(const Frame& F, int l, int rep) {
    unsigned* head = (unsigned*)(F.ws + WS_CTL) + CW_QUEUE + 64 * l + 16 * rep;
    LAS int* slot = (LAS int*)(F.lds + LDS_MISC + 64);
    for (;;) {
        if (F.tid == 0) *slot = (int)__hip_atomic_fetch_add(head, 1u, __ATOMIC_RELAXED, __HIP_MEMORY_SCOPE_AGENT);
        __syncthreads();
        const int it = *slot;
        __syncthreads();
        const Frame Fi = relaunder(F);
        if (it >= 16 + 512) break;
        if (it < 16) { rw2_wg(Fi, it); __syncthreads(); }
        else { const int a = it - 16; attn_unit(Fi, ((a & 3) << 7) | (127 - (a >> 2))); }
    }
}
__device__ __forceinline__ void phase_rw1(const Frame& F, int l) {
    unsigned* head = (unsigned*)(F.ws + WS_CTL) + CW_QUEUE + 64 * l + 32;
    LAS int* slot = (LAS int*)(F.lds + LDS_MISC + 64);
    for (;;) {
        if (F.tid == 0) *slot = (int)__hip_atomic_fetch_add(head, 2u, __ATOMIC_RELAXED, __HIP_MEMORY_SCOPE_AGENT);
        __syncthreads();
        const int u0 = *slot;
        __syncthreads();
        if (u0 >= 2048) break;
        { const Frame Fi = relaunder(F); rw1_unit(Fi, u0); }
        { const Frame Fi = relaunder(F); rw1_unit(Fi, u0 + 1); }
    }
}
__device__ __forceinline__ void phase_rw3(const Frame& F, int l) { for (int u = F.bid; u < 2048; u += F.G) { const Frame Fi = relaunder(F); rw3_unit(Fi, u, l); } }
__device__ __forceinline__ void phase_router(const Frame& F, int l) {
    LAS float* rwt = (LAS float*)F.lds;
    LAS float* lg = (LAS float*)(F.lds + 65536);
    LAS unsigned* lcnt = (LAS unsigned*)(F.lds + 65536 + 2048);
    if (F.tid < 32) lcnt[F.tid] = 0u;
    for (int i = F.tid; i < 16384; i += NTHR) { const int c = i >> 4, e = i & 15; rwt[e * 1024 + c] = F.in(I_RTW)[i]; }
    __syncthreads();
    const bf16* xin = (const bf16*)(F.ws + WS_XR);
    int* texp = (int*)(F.ws + WS_TOK); int* tpos = (int*)(F.ws + WS_TOK + 131072); float* tw = (float*)(F.ws + WS_TOK + 2 * 131072);
    unsigned* cnt = (unsigned*)(F.ws + WS_CTL) + CW_CNT + 64 * l;
    const float* ng = F.in(I_NORMG) + (size_t)(l * 2 + 1) * D;
    LAS float* mylg = lg + F.wave * 64;
    bf16* H2 = (bf16*)(F.ws + WS_H); int* e2t = (int*)(F.ws + WS_E2T);
    for (int n4 = (F.bid * NWAVE + F.wave) * 4; n4 < NTOK; n4 += F.G * NWAVE * 4) {
        const int b = n4 / T; const float* sh = F.modp(l, b) + 3072; const float* scp = sh + 1024;
        float hv[4][16];
#pragma unroll
        for (int tk = 0; tk < 4; ++tk) {
            f32x4 xv[4]; float ss = 0.f;
#pragma unroll
            for (int j = 0; j < 4; ++j) { const u32x2 xr = *(const u32x2*)(xin + (size_t)(n4 + tk) * D + 4 * F.lane + 256 * j); xv[j] = (f32x4){bflo(xr.x), bfhi(xr.x), bflo(xr.y), bfhi(xr.y)}; ss += xv[j][0] * xv[j][0] + xv[j][1] * xv[j][1] + xv[j][2] * xv[j][2] + xv[j][3] * xv[j][3]; }
            ss = sum64(ss);
            const float inv = __builtin_amdgcn_rsqf(ss * (1.f / D) + 1e-6f);
#pragma unroll
            for (int j = 0; j < 4; ++j) { const int c = 4 * F.lane + 256 * j; const f32x4 g = *(const f32x4*)(ng + c), s1 = *(const f32x4*)(scp + c), s0 = *(const f32x4*)(sh + c);
#pragma unroll
                for (int q = 0; q < 4; ++q) hv[tk][4 * j + q] = xv[j][q] * inv * g[q] * (1.f + s1[q]) + s0[q];
                u32x2 w; w.x = pk2(hv[tk][4 * j], hv[tk][4 * j + 1]); w.y = pk2(hv[tk][4 * j + 2], hv[tk][4 * j + 3]);
                *(u32x2*)(H2 + (size_t)(n4 + tk) * D + c) = w; }
        }
        float acc[64];
#pragma unroll
        for (int i = 0; i < 64; ++i) acc[i] = 0.f;
#pragma unroll
        for (int e = 0; e < 16; ++e)
#pragma unroll
            for (int j = 0; j < 4; ++j) { const f32x4 w = *(const LAS f32x4*)(rwt + e * 1024 + 4 * F.lane + 256 * j);
#pragma unroll
                for (int tk = 0; tk < 4; ++tk) acc[tk * 16 + e] += hv[tk][4 * j] * w[0] + hv[tk][4 * j + 1] * w[1] + hv[tk][4 * j + 2] * w[2] + hv[tk][4 * j + 3] * w[3]; }
#define RT_STEP(MSK, XCHG) do { const bool up = (F.lane & (MSK)) != 0; \
            _Pragma("unroll") for (int i = 0; i < (MSK); ++i) { const float keep = up ? acc[i + (MSK)] : acc[i], send = up ? acc[i] : acc[i + (MSK)]; acc[i] = keep + XCHG; } } while (0)
        RT_STEP(32, other_half(send, F.lane >> 5)); RT_STEP(16, xor_lane<16>(send)); RT_STEP(8, xor_lane<8>(send)); RT_STEP(4, xor_lane<4>(send)); RT_STEP(2, xor_lane<2>(send)); RT_STEP(1, xor_lane<1>(send));
#undef RT_STEP
        mylg[F.lane] = acc[0];
        __builtin_amdgcn_fence(__ATOMIC_RELEASE, "workgroup"); __builtin_amdgcn_s_waitcnt(0xc07f); __builtin_amdgcn_fence(__ATOMIC_ACQUIRE, "workgroup");
        if (F.lane < 4) {
            const int tk = F.lane, n = n4 + tk;
            float sc[16], sl[16];
#pragma unroll
            for (int e = 0; e < 16; ++e) { sc[e] = sigmoidf_(mylg[tk * 16 + e]); sl[e] = sc[e] + F.in(I_RTB)[e]; }
            int bestg = 0; float bests = -1e30f;
#pragma unroll
            for (int gq = 0; gq < 4; ++gq) { float m1 = -1e30f, m2 = -1e30f;
#pragma unroll
                for (int j = 0; j < 4; ++j) { const float v = sl[gq * 4 + j]; if (v > m1) { m2 = m1; m1 = v; } else if (v > m2) m2 = v; }
                const float gs = m1 + m2; if (gs > bests) { bests = gs; bestg = gq; } }
            float v1 = -1e30f, v2 = -1e30f; int e1 = 0, e2 = 0; float s1 = 0.f, s2 = 0.f;
#pragma unroll
            for (int gq = 0; gq < 4; ++gq)
#pragma unroll
                for (int j = 0; j < 4; ++j) { if (gq == bestg) { const float v = sl[gq * 4 + j], s = sc[gq * 4 + j]; const int e = gq * 4 + j;
                    if (v > v1) { v2 = v1; e2 = e1; s2 = s1; v1 = v; e1 = e; s1 = s; } else if (v > v2) { v2 = v; e2 = e; s2 = s; } } }
            const float den = s1 + s2;
            texp[n * 2] = e1; texp[n * 2 + 1] = e2; tw[n * 2] = s1 / den; tw[n * 2 + 1] = s2 / den;
            tpos[n * 2] = (int)__hip_atomic_fetch_add(lcnt + e1, 1u, __ATOMIC_RELAXED, __HIP_MEMORY_SCOPE_WORKGROUP);
            tpos[n * 2 + 1] = (int)__hip_atomic_fetch_add(lcnt + e2, 1u, __ATOMIC_RELAXED, __HIP_MEMORY_SCOPE_WORKGROUP);
        }
    }
    __syncthreads();
    if (F.tid < NE) { const unsigned c = lcnt[F.tid]; lcnt[16 + F.tid] = c ? __hip_atomic_fetch_add(cnt + F.tid, c, __ATOMIC_RELAXED, __HIP_MEMORY_SCOPE_AGENT) : 0u; }
    __syncthreads();
    for (int n4 = (F.bid * NWAVE + F.wave) * 4; n4 < NTOK; n4 += F.G * NWAVE * 4)
        if (F.lane < 8) { const int i = (n4 + (F.lane >> 1)) * 2 + (F.lane & 1); const int e = texp[i], p = tpos[i] + (int)lcnt[16 + e]; tpos[i] = p; e2t[e * 16384 + p] = i >> 1; }
}
constexpr int PH_PER_LAYER = 14, N_PHASES = 1 + DEPTH * PH_PER_LAYER + 1;
#define KIND(k) ((k) == 0 ? 0 : ((k) == N_PHASES - 1 ? PH_PER_LAYER + 1 : (((k) - 1) % PH_PER_LAYER) + 1))
#define IN(k) ((KSEL < 0 || KIND(k) == KSEL) && lo <= (k) && (k) < hi)
#define SEAM(k) do { if (IN(k) && IN((k) + 1)) { XcdBarrier b2_ = bar; unsigned* q_ = b2_.bar; unsigned x_ = b2_.x; asm volatile("" : "+s"(q_), "+s"(x_)); b2_.bar = q_; b2_.x = x_; xcd_barrier(b2_); } } while (0)
#define FRESH() do { int t_ = threadIdx.x; asm volatile("" : "+v"(t_)); F.tid = t_; F.lane = t_ & 63; F.wave = __builtin_amdgcn_readfirstlane(t_ >> 6); \
        const CAS Params* k_ = (const CAS Params*)__builtin_amdgcn_kernarg_segment_ptr(); asm volatile("" : "+s"(k_)); F.p = k_; \
        GAS unsigned char* w_ = (GAS unsigned char*)k_->ws; asm volatile("" : "+s"(w_)); F.ws = (unsigned char*)w_; int b_ = blockIdx.x; asm volatile("" : "+s"(b_)); F.bid = b_; int g_ = gridDim.x; asm volatile("" : "+s"(g_)); F.G = g_; } while (0)

template <int KSEL, int l>
__device__ __forceinline__ void layer_phases(Frame& F, const XcdBarrier& bar, const int lo, const int hi) {
    constexpr int pb = 1 + PH_PER_LAYER * l;
        if (IN(pb + 0)) { FRESH(); if (l == 0) { phase_norm<false, true>(F, 0, 0); FRESH(); phase_convert_weights(F); } else phase_norm<true, true>(F, l, l - 1); }
        SEAM(pb + 0);
        if (IN(pb + 1)) { FRESH();
            pg8::Gemm g{(const bf16*)(F.ws + WS_H), F.lw(l, LW_WIN1), D}; pg8::StaticOrder S; S.init(NTOK, N1P, F.G, F.bid);
            pg8::EpiBf16<0> E{(bf16*)(F.ws + WS_P1), N1P, F.in(I_BIN) + (size_t)l * INC};
            pg8::gemm_phase(F.lds, g, S, E, F.tid);
        }
        SEAM(pb + 1);
        if (IN(pb + 2)) { FRESH(); phase_prep(F, l); }
        SEAM(pb + 2);
        if (IN(pb + 3)) { FRESH(); phase_compress(F, l); FRESH(); phase_rw1(F, l); }
        SEAM(pb + 3);
        if (IN(pb + 5)) { FRESH(); phase_mix(F, l, 0); }
        SEAM(pb + 5);
        if (IN(pb + 6)) { FRESH(); phase_rw3(F, l); }
        SEAM(pb + 6);
        if (IN(pb + 7)) { FRESH();
            pg8::Gemm g{(const bf16*)(F.ws + WS_H), F.lw(l, LW_WM), D}; pg8::MergePairOrder S; S.base.init(NTOK, D, F.G, F.bid);
            pg8::EpiBf16<1> E{(bf16*)(F.ws + WS_PM), NMRG, F.in(I_BIN) + (size_t)l * INC + N1};
            pg8::gemm_phase(F.lds, g, S, E, F.tid);
        }
        if (IN(pb + 8)) { FRESH();
            static_assert(WS_YB == WS_YA + (size_t)NTOK * RW * 2 && LW_UPB == LW_UPA + (size_t)D * RW * 2, "y_b follows y_a, W_up_nsa follows W_up_rwkv");
            pg8::UpPairOrder S; S.base.init(NTOK, D, F.G, F.bid);
            pg8::Gemm g{(const bf16*)(F.ws + WS_YA), F.lw(l, LW_UPA), RW}; pg8::EpiUpPair E{(const bf16*)(F.ws + WS_PM), (bf16*)(F.ws + WS_MIX)};
            pg8::gemm_phase(F.lds, g, S, E, F.tid);
        }
        SEAM(pb + 8);
        if (IN(pb + 9)) { FRESH();
            pg8::Gemm g{(const bf16*)(F.ws + WS_MIX), F.lw(l, LW_OUT), D}; pg8::StaticOrder S; S.init(NTOK, D, F.G, F.bid);
            pg8::EpiOut E{l == 0 ? F.in(I_X) : (const float*)F.outp(), (bf16*)(F.ws + WS_XR), F.modp(l, 0) + 2048};
            pg8::gemm_phase(F.lds, g, S, E, F.tid);
        }
        SEAM(pb + 9);
        if (IN(pb + 10)) { FRESH(); phase_router(F, l); __syncthreads(); FRESH(); convert_experts(F, l); }
        SEAM(pb + 10);
        if (IN(pb + 12)) { FRESH(); const LAS int* tb = moe_tables(F, l);
            pg8::Gemm g{(const bf16*)(F.ws + WS_H), (const bf16*)(F.ws + WS_WGU), D}; pg8::MoeOrder S{tb, F.G, F.bid, (const int*)(F.ws + WS_E2T)};
            pg8::EpiGateUp E{(bf16*)(F.ws + WS_ACT)};
            pg8::gemm_phase<pg8::EpiGateUp, pg8::MoeOrder, true, true, true>(F.lds, g, S, E, F.tid);
        }
        SEAM(pb + 12);
        if (IN(pb + 13)) { FRESH(); const LAS int* tb = moe_tables(F, l);
            pg8::Gemm g{(const bf16*)(F.ws + WS_ACT), (const bf16*)(F.ws + WS_WD), DE}; pg8::MoeOrder S{tb, F.G, F.bid, (const int*)(F.ws + WS_E2T)};
            pg8::EpiBf16<0> E{(bf16*)(F.ws + WS_YBS), D, nullptr};
            pg8::gemm_phase(F.lds, g, S, E, F.tid);
        }
        SEAM(pb + 13);
    }

template <int KSEL>
__global__ void __launch_bounds__(NTHR, 2) mk_fwd(Params prm) {
    extern __shared__ __attribute__((aligned(16))) unsigned char lds_raw[];
    Frame F; F.p = (const CAS Params*)__builtin_amdgcn_kernarg_segment_ptr(); F.lds = (LAS unsigned char*)lds_raw; F.ws = F.p->ws; F.tid = threadIdx.x; F.lane = F.tid & 63; F.wave = __builtin_amdgcn_readfirstlane(F.tid >> 6); F.G = gridDim.x; F.bid = blockIdx.x;
    if (F.tid < 64) ((LAS unsigned*)(F.lds + LDS_MISC))[F.tid] = 0u;
    __syncthreads();
    const int lo = F.p->ph_lo, hi = F.p->ph_hi;
    XcdBarrier bar; bar.bar = (unsigned*)(F.ws + WS_CTL) + CW_BAR + F.p->li * XCD_BAR_WORDS; bar.x = 0; bar.st = (volatile LAS unsigned*)(F.lds + LDS_MISC);
    if (hi - lo > 1) bar = xcd_barrier_post((unsigned*)(F.ws + WS_CTL) + CW_BAR + F.p->li * XCD_BAR_WORDS, (volatile LAS unsigned*)(F.lds + LDS_MISC));
    if (IN(0)) { FRESH(); phase_prologue(F); }
    SEAM(0);
    layer_phases<KSEL, 0>(F, bar, lo, hi);
    layer_phases<KSEL, 1>(F, bar, lo, hi);
    if (IN(N_PHASES - 1)) { FRESH(); phase_norm<true, false>(F, 0, DEPTH - 1); }

}

#if MK_N_LAUNCHES == 1
static hipError_t set_lds_attr() { return hipFuncSetAttribute((const void*)mk_fwd<-1>, hipFuncAttributeMaxDynamicSharedMemorySize, LDS_BYTES); }
#else
template <int K> static hipError_t set_lds_attr_k() { hipError_t e = hipFuncSetAttribute((const void*)mk_fwd<K>, hipFuncAttributeMaxDynamicSharedMemorySize, LDS_BYTES); if (e != hipSuccess) return e; if constexpr (K > 0) return set_lds_attr_k<K - 1>(); else return hipSuccess; }
static hipError_t set_lds_attr() { return set_lds_attr_k<PH_PER_LAYER + 1>(); }
template <int K> static void launch_kind_k(int kind, int grid, hipStream_t stream, const Params& p) {
    if (kind == K) { hipLaunchKernelGGL(mk_fwd<K>, dim3(grid), dim3(NTHR), LDS_BYTES, stream, p); return; }
    if constexpr (K > 0) launch_kind_k<K - 1>(kind, grid, stream, p);
}
static void launch_kind(int kind, int grid, hipStream_t stream, const Params& p) { launch_kind_k<PH_PER_LAYER + 1>(kind, grid, stream, p); }
#endif
extern "C" void kernel_launch(void* const* d_in, const int* in_sizes, int n_in, void* d_out, int out_size, void* d_ws, size_t ws_size, hipStream_t stream) {
    static int grid = 0;
    if (grid == 0) {
        if (n_in != 30 || in_sizes[0] != NTOK * D || out_size != NTOK * D || ws_size < WS_END) {
            fprintf(stderr, "kernel_launch: unexpected problem: n_in %d in0 %d out %d ws %zu (need %zu); nothing launched\n", n_in, n_in > 0 ? in_sizes[0] : -1, out_size, ws_size, (size_t)WS_END); grid = -1; return; }
        int dev = 0, cus = 0;
        if (hipGetDevice(&dev) != hipSuccess || hipDeviceGetAttribute(&cus, hipDeviceAttributeMultiprocessorCount, dev) != hipSuccess) { grid = -1; return; }
        if (set_lds_attr() != hipSuccess) { fprintf(stderr, "kernel_launch: hipFuncSetAttribute failed\n"); grid = -1; return; }
        (void)hipGetLastError();
        grid = cus;
    }
    if (grid < 0) return;
    (void)hipMemsetAsync((char*)d_ws + WS_CTL, 0, CTL_BYTES, stream);
    Params p{};
    for (int i = 0; i < 30; ++i) p.in[i] = (const float*)d_in[i];
    p.out = (float*)d_out; p.ws = (unsigned char*)d_ws;
#if MK_N_LAUNCHES == 1
#ifdef MK_CUTS
    { const int cuts[] = {0, MK_CUTS, N_PHASES}; const int nc = (int)(sizeof(cuts) / sizeof(int));
      for (int i = 0; i + 1 < nc; ++i) { p.ph_lo = cuts[i]; p.ph_hi = cuts[i + 1]; p.li = i; hipLaunchKernelGGL(mk_fwd<-1>, dim3(grid), dim3(NTHR), LDS_BYTES, stream, p); } }
#else
    p.ph_lo = 0; p.ph_hi = N_PHASES;
    hipLaunchKernelGGL(mk_fwd<-1>, dim3(grid), dim3(NTHR), LDS_BYTES, stream, p);
#endif
#else
    for (int k = 0; k < N_PHASES; ++k) { p.ph_lo = k; p.ph_hi = k + 1; launch_kind(KIND(k), grid, stream, p); }
#endif
}
```

```cpp
#include <hip/hip_runtime.h>
#include <cstdio>
#include <cstdint>

#ifndef MK_N_LAUNCHES
#define MK_N_LAUNCHES 1
#endif

#define LAS __attribute__((address_space(3)))
typedef unsigned short bf16;
typedef short bf16x8 __attribute__((ext_vector_type(8)));
typedef short bf16x4 __attribute__((ext_vector_type(4)));
typedef float f32x4 __attribute__((ext_vector_type(4)));
typedef float f32x16 __attribute__((ext_vector_type(16)));
typedef float f32x2 __attribute__((ext_vector_type(2)));
typedef unsigned u32x4 __attribute__((ext_vector_type(4)));
typedef unsigned u32x2 __attribute__((ext_vector_type(2)));

constexpr int NB = 2, T = 8192, D = 1024, NTOK = NB * T, DEPTH = 2;
constexpr int RW = 512, RCOLS = 1792;
constexpr int QOFF = 1792, KVOFF = 2304, GOFF = 3072;
constexpr int N1 = 3096, N1P = 3072;
constexpr int NMRG = 2048, INC = 5144;
constexpr int NE = 16, DE = 512, NSLOT = 36864;
constexpr int NCMP = 511, NCMPP = 512;

constexpr size_t MiB = 1u << 20;
constexpr size_t WS_CTL = 0, CTL_BYTES = 1 * MiB;
constexpr size_t WS_SMALL = 1 * MiB;
constexpr size_t SM_MOD = 0;
constexpr size_t SM_ROPE = 128 * 1024;
constexpr size_t SM_CMPB = 704 * 1024;
constexpr size_t SM_BLK = 720 * 1024;
constexpr size_t SM_S2T = 768 * 1024;
constexpr size_t WS_TOK = 2 * MiB;
constexpr size_t WS_W = 3 * MiB;
constexpr size_t LW_WIN1 = 0;
constexpr size_t LW_WM = LW_WIN1 + (size_t)N1P * D * 2;
constexpr size_t LW_UPA = LW_WM + (size_t)NMRG * D * 2;
constexpr size_t LW_UPB = LW_UPA + (size_t)D * RW * 2;
constexpr size_t LW_OUT = LW_UPB + (size_t)D * RW * 2;
constexpr size_t LW_C1 = LW_OUT + (size_t)D * D * 2;
constexpr size_t LW_C2 = LW_C1 + (size_t)2 * 256 * 2048 * 2;
constexpr size_t LW_L2 = LW_C2 + (size_t)2 * 64 * 256 * 2;
constexpr size_t LW_A2 = LW_L2 + (size_t)512 * 64 * 2;
constexpr size_t LW_G2 = LW_A2 + (size_t)512 * 64 * 2;
constexpr size_t LW_WG = LW_G2 + (size_t)512 * 128 * 2;
constexpr size_t LW_BYTES = ((LW_WG + (size_t)64 * 1024 * 2 + MiB - 1) / MiB) * MiB;
constexpr size_t WS_H = WS_W + 2 * LW_BYTES;
constexpr size_t WS_R = WS_H + 32 * MiB;
constexpr size_t WS_P1 = WS_R;
constexpr size_t WS_RW = WS_R + 104 * MiB;
constexpr size_t RWT = (size_t)NTOK * RW * 2;
constexpr size_t WS_NSA = WS_RW + 128 * MiB;
constexpr size_t NS_Q = WS_NSA;
constexpr size_t KVT = (size_t)4 * T * 64 * 2;
constexpr size_t NS_KS = NS_Q + 16 * MiB, NS_KW = NS_KS + KVT, NS_VST = NS_KW + KVT, NS_VWT = NS_VST + KVT, NS_KC = NS_VWT + KVT, NS_VC = NS_KC + KVT;
constexpr size_t NS_KCMP = NS_VC + KVT;
constexpr size_t NS_VCMPT = NS_KCMP + (size_t)4 * 512 * 64 * 2;
constexpr size_t NS_GATE = NS_VCMPT + (size_t)4 * 512 * 64 * 2;
constexpr size_t NS_END = NS_GATE + (size_t)NTOK * 24 * 4;
constexpr size_t WS_Y = WS_R;
constexpr size_t WS_YA = WS_R + 32 * MiB, WS_YB = WS_YA + 16 * MiB;
constexpr size_t WS_WN = WS_R + 64 * MiB;
constexpr size_t WS_UPN = WS_R + 80 * MiB;
constexpr size_t WS_GC = WS_R + 96 * MiB;
constexpr size_t WS_PT = WS_R;
constexpr size_t WS_S0 = WS_RW + 48 * MiB;
constexpr size_t WS_PM = WS_R + 64 * MiB;
constexpr size_t WS_TMP = WS_R + 128 * MiB;
constexpr size_t WS_MIX = WS_R + 160 * MiB;
constexpr size_t WS_E2T = WS_R + 32 * MiB;
constexpr size_t WS_XR = WS_R;
constexpr size_t WS_XB = WS_H;
constexpr size_t WS_ACT = WS_XB + 72 * MiB;
constexpr size_t WS_YBS = WS_ACT + 36 * MiB;
constexpr size_t WS_WGU = WS_YBS + 72 * MiB;
constexpr size_t WS_WD = WS_WGU + 32 * MiB;
constexpr size_t WS_END_MOE = WS_WD + 16 * MiB;
constexpr size_t WS_END = (NS_END > WS_END_MOE ? NS_END : WS_END_MOE);
static_assert(WS_MIX + 32 * MiB <= WS_NSA + 64 * MiB, "map");
static_assert(WS_END <= 370 * MiB, "workspace too large");

constexpr int CW_QUEUE = 256;
constexpr int CW_CNT = 512;
constexpr int CW_BAR = 4096;

typedef __bf16 bf16x2_h __attribute__((ext_vector_type(2)));
__device__ __forceinline__ unsigned pk2(float lo, float hi) { const f32x2 v = {lo, hi}; const bf16x2_h b = __builtin_convertvector(v, bf16x2_h); return __builtin_bit_cast(unsigned, b); }
__device__ __forceinline__ unsigned f2bf(float f) { return pk2(f, 0.f) & 0xffffu; }
__device__ __forceinline__ float bf2f(unsigned h) { return __builtin_bit_cast(float, h << 16); }
__device__ __forceinline__ float bflo(unsigned w) { return __builtin_bit_cast(float, w << 16); }
__device__ __forceinline__ float bfhi(unsigned w) { return __builtin_bit_cast(float, w & 0xffff0000u); }
__device__ __forceinline__ float rcpf_(float x) { return __builtin_amdgcn_rcpf(x); }
__device__ __forceinline__ float sigmoidf_(float x) { return rcpf_(1.f + __expf(-x)); }
template <int CTRL> __device__ __forceinline__ float dpp_mov(float v) { return __builtin_bit_cast(float, __builtin_amdgcn_update_dpp(0, __builtin_bit_cast(int, v), CTRL, 0xF, 0xF, true)); }
template <int M> __device__ __forceinline__ float xor_lane(float v) {
    if constexpr (M == 1) return dpp_mov<0xB1>(v); else if constexpr (M == 2) return dpp_mov<0x4E>(v); else return __shfl_xor(v, M, 64);
}
__device__ __forceinline__ float sum_halves(float v) { return v + __shfl_xor(v, 32, 64); }
__device__ __forceinline__ float max_halves(float v) { return fmaxf(v, __shfl_xor(v, 32, 64)); }
__device__ __forceinline__ float other_half(float v, int hi) { return __shfl_xor(v, 32, 64); }
__device__ __forceinline__ float sum8(float v) { v += dpp_mov<0xB1>(v); v += dpp_mov<0x4E>(v); v += dpp_mov<0x141>(v); return v; }
__device__ __forceinline__ float sum16(float v) { v = sum8(v); v += dpp_mov<0x140>(v); return v; }
__device__ __forceinline__ float sum32(float v) { v = sum16(v); v += xor_lane<16>(v); return v; }
__device__ __forceinline__ float sum64(float v) { return sum_halves(sum32(v)); }

#define XB_TMO      128
#define XB_XCNT(j)  (256  + 64 * (j))
#define XB_XSUB(j)  (1280 + 64 * (j))
#define XB_XGEN(j)  (2304 + 64 * (j))
#define XB_TOP      3328
#define XB_TOPGEN   3392
#define XCD_BAR_WORDS 3456
#define XB_SPIN_CAP (1u << 22)
__device__ __forceinline__ unsigned xb_ld(unsigned* p)              { return __hip_atomic_load(p, __ATOMIC_RELAXED, __HIP_MEMORY_SCOPE_AGENT); }
__device__ __forceinline__ unsigned xb_add(unsigned* p, unsigned v) { return __hip_atomic_fetch_add(p, v, __ATOMIC_RELAXED, __HIP_MEMORY_SCOPE_AGENT); }
__device__ __forceinline__ unsigned xb_xcc_id() { return (unsigned)__builtin_amdgcn_s_getreg((3 << 11) | 20) & 0xFu; }
#define XB_SPIN(cond, bar) do { unsigned _sp = 0; while (cond) { __builtin_amdgcn_s_sleep(1); \
    if ((++_sp & 255u) == 0u) { if (xb_ld(&(bar)[XB_TMO])) break; if (_sp > XB_SPIN_CAP) { atomicAdd(&(bar)[XB_TMO], 1u); break; } } } } while (0)
struct XcdBarrier { unsigned* bar; unsigned x; volatile LAS unsigned* st; };
__device__ __forceinline__ XcdBarrier xcd_barrier_post(unsigned* bar, volatile LAS unsigned* st) {
    XcdBarrier b; b.bar = bar; b.x = xb_xcc_id(); b.st = st;
    if (threadIdx.x == 0) (void)xb_add(&bar[XB_XCNT(b.x)], 1u);
    return b;
}
__device__ __forceinline__ void xcd_barrier_complete(unsigned* bar, unsigned x, unsigned& nloc, unsigned& nx) {
    const unsigned G = gridDim.x * gridDim.y * gridDim.z;
    unsigned sum, cnt, mine, sp = 0u;
    for (;;) {
        sum = 0u; cnt = 0u; mine = 0u;
#pragma unroll
        for (unsigned j = 0; j < 16; ++j) { const unsigned c = xb_ld(&bar[XB_XCNT(j)]); sum += c; cnt += (c > 0u) ? 1u : 0u; mine = (j == x) ? c : mine; }
        if (sum == G) break;
        __builtin_amdgcn_s_sleep(1);
        if ((++sp & 255u) == 0u) { if (xb_ld(&bar[XB_TMO])) break; if (sp > XB_SPIN_CAP) { atomicAdd(&bar[XB_TMO], 1u); break; } }
    }
    nloc = mine > 0u ? mine : 1u; nx = cnt > 0u ? cnt : 1u;
}
__device__ __forceinline__ void xcd_barrier(const XcdBarrier& b) {
    asm volatile("s_waitcnt vmcnt(0)" ::: "memory");
    __syncthreads();
    if (threadIdx.x == 0) {
        unsigned* bar = b.bar;
        __builtin_amdgcn_s_waitcnt(0);
        unsigned nloc = b.st[0], nx = b.st[1];
        if (nloc == 0u) { xcd_barrier_complete(bar, b.x, nloc, nx); b.st[0] = nloc; b.st[1] = nx; }
        const unsigned old = xb_add(&bar[XB_XSUB(b.x)], 1u);
        const unsigned gen = old / nloc;
        if (old + 1u == (gen + 1u) * nloc) {
            __builtin_amdgcn_fence(__ATOMIC_RELEASE, "agent");
            asm volatile("s_waitcnt vmcnt(0)" ::: "memory");
            const unsigned og = xb_add(&bar[XB_TOP], 1u);
            const unsigned tg = og / nx;
            if (og + 1u == (tg + 1u) * nx) xb_add(&bar[XB_TOPGEN], 1u);
            else XB_SPIN(xb_ld(&bar[XB_TOPGEN]) == tg, bar);
            __builtin_amdgcn_fence(__ATOMIC_ACQUIRE, "agent");
            xb_add(&bar[XB_XGEN(b.x)], 1u);
            asm volatile("s_waitcnt vmcnt(0)" ::: "memory");
        } else {
            XB_SPIN(xb_ld(&bar[XB_XGEN(b.x)]) == gen, bar);
            __builtin_amdgcn_fence(__ATOMIC_ACQUIRE, "agent");
            asm volatile("s_waitcnt vmcnt(0)" ::: "memory");
        }
    }
    __syncthreads();
}

namespace pg8 {
#define PG8_LAS __attribute__((address_space(3)))
typedef unsigned short bf16_t;
constexpr int BM = 256, BK = 64, HALF = 128, HTB = HALF * BK * 2, STAGE_BYTES = 8 * HTB, NXCD = 8, WGM = 8;
__host__ __device__ __forceinline__ int lds_byte(int r, int c) { const int st = (r >> 4) * 2 + (c >> 5), rr = r & 15, cc = c & 31, ob = rr * 64 + cc * 2; return st * 1024 + (ob ^ (((ob >> 9) & 1) << 5)); }
__host__ __device__ __forceinline__ void stage_rc(int b, int& R, int& C) { const int st = b / 1024, sb = b % 1024, swz = sb ^ (((sb >> 9) & 1) << 5); R = (st >> 1) * 16 + swz / 64; C = (st & 1) * 32 + (swz % 64) / 2; }
__host__ __device__ __forceinline__ int perm32(int rho) { const int n = rho >> 4, i = rho & 15; return 8 * (i >> 2) + 4 * n + (i & 3); }
struct Unit { int pm, pn, bt, part; };
struct Gemm { const bf16_t* A; const bf16_t* Bt; int K; };
struct StaticOrder {
    int nM, nN, nwg, G, c;
    __device__ void init(int M, int N, int G_, int c_) { nM = M / BM; nN = N / BM; nwg = nM * nN; G = G_; c = c_; }
    __device__ bool next(int i, Unit& u) const {
        const long L = (long)i * G + c; if (L >= nwg) return false;
        int wgid = (int)L; { const int q = nwg / NXCD, r = nwg % NXCD, xcd = wgid % NXCD, off = wgid / NXCD; wgid = (xcd < r ? xcd * (q + 1) : r * (q + 1) + (xcd - r) * q) + off; }
        const int nig = WGM * nN, gid = wgid / nig, fm = gid * WGM, gsz = (nM - fm) < WGM ? (nM - fm) : WGM;
        u.pm = fm + ((wgid % nig) % gsz); u.pn = (wgid % nig) / gsz; u.bt = u.pn; u.part = 1; return true;
    }
};
struct MergePairOrder {
    StaticOrder base;
    __device__ bool next(int i, Unit& u) const { Unit b; if (!base.next(i >> 1, b)) return false; u.pm = b.pm; u.pn = b.pn + 4 * (i & 1); u.bt = u.pn; u.part = 1; return true; }
};
struct UpPairOrder {
    StaticOrder base;
    __device__ bool next(int i, Unit& u) const { Unit b; if (!base.next(i >> 1, b)) return false; const int p = i & 1; u.pm = b.pm + 64 * p; u.pn = b.pn; u.bt = b.pn + 4 * p; u.part = p; return true; }
};
struct MoeOrder {
    const PG8_LAS int* tb; int G, c; const int* e2t;
    __device__ bool next(int i, Unit& u) const {
        const int L = i * G + c; if (L >= tb[0] * 4) return false;
        u.pm = L >> 2; u.pn = L & 3; u.bt = tb[64 + u.pm] * 4 + u.pn; u.part = 1; return true;
    }
    __device__ int row_token(int pm, int r) const {
        const int e = tb[64 + pm], p = (pm - tb[1 + e]) * BM + r;
        return p < tb[17 + e] ? ((const __attribute__((address_space(1))) int*)e2t)[e * 16384 + p] : 0;
    }
};
typedef __bf16 bf16x2_c __attribute__((ext_vector_type(2)));
__device__ __forceinline__ unsigned cvt_pk_bf16(float lo, float hi) { const f32x2 v = {lo, hi}; const bf16x2_c b = __builtin_convertvector(v, bf16x2_c); return __builtin_bit_cast(unsigned, b); }

template <class Epi, class Sched, bool ALIGN_EPI = true, bool SP2 = true, bool GATHER = false>
__device__ __forceinline__ void gemm_phase(PG8_LAS unsigned char* lds, const Gemm g, const Sched& S, const Epi& E, const int tid, const int* rowidx = nullptr) {
    static_assert(!GATHER || SP2, "gather is wired into the SP2 schedule only");
    const int wid = __builtin_amdgcn_readfirstlane(tid >> 6), lane = tid & 63, wr = wid >> 2, wc = wid & 3, fr = lane & 15, fq = lane >> 4;
    const int K = g.K, nt = K / BK;
    unsigned voffA[2], voffB[2]; int rowA[2]; unsigned colA[2];
#pragma unroll
    for (int i = 0; i < 2; ++i) { int R, C; stage_rc(tid * 16 + i * 8192, R, C); const int Rb = Epi::PERM ? ((R & ~31) + perm32(R & 31)) : R;
        voffA[i] = (unsigned)(R * K + C) * 2u; voffB[i] = (unsigned)(Rb * K + C) * 2u; rowA[i] = R; colA[i] = (unsigned)C * 2u; }
    unsigned cvo[2][2], nvo[2][2];
#define PG8_VO(dst, pmv) do { _Pragma("unroll") for (int _h = 0; _h < 2; ++_h) _Pragma("unroll") for (int _i = 0; _i < 2; ++_i) dst[_h][_i] = (unsigned)S.row_token((pmv), _h * HALF + rowA[_i]) * (unsigned)(K * 2) + colA[_i]; } while (0)
#define PG8_VOCP(dst, src) do { _Pragma("unroll") for (int _h = 0; _h < 2; ++_h) _Pragma("unroll") for (int _i = 0; _i < 2; ++_i) dst[_h][_i] = src[_h][_i]; } while (0)
    const size_t kstep = (size_t)(BK * 2);
    const size_t hstep = (size_t)HALF * K * 2;
    const size_t tstep = 2 * hstep;
    const unsigned ldsw = (unsigned)wid * 1024u;
    const int aoff = lds_byte(wr * 64 + fr, fq * 8), boff = lds_byte(wc * 32 + fr, fq * 8);
#define PG8_SA(b, h) (((b) * 2 + (h)) * HTB)
#define PG8_SB(b, h) ((4 + (b) * 2 + (h)) * HTB)
#define PG8_STAGE(bufoff, gbase, voff) do { _Pragma("unroll") for (int _i = 0; _i < 2; ++_i) \
        __builtin_amdgcn_global_load_lds((const unsigned*)((const char*)(gbase) + (voff)[_i]), (PG8_LAS unsigned*)(lds + (bufoff) + ldsw + _i * 8192), 16, 0, 0); } while (0)
#define PG8_STAGE_A(bufoff, kb, h, nx) do { if constexpr (GATHER) { const unsigned vo_[2] = {(nx) ? nvo[h][0] : cvo[h][0], (nx) ? nvo[h][1] : cvo[h][1]}; PG8_STAGE(bufoff, kb, vo_); } \
        else { PG8_STAGE(bufoff, (kb) + (h) * hstep, voffA); } } while (0)
#define PG8_LDA(dst, b, h) do { _Pragma("unroll") for (int m = 0; m < 4; ++m) _Pragma("unroll") for (int k = 0; k < 2; ++k) dst[m][k] = *(const PG8_LAS bf16x8*)(lds + PG8_SA(b, h) + aoff + m * 2048 + k * 1024); } while (0)
#define PG8_LDB(dst, b, h) do { _Pragma("unroll") for (int n = 0; n < 2; ++n) _Pragma("unroll") for (int k = 0; k < 2; ++k) dst[n][k] = *(const PG8_LAS bf16x8*)(lds + PG8_SB(b, h) + boff + n * 2048 + k * 1024); } while (0)
#define PG8_MMA(ai, bj, At, Bt) do { __builtin_amdgcn_s_setprio(1); _Pragma("unroll") for (int m = 0; m < 4; ++m) _Pragma("unroll") for (int n = 0; n < 2; ++n) _Pragma("unroll") for (int k = 0; k < 2; ++k) \
        acc[ai][bj][m][n] = __builtin_amdgcn_mfma_f32_16x16x32_bf16(Bt[n][k], At[m][k], acc[ai][bj][m][n], 0, 0, 0); __builtin_amdgcn_s_setprio(0); } while (0)
#define PG8_WAIT_V(n) asm volatile("s_waitcnt vmcnt(" #n ")" ::: "memory")
#define PG8_WAIT_L(n) asm volatile("s_waitcnt lgkmcnt(" #n ")" ::: "memory")
#define PG8_BAR __builtin_amdgcn_s_barrier()
#define PG8_SCHED __builtin_amdgcn_sched_barrier(0)
    Unit cur, nxt; int ui = 0; bool has_next = false;
    if (!S.next(0, cur)) return;
    if constexpr (GATHER) { PG8_VO(cvo, cur.pm); has_next = S.next(1, nxt); if (has_next) PG8_VO(nvo, nxt.pm); else PG8_VOCP(nvo, cvo); }
    f32x4 acc[2][2][4][2];
#pragma unroll
    for (int a = 0; a < 2; ++a)
#pragma unroll
        for (int b = 0; b < 2; ++b)
#pragma unroll
            for (int m = 0; m < 4; ++m)
#pragma unroll
                for (int n = 0; n < 2; ++n) acc[a][b][m][n] = (f32x4){0.f, 0.f, 0.f, 0.f};
    bf16x8 At[4][2], B0[2][2], B1[2][2];
    const char* cA = (const char*)g.A + (GATHER ? (size_t)0 : (size_t)cur.pm * tstep); const char* cB = (const char*)g.Bt + (size_t)cur.bt * tstep;
    if constexpr (SP2) {
        PG8_STAGE(PG8_SB(0, 0), cB, voffB); PG8_STAGE(PG8_SB(0, 1), cB + hstep, voffB); PG8_STAGE_A(PG8_SA(0, 0), cA, 0, false); PG8_STAGE_A(PG8_SA(0, 1), cA, 1, false);
        if (wr == 1) PG8_BAR;
        PG8_WAIT_V(2); PG8_BAR;
        PG8_STAGE(PG8_SB(1, 0), cB + kstep, voffB); PG8_STAGE_A(PG8_SA(1, 0), cA + kstep, 0, false); PG8_STAGE(PG8_SB(1, 1), cB + hstep + kstep, voffB);
        PG8_WAIT_V(6); PG8_BAR;
    } else {
        PG8_STAGE(PG8_SB(0, 0), cB, voffB); PG8_STAGE(PG8_SA(0, 0), cA, voffA); PG8_STAGE(PG8_SB(0, 1), cB + hstep, voffB); PG8_STAGE(PG8_SA(0, 1), cA + hstep, voffA);
        if (wr == 1) PG8_BAR;
        PG8_WAIT_V(4); PG8_BAR;
        PG8_STAGE(PG8_SB(1, 0), cB + kstep, voffB); PG8_STAGE(PG8_SA(1, 0), cA + kstep, voffA); PG8_STAGE(PG8_SB(1, 1), cB + hstep + kstep, voffB);
        PG8_WAIT_V(6); PG8_BAR;
    }
    for (;;) {
        if constexpr (!GATHER) has_next = S.next(ui + 1, nxt);
        const char* nA = (has_next && !GATHER) ? (const char*)g.A + (size_t)nxt.pm * tstep : cA; const char* nB = has_next ? (const char*)g.Bt + (size_t)nxt.bt * tstep : cB;
        for (int t = 0; t < nt; t += 2) {
            const bool last = (t == nt - 2);
            const char* a1 = cA + (size_t)(t + 1) * kstep;
            const char* a2 = last ? nA : cA + (size_t)(t + 2) * kstep; const char* b2 = last ? nB : cB + (size_t)(t + 2) * kstep;
            const char* a3 = a2 + kstep; const char* b3 = b2 + kstep;
            if constexpr (SP2) {
            PG8_LDB(B0, 0, 0); PG8_LDB(B1, 0, 1); PG8_SCHED; PG8_LDA(At, 0, 0); PG8_STAGE_A(PG8_SA(1, 1), a1, 1, false);
            PG8_WAIT_V(8); PG8_WAIT_L(0); PG8_BAR; PG8_MMA(0, 0, At, B0); PG8_MMA(0, 1, At, B1); PG8_BAR; PG8_SCHED;
            PG8_LDA(At, 0, 1); PG8_STAGE(PG8_SB(0, 0), b2, voffB); PG8_STAGE(PG8_SB(0, 1), b2 + hstep, voffB); PG8_STAGE_A(PG8_SA(0, 0), a2, 0, last);
            PG8_WAIT_V(8); PG8_WAIT_L(0); PG8_BAR; PG8_MMA(1, 0, At, B0); PG8_MMA(1, 1, At, B1); PG8_BAR; PG8_SCHED;
            PG8_LDB(B0, 1, 0); PG8_LDB(B1, 1, 1); PG8_SCHED; PG8_LDA(At, 1, 0); PG8_STAGE_A(PG8_SA(0, 1), a2, 1, last);
            PG8_WAIT_V(8); PG8_WAIT_L(0); PG8_BAR; PG8_MMA(0, 0, At, B0); PG8_MMA(0, 1, At, B1); PG8_BAR; PG8_SCHED;
            PG8_LDA(At, 1, 1); PG8_STAGE(PG8_SB(1, 0), b3, voffB); PG8_STAGE(PG8_SB(1, 1), b3 + hstep, voffB); PG8_STAGE_A(PG8_SA(1, 0), a3, 0, last);
            PG8_WAIT_V(8); PG8_WAIT_L(0); PG8_BAR; PG8_MMA(1, 0, At, B0); PG8_MMA(1, 1, At, B1); PG8_BAR; PG8_SCHED;
            } else {
            PG8_LDB(B0, 0, 0); PG8_SCHED; PG8_LDA(At, 0, 0); PG8_STAGE(PG8_SA(1, 1), a1 + hstep, voffA);
            PG8_WAIT_L(8); PG8_BAR; PG8_WAIT_L(0); PG8_MMA(0, 0, At, B0); PG8_BAR; PG8_SCHED;
            PG8_LDB(B1, 0, 1); PG8_STAGE(PG8_SB(0, 0), b2, voffB);
            PG8_BAR; PG8_WAIT_L(0); PG8_MMA(0, 1, At, B1); PG8_BAR;
            PG8_LDA(At, 0, 1); PG8_STAGE(PG8_SA(0, 0), a2, voffA);
            PG8_BAR; PG8_WAIT_L(0); PG8_MMA(1, 0, At, B0); PG8_BAR; PG8_SCHED;
            PG8_STAGE(PG8_SB(0, 1), b2 + hstep, voffB);
            PG8_WAIT_V(6); PG8_BAR; PG8_MMA(1, 1, At, B1); PG8_BAR;
            PG8_LDB(B0, 1, 0); PG8_SCHED; PG8_LDA(At, 1, 0); PG8_STAGE(PG8_SA(0, 1), a2 + hstep, voffA);
            PG8_WAIT_L(8); PG8_BAR; PG8_WAIT_L(0); PG8_MMA(0, 0, At, B0); PG8_BAR; PG8_SCHED;
            PG8_LDB(B1, 1, 1); PG8_STAGE(PG8_SB(1, 0), b3, voffB);
            PG8_BAR; PG8_WAIT_L(0); PG8_MMA(0, 1, At, B1); PG8_BAR;
            PG8_LDA(At, 1, 1); PG8_STAGE(PG8_SA(1, 0), a3, voffA);
            PG8_BAR; PG8_WAIT_L(0); PG8_MMA(1, 0, At, B0); PG8_BAR; PG8_SCHED;
            PG8_STAGE(PG8_SB(1, 1), b3 + hstep, voffB);
            PG8_WAIT_V(6); PG8_BAR; PG8_MMA(1, 1, At, B1); PG8_BAR;
            }
        }
        Unit nn = nxt; bool has_nn = false; unsigned nnvo[2][2];
        if constexpr (GATHER) { has_nn = has_next && S.next(ui + 2, nn); if (has_nn) PG8_VO(nnvo, nn.pm); else PG8_VOCP(nnvo, nvo); }
        if constexpr (ALIGN_EPI) { if (wr == 0) PG8_BAR; }
        bool keep = false;
        if constexpr (Epi::PAIRED) { if (cur.part == 0) { E.mid(acc, cur, wr, wc, fr, fq); keep = true; } }
        if (!keep) E(acc, cur, wr, wc, fr, fq);
        if (!has_next) break;
        if (!keep) {
#pragma unroll
        for (int a = 0; a < 2; ++a)
#pragma unroll
            for (int b = 0; b < 2; ++b)
#pragma unroll
                for (int m = 0; m < 4; ++m)
#pragma unroll
                    for (int n = 0; n < 2; ++n) acc[a][b][m][n] = (f32x4){0.f, 0.f, 0.f, 0.f};
        }
        cur = nxt; cA = nA; cB = nB; ++ui;
        if constexpr (GATHER) { PG8_VOCP(cvo, nvo); PG8_VOCP(nvo, nnvo); nxt = nn; has_next = has_nn; }
        if constexpr (ALIGN_EPI) { if (wr == 1) PG8_BAR; }
    }
    PG8_WAIT_V(0);
    if constexpr (!ALIGN_EPI) { if (wr == 0) PG8_BAR; }
    PG8_BAR;
#undef PG8_SA
#undef PG8_SB
#undef PG8_STAGE
#undef PG8_LDA
#undef PG8_STAGE_A
#undef PG8_VO
#undef PG8_VOCP
#undef PG8_LDB
#undef PG8_MMA
#undef PG8_WAIT_V
#undef PG8_WAIT_L
#undef PG8_BAR
#undef PG8_SCHED
}

template <int ACT  > struct EpiBf16 {
    static constexpr bool PERM = true, PAIRED = false;
    bf16_t* O; int ldc; const float* bias;
    __device__ __forceinline__ void operator()(const f32x4 (&acc)[2][2][4][2], const Unit& u, int wr, int wc, int fr, int fq) const {
        const int row0 = u.pm * BM + wr * 64 + fr; const int col0 = u.pn * BM + wc * 32 + 8 * fq;
        f32x4 bv[2][2];
#pragma unroll
        for (int bj = 0; bj < 2; ++bj)
#pragma unroll
            for (int n = 0; n < 2; ++n) bv[bj][n] = bias ? *(const f32x4*)(bias + col0 + bj * HALF + 4 * n) : (f32x4){0.f, 0.f, 0.f, 0.f};
#pragma unroll
        for (int ai = 0; ai < 2; ++ai)
#pragma unroll
            for (int m = 0; m < 4; ++m) { bf16_t* rowp = O + (size_t)(row0 + ai * HALF + m * 16) * ldc + col0;
#pragma unroll
                for (int bj = 0; bj < 2; ++bj) { f32x4 v0 = acc[ai][bj][m][0] + bv[bj][0], v1 = acc[ai][bj][m][1] + bv[bj][1];
                    if (ACT == 1) {
#pragma unroll
                        for (int j = 0; j < 4; ++j) { v0[j] = __builtin_amdgcn_rcpf(1.f + __expf(-v0[j])); v1[j] = __builtin_amdgcn_rcpf(1.f + __expf(-v1[j])); } }
                    u32x4 w; w.x = cvt_pk_bf16(v0[0], v0[1]); w.y = cvt_pk_bf16(v0[2], v0[3]); w.z = cvt_pk_bf16(v1[0], v1[1]); w.w = cvt_pk_bf16(v1[2], v1[3]);
                    *(u32x4*)(rowp + bj * HALF) = w; } }
    }
};
template <int MODE> struct EpiUp {
    static constexpr bool PERM = true, PAIRED = false;
    const bf16_t* PMg; bf16_t* TMP; bf16_t* MIX;
    __device__ __forceinline__ void operator()(const f32x4 (&acc)[2][2][4][2], const Unit& u, int wr, int wc, int fr, int fq) const {
        const int row0 = u.pm * BM + wr * 64 + fr; const int col0 = u.pn * BM + wc * 32 + 8 * fq;
#pragma unroll
        for (int ai = 0; ai < 2; ++ai)
#pragma unroll
            for (int m = 0; m < 4; ++m) { const size_t row = (size_t)(row0 + ai * HALF + m * 16);
#pragma unroll
                for (int bj = 0; bj < 2; ++bj) { const int col = col0 + bj * HALF;
                    const u32x4 gw = *(const u32x4*)(PMg + row * NMRG + (MODE ? 1024 : 0) + col);
                    float gt[8] = {bflo(gw.x), bfhi(gw.x), bflo(gw.y), bfhi(gw.y), bflo(gw.z), bfhi(gw.z), bflo(gw.w), bfhi(gw.w)};
                    float v[8];
#pragma unroll
                    for (int j = 0; j < 4; ++j) { v[j] = acc[ai][bj][m][0][j] * gt[j]; v[4 + j] = acc[ai][bj][m][1][j] * gt[4 + j]; }
                    if (MODE == 1) { const u32x4 tw = *(const u32x4*)(TMP + row * D + col);
                        v[0] += bflo(tw.x); v[1] += bfhi(tw.x); v[2] += bflo(tw.y); v[3] += bfhi(tw.y); v[4] += bflo(tw.z); v[5] += bfhi(tw.z); v[6] += bflo(tw.w); v[7] += bfhi(tw.w); }
                    u32x4 w; w.x = cvt_pk_bf16(v[0], v[1]); w.y = cvt_pk_bf16(v[2], v[3]); w.z = cvt_pk_bf16(v[4], v[5]); w.w = cvt_pk_bf16(v[6], v[7]);
                    *(u32x4*)((MODE ? MIX : TMP) + row * D + col) = w; } }
    }
};
struct EpiUpPair {
    static constexpr bool PERM = true, PAIRED = true;
    const bf16_t* PMg; bf16_t* MIX;
    __device__ __forceinline__ void mid(f32x4 (&acc)[2][2][4][2], const Unit& u, int wr, int wc, int fr, int fq) const {
        const int row0 = u.pm * BM + wr * 64 + fr; const int col0 = u.pn * BM + wc * 32 + 8 * fq;
#pragma unroll
        for (int ai = 0; ai < 2; ++ai)
#pragma unroll
            for (int m = 0; m < 4; ++m) { const size_t row = (size_t)(row0 + ai * HALF + m * 16);
#pragma unroll
                for (int bj = 0; bj < 2; ++bj) { const int col = col0 + bj * HALF;
                    const u32x4 ga = *(const u32x4*)(PMg + row * NMRG + col), gb = *(const u32x4*)(PMg + row * NMRG + 1024 + col);
                    const float na[8] = {bflo(ga.x), bfhi(ga.x), bflo(ga.y), bfhi(ga.y), bflo(ga.z), bfhi(ga.z), bflo(ga.w), bfhi(ga.w)};
                    const float nb[8] = {bflo(gb.x), bfhi(gb.x), bflo(gb.y), bfhi(gb.y), bflo(gb.z), bfhi(gb.z), bflo(gb.w), bfhi(gb.w)};
#pragma unroll
                    for (int j = 0; j < 4; ++j) { acc[ai][bj][m][0][j] *= na[j] * __builtin_amdgcn_rcpf(nb[j]); acc[ai][bj][m][1][j] *= na[4 + j] * __builtin_amdgcn_rcpf(nb[4 + j]); } } }
    }
    __device__ __forceinline__ void operator()(const f32x4 (&acc)[2][2][4][2], const Unit& u, int wr, int wc, int fr, int fq) const {
        const int row0 = (u.pm - 64) * BM + wr * 64 + fr; const int col0 = u.pn * BM + wc * 32 + 8 * fq;
#pragma unroll
        for (int ai = 0; ai < 2; ++ai)
#pragma unroll
            for (int m = 0; m < 4; ++m) { const size_t row = (size_t)(row0 + ai * HALF + m * 16);
#pragma unroll
                for (int bj = 0; bj < 2; ++bj) { const int col = col0 + bj * HALF;
                    const u32x4 gb = *(const u32x4*)(PMg + row * NMRG + 1024 + col);
                    const float nb[8] = {bflo(gb.x), bfhi(gb.x), bflo(gb.y), bfhi(gb.y), bflo(gb.z), bfhi(gb.z), bflo(gb.w), bfhi(gb.w)};
                    u32x4 w; w.x = cvt_pk_bf16(acc[ai][bj][m][0][0] * nb[0], acc[ai][bj][m][0][1] * nb[1]); w.y = cvt_pk_bf16(acc[ai][bj][m][0][2] * nb[2], acc[ai][bj][m][0][3] * nb[3]);
                    w.z = cvt_pk_bf16(acc[ai][bj][m][1][0] * nb[4], acc[ai][bj][m][1][1] * nb[5]); w.w = cvt_pk_bf16(acc[ai][bj][m][1][2] * nb[6], acc[ai][bj][m][1][3] * nb[7]);
                    *(u32x4*)(MIX + row * D + col) = w; } }
    }
};
template <bool XBF  > struct EpiOut {
    static constexpr bool PERM = true, PAIRED = false;
    const void* Xin; bf16_t* Xout; const float* gate;
    __device__ __forceinline__ void operator()(const f32x4 (&acc)[2][2][4][2], const Unit& u, int wr, int wc, int fr, int fq) const {
        const int row0 = u.pm * BM + wr * 64 + fr, col0 = u.pn * BM + wc * 32 + 8 * fq;
        const float* gp = gate + (size_t)((u.pm * BM) / T) * 6144;
        f32x4 gv[2][2];
#pragma unroll
        for (int bj = 0; bj < 2; ++bj)
#pragma unroll
            for (int n = 0; n < 2; ++n) gv[bj][n] = *(const f32x4*)(gp + col0 + bj * HALF + n * 4);
#pragma unroll
        for (int ai = 0; ai < 2; ++ai)
#pragma unroll
            for (int m = 0; m < 4; ++m) { const size_t ro = (size_t)(row0 + ai * HALF + m * 16) * D + col0;
#pragma unroll
                for (int bj = 0; bj < 2; ++bj) {
                    f32x4 xa, xb;
                    if constexpr (XBF) { const u32x4 xr = *(const u32x4*)((const bf16_t*)Xin + ro + bj * HALF); xa = (f32x4){bflo(xr.x), bfhi(xr.x), bflo(xr.y), bfhi(xr.y)}; xb = (f32x4){bflo(xr.z), bfhi(xr.z), bflo(xr.w), bfhi(xr.w)}; }
                    else { xa = *(const f32x4*)((const float*)Xin + ro + bj * HALF); xb = *(const f32x4*)((const float*)Xin + ro + bj * HALF + 4); }
                    const f32x4 r0 = xa + gv[bj][0] * acc[ai][bj][m][0], r1 = xb + gv[bj][1] * acc[ai][bj][m][1];
                    u32x4 w; w.x = cvt_pk_bf16(r0[0], r0[1]); w.y = cvt_pk_bf16(r0[2], r0[3]); w.z = cvt_pk_bf16(r1[0], r1[1]); w.w = cvt_pk_bf16(r1[2], r1[3]);
                    *(u32x4*)(Xout + ro + bj * HALF) = w; } }
    }
};
struct EpiGateUp {
    static constexpr bool PERM = true, PAIRED = false;
    bf16_t* ACT;
    __device__ __forceinline__ void operator()(const f32x4 (&acc)[2][2][4][2], const Unit& u, int wr, int wc, int fr, int fq) const {
        const int row0 = u.pm * BM + wr * 64 + fr; const int col0 = u.pn * HALF + wc * 32 + 8 * fq;
#pragma unroll
        for (int ai = 0; ai < 2; ++ai)
#pragma unroll
            for (int m = 0; m < 4; ++m) { bf16_t* rowp = ACT + (size_t)(row0 + ai * HALF + m * 16) * DE + col0;
                float v[8];
#pragma unroll
                for (int n = 0; n < 2; ++n)
#pragma unroll
                    for (int j = 0; j < 4; ++j) { const float gq = acc[ai][0][m][n][j], uq = acc[ai][1][m][n][j]; v[4 * n + j] = gq * __builtin_amdgcn_rcpf(1.f + __expf(-gq)) * uq; }
                u32x4 w; w.x = cvt_pk_bf16(v[0], v[1]); w.y = cvt_pk_bf16(v[2], v[3]); w.z = cvt_pk_bf16(v[4], v[5]); w.w = cvt_pk_bf16(v[6], v[7]);
                *(u32x4*)rowp = w; }
    }
};
}

constexpr int NTHR = 512, NWAVE = 8;
constexpr int LDS_BYTES = 147456;
constexpr int LDS_MISC = 143360;
struct Params { const float* in[30]; float* out; unsigned char* ws; int ph_lo, ph_hi, li, pad; };
enum { I_X = 0, I_C, I_WADA, I_BADA, I_NORMG, I_WIN, I_BIN, I_MU, I_W0, I_W2, I_A0, I_A2, I_G2, I_KK, I_KA, I_RK, I_GNG, I_GNB, I_QKG, I_CPOS, I_CW1, I_CW2, I_UPA, I_UPB, I_WOUT, I_RTW, I_RTB, I_EG, I_EU, I_ED };

#define CAS __attribute__((address_space(4)))
#define GAS __attribute__((address_space(1)))
template <class T> __device__ __forceinline__ T* as_global(T* p) { return (T*)(GAS T*)p; }
struct Frame {
    const CAS Params* p; LAS unsigned char* lds; unsigned char* ws; int tid, lane, wave, G, bid;
    __device__ __forceinline__ const float* in(int i) const { return as_global(p->in[i]); }
    __device__ __forceinline__ float* outp() const { return as_global(p->out); }
    __device__ __forceinline__ float* modp(int l, int b) const { return (float*)(ws + WS_SMALL + SM_MOD) + ((size_t)l * 2 + b) * 6144; }
    __device__ __forceinline__ bf16* lw(int l, size_t off) const { return (bf16*)(ws + WS_W + (size_t)l * LW_BYTES + off); }
};

__device__ __forceinline__ Frame relaunder(const Frame& F0) {
    Frame F = F0; int t_ = F0.tid; GAS unsigned char* w_ = (GAS unsigned char*)F0.ws; asm volatile("" : "+v"(t_), "+s"(w_)); F.tid = t_; F.lane = t_ & 63; F.wave = __builtin_amdgcn_readfirstlane(t_ >> 6); F.ws = (unsigned char*)w_; return F;
}
template <class RowMap>
__device__ __forceinline__ void xpose_job(const Frame& F, const float* src, int ld, int K, int c0, int nvalid, int npad, bf16* dst, RowMap rm, int& rot) {
    const int kparts = (K >= 512) ? 4 : 1, kspan = K / kparts, kw = kspan >> 3;
    const int nunit = (npad >> 6) * kparts;
    int start = (F.bid + F.G - (rot % F.G)) % F.G;
    for (int t = start; t < nunit; t += F.G) {
        const int kp = t % kparts, n_i = t / kparts;
        const int n = n_i * 64 + F.lane; const bool valid = n < nvalid;
        const float* sp = src + (size_t)(kp * kspan + F.wave * kw) * ld + c0 + n;
        bf16* dp = dst + (size_t)(rm(n_i) + F.lane) * K + kp * kspan + F.wave * kw;
#pragma unroll 2
        for (int k = 0; k < kw; k += 8) {
            float v[8];
#pragma unroll
            for (int j = 0; j < 8; ++j) v[j] = valid ? sp[(size_t)(k + j) * ld] : 0.f;
            u32x4 w; w.x = pk2(v[0], v[1]); w.y = pk2(v[2], v[3]); w.z = pk2(v[4], v[5]); w.w = pk2(v[6], v[7]);
            *(u32x4*)(dp + k) = w;
        }
    }
    rot += nunit;
}
struct RmId { __device__ int operator()(int n_i) const { return n_i * 64; } };
struct RmGate { int up; __device__ int operator()(int n_i) const { return 256 * (n_i >> 1) + 64 * (n_i & 1) + (up ? 128 : 0); } };

__device__ __forceinline__ double sin_poly(double x) {
    const double x2 = x * x; double term = x, sum = x;
#pragma unroll
    for (int k = 1; k <= 14; ++k) { term *= -x2 / (double)((2 * k) * (2 * k + 1)); sum += term; }
    return sum;
}
__device__ __forceinline__ double cos_poly(double x) {
    const double x2 = x * x; double term = 1.0, sum = 1.0;
#pragma unroll
    for (int k = 1; k <= 14; ++k) { term *= -x2 / (double)((2 * k - 1) * (2 * k)); sum += term; }
    return sum;
}

__device__ __forceinline__ void phase_prologue(const Frame& F) {
    const int tid = F.tid, G = F.G, bid = F.bid;
    {
        const double invf[8] = {1.0, 0.19392274474868576, 0.03760603093086393, 0.007292664737217109, 0.001414213562373095, 0.0002742481756762073, 5.318295896944988e-05, 1.031338537721246e-05};
        float* rope = (float*)(F.ws + WS_SMALL + SM_ROPE);
        for (int idx = bid * NTHR + tid; idx < T * 8; idx += G * NTHR) {
            const int t = idx >> 3, i = idx & 7;
            double fr = 1.0;
#pragma unroll
            for (int q = 0; q < 8; ++q) fr = (i == q) ? invf[q] : fr;
            double a = (double)t * fr; double r = a * 0.15915494309189535; r -= __builtin_floor(r + 0.5);
            const double x = r * 6.283185307179586;
            rope[t * 16 + i] = (float)cos_poly(x); rope[t * 16 + 8 + i] = (float)sin_poly(x);
        }
    }
    {
        LAS float* sc = (LAS float*)F.lds;
        LAS float* red = sc + 2048;
        for (int i = tid; i < 2048; i += NTHR) { const float cv = F.in(I_C)[i]; sc[i] = cv / (1.f + __expf(-cv)); }
        __syncthreads();
        for (int u = bid; u < 192; u += G) {
            const int l = u / 96, c0 = (u % 96) * 64, col = c0 + F.lane;
            const float* wp = F.in(I_WADA) + (size_t)l * D * 6144 + col;
            float a0 = 0.f, a1 = 0.f;
            const int kb = F.wave * 128;
#pragma unroll 8
            for (int k = 0; k < 128; ++k) { const float wv = wp[(size_t)(kb + k) * 6144]; a0 += sc[kb + k] * wv; a1 += sc[1024 + kb + k] * wv; }
            red[(F.wave * 2 + 0) * 64 + F.lane] = a0; red[(F.wave * 2 + 1) * 64 + F.lane] = a1;
            __syncthreads();
            if (tid < 128) { const int b = tid >> 6, ln = tid & 63; float s = 0.f;
#pragma unroll
                for (int w = 0; w < 8; ++w) s += red[(w * 2 + b) * 64 + ln];
                F.modp(l, b)[c0 + ln] = s + F.in(I_BADA)[l * 6144 + c0 + ln]; }
            __syncthreads();
        }
    }
    {
        LAS float* red = (LAS float*)F.lds;
        for (int u = bid; u < 16; u += G) {
            const int li = u >> 2, q = u & 3, c = tid & 255, hf = tid >> 8;
            const float* pos = F.in(I_CPOS) + (size_t)li * 2048 + q * 512 + hf * 256;
            const float* w1 = F.in(I_CW1) + (size_t)li * 2048 * 256 + (size_t)(q * 512 + hf * 256) * 256 + c;
            float a = 0.f;
#pragma unroll 8
            for (int j = 0; j < 256; ++j) a += pos[j] * w1[(size_t)j * 256];
            red[tid] = a; __syncthreads();
            if (tid < 256) ((float*)(F.ws + WS_SMALL + SM_CMPB))[(li * 4 + q) * 256 + tid] = red[tid] + red[tid + 256];
            __syncthreads();
        }
    }
}
__device__ __forceinline__ void phase_convert_weights(const Frame& F) {
    int rot = 0;
#pragma unroll 1
    for (int jj = 0; jj < DEPTH * 13; ++jj) {
        const int l = jj / 13, j = jj - l * 13;
        const float* src; int ld, K, c0 = 0, nvalid, npad; bf16* dst;
        if (j == 0)      { src = F.in(I_WIN) + (size_t)l * D * INC; ld = INC; K = D; nvalid = N1P; npad = N1P; dst = F.lw(l, LW_WIN1); }
        else if (j == 1) { src = F.in(I_WIN) + (size_t)l * D * INC; ld = INC; K = D; c0 = N1; nvalid = NMRG; npad = NMRG; dst = F.lw(l, LW_WM); }
        else if (j == 2) { src = F.in(I_UPA) + (size_t)l * RW * D; ld = D; K = RW; nvalid = D; npad = D; dst = F.lw(l, LW_UPA); }
        else if (j == 3) { src = F.in(I_UPB) + (size_t)l * RW * D; ld = D; K = RW; nvalid = D; npad = D; dst = F.lw(l, LW_UPB); }
        else if (j == 4) { src = F.in(I_WOUT) + (size_t)l * D * D; ld = D; K = D; nvalid = D; npad = D; dst = F.lw(l, LW_OUT); }
        else if (j <= 6) { const int i = j - 5; src = F.in(I_CW1) + (size_t)(l * 2 + i) * 2048 * 256; ld = 256; K = 2048; nvalid = 256; npad = 256; dst = F.lw(l, LW_C1) + (size_t)i * 256 * 2048; }
        else if (j <= 8) { const int i = j - 7; src = F.in(I_CW2) + (size_t)(l * 2 + i) * 256 * 64; ld = 64; K = 256; nvalid = 64; npad = 64; dst = F.lw(l, LW_C2) + (size_t)i * 64 * 256; }
        else if (j == 9) { src = F.in(I_W2) + (size_t)l * 64 * RW; ld = RW; K = 64; nvalid = RW; npad = RW; dst = F.lw(l, LW_L2); }
        else if (j == 10) { src = F.in(I_A2) + (size_t)l * 64 * RW; ld = RW; K = 64; nvalid = RW; npad = RW; dst = F.lw(l, LW_A2); }
        else if (j == 11) { src = F.in(I_G2) + (size_t)l * 128 * RW; ld = RW; K = 128; nvalid = RW; npad = RW; dst = F.lw(l, LW_G2); }
        else { src = F.in(I_WIN) + (size_t)l * D * INC; ld = INC; K = D; c0 = N1P; nvalid = 24; npad = 64; dst = F.lw(l, LW_WG); }
        xpose_job(F, src, ld, K, c0, nvalid, npad, dst, RmId{}, rot);
    }
}
__device__ __forceinline__ void convert_experts(const Frame& F, int l) {
    int rot = 0;
    for (int e = 0; e < NE; ++e) {
        bf16* wgu = (bf16*)(F.ws + WS_WGU) + (size_t)e * 1024 * 1024;
        xpose_job(F, F.in(I_EG) + ((size_t)l * NE + e) * D * DE, DE, D, 0, DE, DE, wgu, RmGate{0}, rot);
        xpose_job(F, F.in(I_EU) + ((size_t)l * NE + e) * D * DE, DE, D, 0, DE, DE, wgu, RmGate{1}, rot);
        xpose_job(F, F.in(I_ED) + ((size_t)l * NE + e) * DE * D, D, DE, 0, D, D, (bf16*)(F.ws + WS_WD) + (size_t)e * 1024 * 512, RmId{}, rot);
    }
}

constexpr int LDS_MOETB = LDS_MISC + 1024;
__device__ __forceinline__ LAS int* moe_tables(const Frame& F, int l) {
    LAS int* tb = (LAS int*)(F.lds + LDS_MOETB);
    if (F.tid < NE) tb[17 + F.tid] = (int)__hip_atomic_load((const unsigned*)(F.ws + WS_CTL) + CW_CNT + 64 * l + F.tid, __ATOMIC_RELAXED, __HIP_MEMORY_SCOPE_AGENT);
    __syncthreads();
    if (F.tid == 0) { int nb = 0;
        for (int e = 0; e < NE; ++e) { tb[1 + e] = nb; nb += (tb[17 + e] + 255) >> 8; }
        tb[0] = nb; }
    __syncthreads();
    if (F.tid < tb[0]) { int e = 0;
#pragma unroll
        for (int q = 1; q < NE; ++q) e += (tb[1 + q] <= F.tid) ? 1 : 0;
        tb[64 + F.tid] = e; }
    __syncthreads();
    return tb;
}

template <bool COMBINE, bool NORM, bool FROM_OUT = false>
__device__ __forceinline__ void phase_norm(const Frame& F, int l, int lc) {
    const float* xin = (COMBINE || FROM_OUT) ? F.outp() : F.in(I_X);
    bf16* H = (bf16*)(F.ws + WS_H);
    const int* texp = (const int*)(F.ws + WS_TOK); const int* tpos = (const int*)(F.ws + WS_TOK + 131072); const float* tw = (const float*)(F.ws + WS_TOK + 2 * 131072);
    const LAS int* tb = COMBINE ? moe_tables(F, lc) : nullptr;
    const bf16* yb = (const bf16*)(F.ws + WS_YBS);
    constexpr int RB = COMBINE ? 2 : 4;
    const int rstride = F.G * NWAVE;
    for (int nb = F.bid * NWAVE + F.wave; nb < NTOK; nb += rstride * RB) {
        f32x4 xv[RB][4]; u32x2 y0[RB][4], y1[RB][4]; float w0[RB], w1[RB];
#pragma unroll
        for (int r = 0; r < RB; ++r) { const int n = (nb + r * rstride < NTOK) ? nb + r * rstride : nb;
#pragma unroll
            for (int j = 0; j < 4; ++j) {
                if (COMBINE) { const u32x2 xr = *(const u32x2*)((const bf16*)(F.ws + WS_XR) + (size_t)n * D + 4 * F.lane + 256 * j); xv[r][j] = (f32x4){bflo(xr.x), bfhi(xr.x), bflo(xr.y), bfhi(xr.y)}; }
                else xv[r][j] = *(const f32x4*)(xin + (size_t)n * D + 4 * F.lane + 256 * j); }
            if (COMBINE) { const int s0 = tb[1 + texp[n * 2]] * 256 + tpos[n * 2], s1 = tb[1 + texp[n * 2 + 1]] * 256 + tpos[n * 2 + 1]; w0[r] = tw[n * 2]; w1[r] = tw[n * 2 + 1];
#pragma unroll
                for (int j = 0; j < 4; ++j) { const int c = 4 * F.lane + 256 * j; y0[r][j] = *(const u32x2*)(yb + (size_t)s0 * D + c); y1[r][j] = *(const u32x2*)(yb + (size_t)s1 * D + c); } }
        }
#pragma unroll
        for (int r = 0; r < RB; ++r) { const int n = (nb + r * rstride < NTOK) ? nb + r * rstride : nb; const int b = n / T;
            if (COMBINE) {
                const float* gf = F.modp(lc, b) + 5120;
#pragma unroll
                for (int j = 0; j < 4; ++j) {
                    const int c = 4 * F.lane + 256 * j;
                    const f32x4 gv = *(const f32x4*)(gf + c);
                    xv[r][j][0] += gv[0] * (w0[r] * bflo(y0[r][j].x) + w1[r] * bflo(y1[r][j].x)); xv[r][j][1] += gv[1] * (w0[r] * bfhi(y0[r][j].x) + w1[r] * bfhi(y1[r][j].x));
                    xv[r][j][2] += gv[2] * (w0[r] * bflo(y0[r][j].y) + w1[r] * bflo(y1[r][j].y)); xv[r][j][3] += gv[3] * (w0[r] * bfhi(y0[r][j].y) + w1[r] * bfhi(y1[r][j].y));
                    if (NORM) { u32x2 w; w.x = pk2(xv[r][j][0], xv[r][j][1]); w.y = pk2(xv[r][j][2], xv[r][j][3]); *(u32x2*)((bf16*)F.outp() + (size_t)n * D + c) = w; }
                    else *(f32x4*)(F.outp() + (size_t)n * D + c) = xv[r][j];
                }
            }
            if (NORM) {
                float ss = 0.f;
#pragma unroll
                for (int j = 0; j < 4; ++j) ss += xv[r][j][0] * xv[r][j][0] + xv[r][j][1] * xv[r][j][1] + xv[r][j][2] * xv[r][j][2] + xv[r][j][3] * xv[r][j][3];
                ss = sum64(ss);
                const float inv = __builtin_amdgcn_rsqf(ss * (1.f / D) + 1e-6f);
                const float* ng = F.in(I_NORMG) + (size_t)(l * 2 + 0) * D; const float* sh = F.modp(l, b); const float* scp = sh + 1024;
#pragma unroll
                for (int j = 0; j < 4; ++j) {
                    const int c = 4 * F.lane + 256 * j;
                    const f32x4 g = *(const f32x4*)(ng + c), s1 = *(const f32x4*)(scp + c), s0 = *(const f32x4*)(sh + c);
                    float o[4];
#pragma unroll
                    for (int q = 0; q < 4; ++q) o[q] = xv[r][j][q] * inv * g[q] * (1.f + s1[q]) + s0[q];
                    u32x2 w; w.x = pk2(o[0], o[1]); w.y = pk2(o[2], o[3]);
                    *(u32x2*)(H + (size_t)n * D + c) = w;
                }
            }
        }
    }
}

__device__ __forceinline__ f32x16 mfma32(bf16x8 a, bf16x8 b, f32x16 c) { return __builtin_amdgcn_mfma_f32_32x32x16_bf16(a, b, c, 0, 0, 0); }
__device__ __forceinline__ f32x16 zero16() { f32x16 z;
#pragma unroll
    for (int q = 0; q < 16; ++q) z[q] = 0.f; return z; }

__device__ __forceinline__ void st_bf(bf16* p, float v) { *p = (bf16)f2bf(v); }
__device__ __forceinline__ float quad_sum(float v) {
    v += __builtin_bit_cast(float, __builtin_amdgcn_update_dpp(0, __builtin_bit_cast(int, v), 0xB1, 0xF, 0xF, true));
    v += __builtin_bit_cast(float, __builtin_amdgcn_update_dpp(0, __builtin_bit_cast(int, v), 0x4E, 0xF, 0xF, true));
    return v;
}
constexpr int PR_STRIDE = 3600, LA_OFF = 33 * PR_STRIDE, LA_STRIDE = 528;
__device__ __forceinline__ void phase_prep(const Frame& F, int l) {
    const int tid = F.tid, lane = F.lane, wave = F.wave, l31 = lane & 31, hi = lane >> 5;
    const bf16* p1 = (const bf16*)(F.ws + WS_P1);
    bf16* rwR = (bf16*)(F.ws + WS_RW); bf16* rwK = rwR + (size_t)NTOK * RW; bf16* rwV = rwK + (size_t)NTOK * RW; bf16* rwKK = rwV + (size_t)NTOK * RW;
    bf16* rwB = rwKK + (size_t)NTOK * RW; bf16* rwG = rwB + (size_t)NTOK * RW; _Float16* rwD = (_Float16*)(F.ws + WS_RW + 96 * MiB);
    const float* mu = F.in(I_MU) + (size_t)l * RCOLS;
    const bf16* w2t = F.lw(l, LW_L2); const bf16* a2t = F.lw(l, LW_A2); const bf16* g2t = F.lw(l, LW_G2);
    const float* rope = (const float*)(F.ws + WS_SMALL + SM_ROPE);
    const float* qkg = F.in(I_QKG) + (size_t)l * 4 * 64;
    bf16* nsQ = (bf16*)(F.ws + NS_Q); bf16* nsKS = (bf16*)(F.ws + NS_KS); bf16* nsKW = (bf16*)(F.ws + NS_KW); bf16* nsVST = (bf16*)(F.ws + NS_VST); bf16* nsVWT = (bf16*)(F.ws + NS_VWT);
    bf16* nsKC = (bf16*)(F.ws + NS_KC); bf16* nsVC = (bf16*)(F.ws + NS_VC); float* nsG = (float*)(F.ws + NS_GATE);
    LAS unsigned char* lds = F.lds;
    for (int u = F.bid; u < NTOK / 32; u += F.G) {
        const int n0 = u * 32, t0 = n0 % T, bb = n0 / T;
        u32x4 sv[15];
        {   const Frame Fs = relaunder(F); const int tid = Fs.tid; const bf16* p1 = (const bf16*)(Fs.ws + WS_P1);
#pragma unroll
            for (int it = 0; it < 15; ++it) { const int idx = tid + it * NTHR; const int row = idx / 224, ch = idx - row * 224;
                sv[it] = (u32x4){0u, 0u, 0u, 0u};
                if (idx < 33 * 224 && !(row == 0 && t0 == 0)) sv[it] = *(const u32x4*)(p1 + (size_t)(n0 - 1 + row) * N1P + ch * 8); } }
        {
            const Frame Fg = relaunder(F); const int tid = Fg.tid, lane = Fg.lane, wave = Fg.wave, l31 = lane & 31, hi = lane >> 5;
            const bf16* Hh = (const bf16*)(Fg.ws + WS_H) + (size_t)(n0 + l31) * D + 128 * wave + hi * 8; const bf16* Wg = Fg.lw(l, LW_WG) + (size_t)l31 * D + 128 * wave + hi * 8;
            float* nsG = (float*)(Fg.ws + NS_GATE);
            f32x16 d = zero16();
#pragma unroll
            for (int ks = 0; ks < 8; ++ks) d = mfma32(*(const bf16x8*)(Hh + ks * 16), *(const bf16x8*)(Wg + ks * 16), d);
            LAS float* part = (LAS float*)lds + wave * 1024;
#pragma unroll
            for (int q = 0; q < 16; ++q) part[(8 * (q >> 2) + 4 * hi + (q & 3)) * 32 + l31] = d[q];
            __syncthreads();
            for (int i = tid; i < 32 * 24; i += NTHR) { const int tl = i / 24, j = i - tl * 24; float a = F.in(I_BIN)[(size_t)l * INC + N1P + j];
#pragma unroll
                for (int w = 0; w < 8; ++w) a += ((const LAS float*)lds)[w * 1024 + tl * 32 + j];
                nsG[(size_t)(n0 + tl) * 24 + j] = sigmoidf_(a); }
            __syncthreads();
        }
        {
            const Frame Fs = relaunder(F); const int tid = Fs.tid;
#pragma unroll
            for (int it = 0; it < 15; ++it) { const int idx = tid + it * NTHR; const int row = idx / 224, ch = idx - row * 224;
                if (idx < 33 * 224) *(LAS u32x4*)(lds + row * PR_STRIDE + ch * 16) = sv[it]; }
        }
        __syncthreads();
        {
            const int i = lane >> 1, cs = 32 * wave + 16 * (lane & 1);
            const LAS u32x4* cur = (const LAS u32x4*)(lds + (i + 1) * PR_STRIDE + (1536 + cs) * 2); const LAS u32x4* prv = (const LAS u32x4*)(lds + i * PR_STRIDE + (1536 + cs) * 2);
            const u32x4 c0 = cur[0], c1 = cur[1], q0 = prv[0], q1 = prv[1];
            const unsigned cw[8] = {c0.x, c0.y, c0.z, c0.w, c1.x, c1.y, c1.z, c1.w}, pw[8] = {q0.x, q0.y, q0.z, q0.w, q1.x, q1.y, q1.z, q1.w};
            const float* mup = mu + 1536 + cs;
            unsigned ow[8];
#pragma unroll
            for (int jj = 0; jj < 8; ++jj) {
                const f32x2 m2 = *(const f32x2*)(mup + 2 * jj);
                const float ca = bflo(cw[jj]), cb = bfhi(cw[jj]), pa = bflo(pw[jj]), pb = bfhi(pw[jj]);
                const float sa = ca + (pa - ca) * m2[0], sb = cb + (pb - cb) * m2[1];
                float fa, fb;
                if (wave < 2) { fa = 1.f - 2.f * rcpf_(__expf(2.f * sa) + 1.f); fb = 1.f - 2.f * rcpf_(__expf(2.f * sb) + 1.f); }
                else if (wave < 4) { fa = sa; fb = sb; }
                else { fa = sigmoidf_(sa); fb = sigmoidf_(sb); }
                ow[jj] = pk2(fa, fb);
            }
            LAS u32x4* la = (LAS u32x4*)(lds + LA_OFF + i * LA_STRIDE + cs * 2);
            la[0] = (u32x4){ow[0], ow[1], ow[2], ow[3]}; la[1] = (u32x4){ow[4], ow[5], ow[6], ow[7]};
        }
        __syncthreads();
        {
            f32x16 accw[2], acca[2], accg[2];
            int colv = 64 * wave + l31; asm volatile("" : "+v"(colv));
#pragma unroll
            for (int ct = 0; ct < 2; ++ct) {
#pragma unroll
                for (int q = 0; q < 16; ++q) { accw[ct][q] = 0.f; acca[ct][q] = 0.f; accg[ct][q] = 0.f; }
                const int col = colv + 32 * ct;
                const LAS unsigned char* lap = lds + LA_OFF + l31 * LA_STRIDE + hi * 16;
#pragma unroll
                for (int ks = 0; ks < 4; ++ks) {
                    const bf16x8 a1 = *(const LAS bf16x8*)(lap + ks * 32), a2 = *(const LAS bf16x8*)(lap + 128 + ks * 32);
                    const bf16x8 b1 = *(const bf16x8*)(w2t + (size_t)col * 64 + ks * 16 + hi * 8), b2 = *(const bf16x8*)(a2t + (size_t)col * 64 + ks * 16 + hi * 8);
                    accw[ct] = mfma32(a1, b1, accw[ct]); acca[ct] = mfma32(a2, b2, acca[ct]);
                }
#pragma unroll
                for (int ks = 0; ks < 8; ++ks) {
                    const bf16x8 a3 = *(const LAS bf16x8*)(lap + 256 + ks * 32);
                    const bf16x8 b3 = *(const bf16x8*)(g2t + (size_t)col * 128 + ks * 16 + hi * 8);
                    accg[ct] = mfma32(a3, b3, accg[ct]);
                }
            }
            const int col0 = colv;
            float mur[2], muk[2], muv[2], w0[2], a0[2], kkc[2], kac[2];
#pragma unroll
            for (int ct = 0; ct < 2; ++ct) { const int col = col0 + 32 * ct;
                mur[ct] = mu[col]; muk[ct] = mu[512 + col]; muv[ct] = mu[1024 + col];
                w0[ct] = F.in(I_W0)[l * RW + col]; a0[ct] = F.in(I_A0)[l * RW + col]; kkc[ct] = F.in(I_KK)[l * RW + col]; kac[ct] = F.in(I_KA)[l * RW + col]; }
#pragma unroll
            for (int i = 0; i < 16; ++i) {
                const int ti = 8 * (i >> 2) + 4 * hi + (i & 3);
                const LAS bf16* cur = (const LAS bf16*)(lds + (ti + 1) * PR_STRIDE) + col0; const LAS bf16* prv = (const LAS bf16*)(lds + ti * PR_STRIDE) + col0;
                const size_t o = (size_t)(n0 + ti) * RW + col0;
                float kx[2], av[2];
#pragma unroll
                for (int ct = 0; ct < 2; ++ct) {
                    const float rc = bf2f(cur[32 * ct]), rp = bf2f(prv[32 * ct]), kc = bf2f(cur[512 + 32 * ct]), kp = bf2f(prv[512 + 32 * ct]), vc = bf2f(cur[1024 + 32 * ct]), vp = bf2f(prv[1024 + 32 * ct]);
                    const float rs = rc + (rp - rc) * mur[ct], ks_ = kc + (kp - kc) * muk[ct], vs = vc + (vp - vc) * muv[ct];
                    const float z = w0[ct] + accw[ct][i];
                    const float sp = (z < 0.f ? -z : 0.f) + 0.6931471805599453f * __builtin_amdgcn_logf(1.f + __expf(-__builtin_fabsf(z)));
                    const float wlog = -sp - 0.5f;
                    const float dec = -__expf(wlog);
                    const float a = sigmoidf_(a0[ct] + acca[ct][i]);
                    st_bf(rwR + o + 32 * ct, rs); st_bf(rwV + o + 32 * ct, vs); st_bf(rwG + o + 32 * ct, accg[ct][i]); rwD[o + 32 * ct] = (_Float16)dec; st_bf(rwK + o + 32 * ct, ks_ * (1.f + (a - 1.f) * kac[ct]));
                    kx[ct] = ks_ * kkc[ct]; av[ct] = a;
                }
                float ss = kx[0] * kx[0] + kx[1] * kx[1];
                ss = sum32(ss);
                const float inv = fminf(__builtin_amdgcn_rsqf(ss), 1e12f);
#pragma unroll
                for (int ct = 0; ct < 2; ++ct) { const float kk = kx[ct] * inv; st_bf(rwKK + o + 32 * ct, kk); st_bf(rwB + o + 32 * ct, kk * av[ct]); }
            }
        }
        __syncthreads();
        {
            const Frame Fs = relaunder(F); const int tid = Fs.tid, lane = Fs.lane, wave = Fs.wave; const bf16* p1 = (const bf16*)(Fs.ws + WS_P1);
            int u_ = u; asm volatile("" : "+s"(u_)); const int n0 = u_ * 32, t0 = n0 % T, bb = n0 / T;
            bf16* nsQ = (bf16*)(Fs.ws + NS_Q); bf16* nsKS = (bf16*)(Fs.ws + NS_KS); bf16* nsKW = (bf16*)(Fs.ws + NS_KW); bf16* nsVST = (bf16*)(Fs.ws + NS_VST); bf16* nsVWT = (bf16*)(Fs.ws + NS_VWT);
            bf16* nsKC = (bf16*)(Fs.ws + NS_KC); bf16* nsVC = (bf16*)(Fs.ws + NS_VC); const float* rope = (const float*)(Fs.ws + WS_SMALL + SM_ROPE);
            const int lq = lane & 15, sub = lane >> 4;
            LAS bf16* vts = (LAS bf16*)lds;
            const int tl = wave * 4 + sub, n = n0 + tl, t = t0 + tl;
#pragma unroll
            for (int sb = 0; sb < 20; sb += 5) {
            u32x2 raws[5];
#pragma unroll
            for (int s5 = 0; s5 < 5; ++s5) raws[s5] = *(const u32x2*)(p1 + (size_t)n * N1P + QOFF + 64 * (sb + s5) + 4 * lq);
#pragma unroll
            for (int s5 = 0; s5 < 5; ++s5) {
                const int v = sb + s5;
                const u32x2 raw = raws[s5];
                float x[4] = {bflo(raw.x), bfhi(raw.x), bflo(raw.y), bfhi(raw.y)};
                const int g = v & 1;
                const bool isq = v < 8, isks = (v == 12 || v == 13), iskw = (v == 16 || v == 17);
                if (isq || isks || iskw) {
                    float ss = x[0] * x[0] + x[1] * x[1] + x[2] * x[2] + x[3] * x[3];
                    ss = sum16(ss);
                    const float inv = __builtin_amdgcn_rsqf(ss * (1.f / 64.f) + 1e-6f);
                    const float* gw = qkg + (isq ? 0 : (isks ? 128 : 192)) + 4 * lq;
#pragma unroll
                    for (int j = 0; j < 4; ++j) x[j] = x[j] * inv * gw[j];
                    float px[4];
#pragma unroll
                    for (int j = 0; j < 4; ++j) px[j] = xor_lane<2>(x[j]);
                    if (lq < 4) {
                        const float* rp = rope + (size_t)t * 16 + 4 * (lq & 1);
#pragma unroll
                        for (int j = 0; j < 4; ++j) { const float c = rp[j], sn = rp[8 + j]; x[j] = (lq < 2) ? (x[j] * c - px[j] * sn) : (x[j] * c + px[j] * sn); }
                    }
                    if (isq) {
#pragma unroll
                        for (int j = 0; j < 4; ++j) x[j] *= 0.18033688011112042f;
                    }
                    u32x2 w; w.x = pk2(x[0], x[1]); w.y = pk2(x[2], x[3]);
                    if (isq) *(u32x2*)(nsQ + (size_t)n * 512 + 64 * v + 4 * lq) = w;
                    else if (isks) {
                        const size_t off = (size_t)(bb * 2 + g) * T * 64 + (size_t)(t >> 6) * 4096 + (size_t)(((((t >> 5) & 1) * 4 + (lq >> 2)) * 32 + (t & 31)) * 2 + ((lq >> 1) & 1)) * 8 + 4 * (lq & 1);
                        *(u32x2*)(nsKS + off) = w;
                    } else *(u32x2*)(nsKW + ((size_t)(bb * 2 + g) * T + t) * 64 + 4 * lq) = w;
                } else if (v < 12) {
                    *(u32x2*)((v < 10 ? nsKC : nsVC) + ((size_t)(bb * 2 + g) * T + t) * 64 + 4 * lq) = raw;
                } else {
                    const int slot = (v >= 18 ? 2 : 0) + g;
                    LAS bf16* dp = vts + (slot * 64 + 4 * lq) * 40 + tl;
                    dp[0] = (bf16)(raw.x & 0xffffu); dp[40] = (bf16)(raw.x >> 16); dp[80] = (bf16)(raw.y & 0xffffu); dp[120] = (bf16)(raw.y >> 16);
                }
            }
            }
            __syncthreads();
            {
                const int row = tid >> 1, hf = tid & 1, slot = row >> 6, d = row & 63, g = slot & 1;
                const LAS u32x4* sp = (const LAS u32x4*)(vts + row * 40 + hf * 16);
                const u32x4 a = sp[0], b = sp[1];
                if (slot >> 1) { bf16* dst = nsVWT + ((size_t)(bb * 2 + g) * 64 + d) * T + t0 + hf * 16; *(u32x4*)dst = a; *(u32x4*)(dst + 8) = b; }
                else {
                    const int sq = ((t0 >> 5) & 1) * 2 + hf;
                    bf16* dst = nsVST + (size_t)(bb * 2 + g) * 64 * T + (size_t)(t0 >> 6) * 4096 + (size_t)((((d >> 5) * 4 + sq) * 32 + (d & 31)) * 2) * 8;
                    *(u32x4*)dst = (u32x4){a.x, a.y, b.x, b.y}; *(u32x4*)(dst + 8) = (u32x4){a.z, a.w, b.z, b.w};
                }
            }
        }
        __syncthreads();
    }
}

__device__ __forceinline__ float gelu_tanh(float x) { const float u = 0.7978845608028654f * (x + 0.044715f * x * x * x); const float e = __expf(2.f * u); return 0.5f * x * (2.f - 2.f * __builtin_amdgcn_rcpf(e + 1.f)); }
__device__ __forceinline__ void phase_compress(const Frame& F, int l) {
    const int tid = F.tid, lane = F.lane, wave = F.wave, l31 = lane & 31, hi = lane >> 5;
    LAS unsigned char* lds = F.lds;
    LAS bf16* hid = (LAS bf16*)lds;
    LAS float* outl = (LAS float*)(lds + 32 * 528);
    const float* cbp = (const float*)(F.ws + WS_SMALL + SM_CMPB);
    const float* rope = (const float*)(F.ws + WS_SMALL + SM_ROPE);
    const float* qkg1 = F.in(I_QKG) + (size_t)l * 256 + 64;
    for (int u = F.bid; u < 128; u += F.G) {
        const int i = u >> 6, bg = (u >> 4) & 3, rt = u & 15;
        const bf16* src = (const bf16*)(F.ws + (i ? NS_VC : NS_KC)) + (size_t)bg * T * 64;
        const bf16* w1t = F.lw(l, LW_C1) + (size_t)i * 256 * 2048; const bf16* w2t = F.lw(l, LW_C2) + (size_t)i * 64 * 256;
        int nrow = rt * 32 + l31; if (nrow > NCMP - 1) nrow = NCMP - 1;
        const bf16* ap = src + (size_t)nrow * 1024 + hi * 8; const bf16* bp = w1t + (size_t)(32 * wave + l31) * 2048 + hi * 8;
        f32x16 acc;
#pragma unroll
        for (int q = 0; q < 16; ++q) acc[q] = 0.f;
#pragma unroll 8
        for (int ks = 0; ks < 128; ++ks) acc = mfma32(*(const bf16x8*)(ap + ks * 16), *(const bf16x8*)(bp + ks * 16), acc);
        {
            const int col = 32 * wave + l31; const int li = l * 2 + i;
            const float cb = cbp[(li * 4 + 0) * 256 + col] + cbp[(li * 4 + 1) * 256 + col] + cbp[(li * 4 + 2) * 256 + col] + cbp[(li * 4 + 3) * 256 + col];
#pragma unroll
            for (int q = 0; q < 16; ++q) { const int r = 8 * (q >> 2) + 4 * hi + (q & 3); hid[r * 264 + col] = (bf16)f2bf(gelu_tanh(acc[q] + cb)); }
        }
        __syncthreads();
        if (wave < 2) {
            f32x16 o;
#pragma unroll
            for (int q = 0; q < 16; ++q) o[q] = 0.f;
#pragma unroll
            for (int ks = 0; ks < 16; ++ks) o = mfma32(*(const LAS bf16x8*)(hid + l31 * 264 + ks * 16 + hi * 8), *(const bf16x8*)(w2t + (size_t)(32 * wave + l31) * 256 + ks * 16 + hi * 8), o);
#pragma unroll
            for (int q = 0; q < 16; ++q) { const int r = 8 * (q >> 2) + 4 * hi + (q & 3); outl[r * 65 + 32 * wave + l31] = o[q]; }
        }
        __syncthreads();
        if (i == 0) {
            const int r = tid >> 4, lq = tid & 15, n = rt * 32 + r;
            float x[4];
#pragma unroll
            for (int j = 0; j < 4; ++j) x[j] = outl[r * 65 + 4 * lq + j];
            float ss = x[0] * x[0] + x[1] * x[1] + x[2] * x[2] + x[3] * x[3];
            ss = sum16(ss);
            const float inv = __builtin_amdgcn_rsqf(ss * (1.f / 64.f) + 1e-6f);
#pragma unroll
            for (int j = 0; j < 4; ++j) x[j] = x[j] * inv * qkg1[4 * lq + j];
            float px[4];
#pragma unroll
            for (int j = 0; j < 4; ++j) px[j] = xor_lane<2>(x[j]);
            const int pos = (n < NCMP) ? 16 * n + 31 : 0;
            if (lq < 4) {
                const float* rp = rope + (size_t)pos * 16 + 4 * (lq & 1);
#pragma unroll
                for (int j = 0; j < 4; ++j) { const float c = rp[j], sn = rp[8 + j]; x[j] = (lq < 2) ? (x[j] * c - px[j] * sn) : (x[j] * c + px[j] * sn); }
            }
            if (n >= NCMP) { x[0] = x[1] = x[2] = x[3] = 0.f; }
            u32x2 w; w.x = pk2(x[0], x[1]); w.y = pk2(x[2], x[3]);
            *(u32x2*)((bf16*)(F.ws + NS_KCMP) + ((size_t)bg * NCMPP + n) * 64 + 4 * lq) = w;
        } else {
            const int d = tid >> 3, n4 = (tid & 7) * 4;
            float x[4];
#pragma unroll
            for (int j = 0; j < 4; ++j) { const int n = rt * 32 + n4 + j; x[j] = (n < NCMP) ? outl[(n4 + j) * 65 + d] : 0.f; }
            u32x2 w; w.x = pk2(x[0], x[1]); w.y = pk2(x[2], x[3]);
            *(u32x2*)((bf16*)(F.ws + NS_VCMPT) + ((size_t)bg * 64 + d) * NCMPP + rt * 32 + n4) = w;
        }
        __syncthreads();
    }
}

constexpr int T72 = 144;
__device__ __forceinline__ f32x16 mm64(const LAS unsigned char* A, const LAS unsigned char* Bt, int m0, int n0, int l31, int hi, f32x16 acc) {
#pragma unroll
    for (int ks = 0; ks < 4; ++ks) acc = mfma32(*(const LAS bf16x8*)(A + (m0 + l31) * T72 + ks * 32 + hi * 16), *(const LAS bf16x8*)(Bt + (n0 + l31) * T72 + ks * 32 + hi * 16), acc);
    return acc;
}
__device__ __forceinline__ void st_tile_T_bf(LAS unsigned char* dst, const f32x16& d, int m0, int n0, int l31, int hi) {
#pragma unroll
    for (int g = 0; g < 4; ++g) { u32x2 w; w.x = pk2(d[4 * g], d[4 * g + 1]); w.y = pk2(d[4 * g + 2], d[4 * g + 3]); *(LAS u32x2*)(dst + (n0 + l31) * T72 + (m0 + 8 * g + 4 * hi) * 2) = w; }
}
__device__ __forceinline__ void st_tile_T_f32(LAS unsigned char* dst, const f32x16& d, int m0, int n0, int l31, int hi) {
#pragma unroll
    for (int g = 0; g < 4; ++g) *(LAS f32x4*)(dst + (n0 + l31) * 272 + (m0 + 8 * g + 4 * hi) * 4) = (f32x4){d[4 * g], d[4 * g + 1], d[4 * g + 2], d[4 * g + 3]};
}

constexpr int R1_AN = 0, R1_BN = 9216, R1_KN = 18432, R1_BHT = 27648, R1_KHT = 36864, R1_VT = 46080, R1_ATF = 55296, R1_AAB = 72704, R1_AAK = 90112, R1_RHS2 = 99328, R1_TT = 116736, R1_AOFF = 120832;
__device__ __forceinline__ void rw1_unit(const Frame& F, int u) {
    const int tid = F.tid, lane = F.lane, wave = F.wave, l31 = lane & 31, hi = lane >> 5;
    LAS unsigned char* lds = F.lds;
    const int c = u & 127, bh = u >> 7, b = bh >> 3, h = bh & 7;
    const size_t n0 = (size_t)b * T + 64 * c; const int cb = 64 * h;
    const bf16* rwK = (const bf16*)(F.ws + WS_RW) + (size_t)NTOK * RW; const bf16* rwV = rwK + (size_t)NTOK * RW; const bf16* rwKK = rwV + (size_t)NTOK * RW; const bf16* rwB = rwKK + (size_t)NTOK * RW;
    const _Float16* rwD = (const _Float16*)(F.ws + WS_RW + 96 * MiB);
    {
        float ldv[8]; unsigned kkr[8], br[8], kr[8], vr[8];
#pragma unroll
        for (int q = 0; q < 8; ++q) { const size_t o = (n0 + 8 * wave + q) * RW + cb + lane; ldv[q] = (float)rwD[o]; kkr[q] = rwKK[o]; br[q] = rwB[o]; kr[q] = rwK[o]; vr[q] = rwV[o]; }
        float part = 0.f;
#pragma unroll
        for (int q = 0; q < 8; ++q) part += ldv[q];
        LAS float* psum = (LAS float*)(lds + R1_AAB);
        psum[wave * 64 + lane] = part;
        __syncthreads();
        float pre = 0.f, tot = 0.f;
#pragma unroll
        for (int w = 0; w < 8; ++w) { const float x = psum[w * 64 + lane]; if (w < wave) pre += x; tot += x; }
        float cwv = pre, atf[8]; unsigned bh_[8], kh_[8];
#pragma unroll
        for (int q = 0; q < 8; ++q) {
            const int t = 8 * wave + q;
            const float cwx = cwv; cwv += ldv[q];
            const float kkv = bf2f(kkr[q]), bv = bf2f(br[q]), kv = bf2f(kr[q]);
            const float ex = __expf(cwx), em = __expf(-cwv), eh = __expf(tot - cwv);
            const float an = -kkv * ex;
            *(LAS bf16*)(lds + R1_AN + t * T72 + lane * 2) = (bf16)f2bf(an);
            *(LAS bf16*)(lds + R1_BN + t * T72 + lane * 2) = (bf16)f2bf(bv * em);
            *(LAS bf16*)(lds + R1_KN + t * T72 + lane * 2) = (bf16)f2bf(kv * em);
            atf[q] = an; bh_[q] = f2bf(bv * eh); kh_[q] = f2bf(kv * eh);
        }
        *(LAS u32x4*)(lds + R1_BHT + lane * T72 + wave * 16) = (u32x4){bh_[0] | (bh_[1] << 16), bh_[2] | (bh_[3] << 16), bh_[4] | (bh_[5] << 16), bh_[6] | (bh_[7] << 16)};
        *(LAS u32x4*)(lds + R1_KHT + lane * T72 + wave * 16) = (u32x4){kh_[0] | (kh_[1] << 16), kh_[2] | (kh_[3] << 16), kh_[4] | (kh_[5] << 16), kh_[6] | (kh_[7] << 16)};
        *(LAS u32x4*)(lds + R1_VT + lane * T72 + wave * 16) = (u32x4){vr[0] | (vr[1] << 16), vr[2] | (vr[3] << 16), vr[4] | (vr[5] << 16), vr[6] | (vr[7] << 16)};
        *(LAS f32x4*)(lds + R1_ATF + lane * 272 + wave * 32) = (f32x4){atf[0], atf[1], atf[2], atf[3]};
        *(LAS f32x4*)(lds + R1_ATF + lane * 272 + wave * 32 + 16) = (f32x4){atf[4], atf[5], atf[6], atf[7]};
        if (wave == 0) ((float*)(F.ws + WS_GC))[(size_t)u * 64 + lane] = __expf(tot);
    }
    __syncthreads();
    {
        const int p = wave >> 2, mt = (wave >> 1) & 1, nt = wave & 1;
        f32x16 d = zero16();
        if (mt <= nt) d = mm64(lds + (p ? R1_KN : R1_BN), lds + R1_AN, 32 * mt, 32 * nt, l31, hi, d);
#pragma unroll
        for (int q = 0; q < 16; ++q) { const int tau = 32 * mt + 8 * (q >> 2) + 4 * hi + (q & 3), t = 32 * nt + l31; if (!(tau < t)) d[q] = 0.f; }
        if (p == 0) {
            st_tile_T_f32(lds + R1_AAB, d, 32 * mt, 32 * nt, l31, hi);
#pragma unroll
            for (int q = 0; q < 16; ++q) { const int tau = 32 * mt + 8 * (q >> 2) + 4 * hi + (q & 3), t = 32 * nt + l31; if ((tau >> 4) == (t >> 4)) d[q] = 0.f; }
            st_tile_T_bf(lds + R1_AOFF, d, 32 * mt, 32 * nt, l31, hi);
        } else st_tile_T_bf(lds + R1_AAK, d, 32 * mt, 32 * nt, l31, hi);
    }
    __syncthreads();
    if (wave < 4) { const int mt = wave >> 1, nt = wave & 1; f32x16 d = zero16(); d = mm64(lds + R1_AAK, lds + R1_VT, 32 * mt, 32 * nt, l31, hi, d); st_tile_T_f32(lds + R1_RHS2, d, 32 * mt, 32 * nt, l31, hi); }
    else if (wave == 4) {
        const int blk = lane >> 4, c = lane & 15;
#pragma unroll
        for (int q = 0; q < 4; ++q) *(LAS u32x4*)(lds + R1_TT + lane * 64 + q * 16) = (u32x4){0u, 0u, 0u, 0u};
        float x[16];
#pragma unroll
        for (int r = 0; r < 16; ++r) x[r] = (r == c) ? 1.f : 0.f;
        unsigned ab_ = (unsigned)(size_t)(lds + R1_AAB) + (unsigned)(blk * 16 * 272 + blk * 64); asm volatile("" : "+v"(ab_));
#pragma unroll
        for (int r = 1; r < 16; ++r) {
            float s0 = 0.f;
#pragma unroll
            for (int q = 0; q < (r + 3) / 4; ++q) { const f32x4 a = *(const LAS f32x4*)((const LAS unsigned char*)(size_t)ab_ + r * 272 + q * 16);
                s0 += a[0] * x[4 * q]; if (4 * q + 1 < r) s0 += a[1] * x[4 * q + 1]; if (4 * q + 2 < r) s0 += a[2] * x[4 * q + 2]; if (4 * q + 3 < r) s0 += a[3] * x[4 * q + 3]; }
            x[r] += s0;
            asm volatile("" : "+v"(x[r]));
        }
#pragma unroll
        for (int r = 0; r < 16; ++r) *(LAS bf16*)(lds + R1_TT + ((blk * 16 + r) * 32 + 8 * (c >> 2) + (c & 3)) * 2) = (bf16)f2bf(x[r]);
    } else {
        const int t3 = F.tid - 320;
#pragma unroll
        for (int q = 0; q < 6; ++q) *(LAS u32x4*)(lds + R1_AN + (t3 + 192 * q) * 16) = (u32x4){0u, 0u, 0u, 0u};
    }
    __syncthreads();
    {
        const int cl = lane & 15, qd = lane >> 4, col = 16 * (wave & 3) + cl, isu = wave >> 2;
        const LAS unsigned char* rhs = lds + (isu ? R1_RHS2 : R1_ATF) + col * 272;
        LAS unsigned char* xt = lds + (isu ? R1_BN : R1_AN) + col * T72;
        bf16* gp = (bf16*)(F.ws + (isu ? WS_UPN : WS_WN)) + (size_t)u * 4096 + col;
#pragma unroll
        for (int d = 0; d < 4; ++d) {
            f32x4 acc = *(const LAS f32x4*)(rhs + (16 * d + 4 * qd) * 4);
            if (d > 0) {
#pragma unroll
                for (int ks = 0; ks < (d == 3 ? 2 : 1); ++ks) {
                    const bf16x8 a = *(const LAS bf16x8*)(lds + R1_AOFF + (16 * d + cl) * T72 + (32 * ks + 8 * qd) * 2), bx = *(const LAS bf16x8*)(xt + (32 * ks + 8 * qd) * 2);
                    acc = __builtin_amdgcn_mfma_f32_16x16x32_bf16(a, bx, acc, 0, 0, 0);
                }
            }
            u32x4 bw; bw.x = pk2(acc[0], acc[1]); bw.y = pk2(acc[2], acc[3]); bw.z = 0u; bw.w = 0u;
            const bf16x8 ta = *(const LAS bf16x8*)(lds + R1_TT + ((d * 16 + cl) * 32 + 8 * qd) * 2);
            f32x4 xo = (f32x4){0.f, 0.f, 0.f, 0.f};
            xo = __builtin_amdgcn_mfma_f32_16x16x32_bf16(ta, __builtin_bit_cast(bf16x8, bw), xo, 0, 0, 0);
            u32x2 w; w.x = pk2(xo[0], xo[1]); w.y = pk2(xo[2], xo[3]);
            *(LAS u32x2*)(xt + (16 * d + 4 * qd) * 2) = w;
#pragma unroll
            for (int r = 0; r < 4; ++r) gp[(16 * d + 4 * qd + r) * 64] = (bf16)f2bf(xo[r]);
        }
    }
    __syncthreads();
    {
        const int mt = (wave >> 1) & 1, nt = wave & 1;
        f32x16 d = zero16();
        if (wave < 4) {
            d = mm64(lds + R1_BHT, lds + R1_AN  , 32 * mt, 32 * nt, l31, hi, d);
            unsigned char* img = F.ws + WS_PT + (size_t)u * 16384;
            const int j = 32 * nt + l31, s_ = j >> 4, r_ = j & 15, half = r_ >> 3, hj = (r_ >> 2) & 1, e_ = r_ & 3;
#pragma unroll
            for (int q = 0; q < 16; ++q) { const int jp = 32 * mt + 8 * (q >> 2) + 4 * hi + (q & 3);
                *(bf16*)(img + (((((jp >> 5) * 4 + s_) * 2 + hj) * 32 + (jp & 31)) * 16 + half * 8 + e_ * 2)) = (bf16)f2bf(d[q]); }
        } else {
            d = mm64(lds + R1_BHT, lds + R1_BN  , 32 * mt, 32 * nt, l31, hi, d);
            d = mm64(lds + R1_KHT, lds + R1_VT, 32 * mt, 32 * nt, l31, hi, d);
            unsigned char* img = F.ws + WS_PT + (size_t)u * 16384 + 8192;
#pragma unroll
            for (int g = 0; g < 4; ++g) { u32x2 w; w.x = pk2(d[4 * g], d[4 * g + 1]); w.y = pk2(d[4 * g + 2], d[4 * g + 3]); *(u32x2*)(img + (((((nt * 2 + mt) * 4 + g) * 2 + hi) * 32 + l31) * 8)) = w; }
        }
    }
    __syncthreads();
}

constexpr int R2_SLOT = 16640, R2_NST = 8, R2_QI = 8192, R2_G = 16384;
__device__ __forceinline__ void rw2_issue(LAS unsigned char* slot, const unsigned char* img, const float* gsrc, int lane) {
#pragma unroll
    for (int i = 0; i < 16; ++i) __builtin_amdgcn_global_load_lds((const unsigned*)(img + i * 1024 + lane * 16), (LAS unsigned*)(slot + i * 1024), 16, 0, 0);
    if (lane < 16) __builtin_amdgcn_global_load_lds((const unsigned*)((const unsigned char*)gsrc + lane * 16), (LAS unsigned*)(slot + R2_G), 16, 0, 0);
}
__device__ __forceinline__ void rw2_wg(const Frame& F, int bh) {
    const int lane = F.lane, wave = F.wave, l31 = lane & 31, hi = lane >> 5;
    LAS unsigned char* lds = F.lds;
    LAS unsigned* ctr = (LAS unsigned*)(lds + LDS_MISC + 128);
    if (F.tid < 8) ctr[F.tid] = 0u;
    __syncthreads();
    const unsigned char* IMG = F.ws + WS_PT + (size_t)bh * 128 * 16384; const float* GC = (const float*)(F.ws + WS_GC) + (size_t)bh * 128 * 64;
    if (wave >= 4) {
        const int k = wave - 4;
        rw2_issue(lds + k * R2_SLOT, IMG + (size_t)k * 16384, GC + k * 64, lane);
        rw2_issue(lds + (k + 4) * R2_SLOT, IMG + (size_t)(k + 4) * 16384, GC + (k + 4) * 64, lane);
#pragma unroll 1
        for (int m = 0; m < 32; ++m) {
            const int c = k + 4 * m;
            if (m < 31) asm volatile("s_waitcnt vmcnt(17)" ::: "memory"); else asm volatile("s_waitcnt vmcnt(0)" ::: "memory");
            if (lane == 0) __hip_atomic_store(ctr + k, (unsigned)(m + 1), __ATOMIC_RELEASE, __HIP_MEMORY_SCOPE_WORKGROUP);
            const int cn = c + 8;
            if (cn < 128) {
                for (;;) { const unsigned a = __hip_atomic_load(ctr + 4, __ATOMIC_ACQUIRE, __HIP_MEMORY_SCOPE_WORKGROUP), b2 = __hip_atomic_load(ctr + 5, __ATOMIC_ACQUIRE, __HIP_MEMORY_SCOPE_WORKGROUP);
                    if ((a < b2 ? a : b2) >= (unsigned)(c + 1)) break; __builtin_amdgcn_s_sleep(1); }
                rw2_issue(lds + (cn & 7) * R2_SLOT, IMG + (size_t)cn * 16384, GC + cn * 64, lane);
            } else if (m < 31) {   asm volatile("s_waitcnt vmcnt(0)" ::: "memory"); }
        }
    } else if (wave < 2) {
        const int ih = wave, irow = 32 * ih + l31;
        bf16* S0 = (bf16*)(F.ws + WS_S0);
        f32x16 acc[2]; acc[0] = zero16(); acc[1] = zero16();
#pragma unroll 1
        for (int c = 0; c < 128; ++c) {
            const size_t ub = ((size_t)bh * 128 + c) * 4096;
            const LAS unsigned char* slot = lds + (c & 7) * R2_SLOT;
            bf16x8 xb[4];
#pragma unroll
            for (int jt = 0; jt < 2; ++jt) {
                u32x4 lo, hi4;
                lo.x = pg8::cvt_pk_bf16(acc[jt][0], acc[jt][1]); lo.y = pg8::cvt_pk_bf16(acc[jt][2], acc[jt][3]); lo.z = pg8::cvt_pk_bf16(acc[jt][4], acc[jt][5]); lo.w = pg8::cvt_pk_bf16(acc[jt][6], acc[jt][7]);
                hi4.x = pg8::cvt_pk_bf16(acc[jt][8], acc[jt][9]); hi4.y = pg8::cvt_pk_bf16(acc[jt][10], acc[jt][11]); hi4.z = pg8::cvt_pk_bf16(acc[jt][12], acc[jt][13]); hi4.w = pg8::cvt_pk_bf16(acc[jt][14], acc[jt][15]);
                xb[2 * jt] = __builtin_bit_cast(bf16x8, lo); xb[2 * jt + 1] = __builtin_bit_cast(bf16x8, hi4);
                bf16* sp = S0 + ub + (size_t)irow * 64 + 32 * jt + 4 * hi;
                *(u32x2*)(sp) = (u32x2){lo.x, lo.y}; *(u32x2*)(sp + 8) = (u32x2){lo.z, lo.w}; *(u32x2*)(sp + 16) = (u32x2){hi4.x, hi4.y}; *(u32x2*)(sp + 24) = (u32x2){hi4.z, hi4.w};
            }
            while (__hip_atomic_load(ctr + (c & 3), __ATOMIC_ACQUIRE, __HIP_MEMORY_SCOPE_WORKGROUP) < (unsigned)((c >> 2) + 1)) __builtin_amdgcn_s_sleep(1);
            f32x16 nw[2];
#pragma unroll
            for (int jt = 0; jt < 2; ++jt)
#pragma unroll
                for (int g = 0; g < 4; ++g) {
                    const u32x2 qv = *(const LAS u32x2*)(slot + R2_QI + (((((ih * 2 + jt) * 4 + g) * 2 + hi) * 32 + l31) * 8));
                    const f32x4 gv = *(const LAS f32x4*)(slot + R2_G + (32 * jt + 8 * g + 4 * hi) * 4);
                    nw[jt][4 * g + 0] = bflo(qv.x) + gv[0] * acc[jt][4 * g + 0]; nw[jt][4 * g + 1] = bfhi(qv.x) + gv[1] * acc[jt][4 * g + 1];
                    nw[jt][4 * g + 2] = bflo(qv.y) + gv[2] * acc[jt][4 * g + 2]; nw[jt][4 * g + 3] = bfhi(qv.y) + gv[3] * acc[jt][4 * g + 3];
                }
#pragma unroll
            for (int jt = 0; jt < 2; ++jt)
#pragma unroll
                for (int s_ = 0; s_ < 4; ++s_) {
                    const bf16x8 af = *(const LAS bf16x8*)(slot + ((((jt * 4 + s_) * 2 + hi) * 32 + l31) * 16));
                    nw[jt] = mfma32(af, xb[s_], nw[jt]);
                }
            asm volatile("s_waitcnt lgkmcnt(0)" ::: "memory");
            if (lane == 0) __hip_atomic_store(ctr + 4 + wave, (unsigned)(c + 1), __ATOMIC_RELEASE, __HIP_MEMORY_SCOPE_WORKGROUP);
            acc[0] = nw[0]; acc[1] = nw[1];
        }
    }
}

constexpr int R3_RN = 0, R3_BN = 9216, R3_KN = 18432, R3_WN = 27648, R3_S0 = 36864, R3_VT = 46080, R3_UT = 55296, R3_ARB = 64512, R3_ARK = 73728, R3_YL = 82944;
__device__ __forceinline__ void rw3_unit(const Frame& F, int u, int l) {
    const int tid = F.tid, lane = F.lane, wave = F.wave, l31 = lane & 31, hi = lane >> 5;
    LAS unsigned char* lds = F.lds;
    const int c = u & 127, bh = u >> 7, b = bh >> 3, h = bh & 7;
    const size_t n0 = (size_t)b * T + 64 * c; const int cb = 64 * h;
    const bf16* rwR = (const bf16*)(F.ws + WS_RW); const bf16* rwK = rwR + (size_t)NTOK * RW; const bf16* rwV = rwK + (size_t)NTOK * RW; const bf16* rwB = rwR + (size_t)4 * NTOK * RW;
    const _Float16* rwD = (const _Float16*)(F.ws + WS_RW + 96 * MiB);
    unsigned short upr[16];
    {   const int mt = (wave >> 1) & 1, nt = wave & 1;
        const bf16* up = (const bf16*)(F.ws + WS_UPN) + (size_t)u * 4096 + 32 * nt + l31;
        if (wave < 4) {
#pragma unroll
            for (int q = 0; q < 16; ++q) upr[q] = up[(32 * mt + 8 * (q >> 2) + 4 * hi + (q & 3)) * 64]; } }
    const size_t od = (n0 + (tid >> 3)) * RW + cb + (tid & 7) * 8;
    const u32x4 rw_d = *(const u32x4*)(rwR + od), kw_d = *(const u32x4*)(rwK + od), vw_d = *(const u32x4*)(rwV + od), gw_d = *(const u32x4*)(rwR + (size_t)5 * NTOK * RW + od);
    {
        float ldv[8]; unsigned rr[8], br[8], kr[8], vr[8];
#pragma unroll
        for (int q = 0; q < 8; ++q) { const size_t o = (n0 + 8 * wave + q) * RW + cb + lane; ldv[q] = (float)rwD[o]; rr[q] = rwR[o]; br[q] = rwB[o]; kr[q] = rwK[o]; vr[q] = rwV[o]; }
        const int row = tid >> 3, ch = (tid & 7) * 8;
        const u32x4 wcp = *(const u32x4*)((const bf16*)(F.ws + WS_WN) + (size_t)u * 4096 + row * 64 + ch), scp = *(const u32x4*)((const bf16*)(F.ws + WS_S0) + (size_t)u * 4096 + row * 64 + ch);
        float part = 0.f;
#pragma unroll
        for (int q = 0; q < 8; ++q) part += ldv[q];
        LAS float* psum = (LAS float*)(lds + R3_YL);
        psum[wave * 64 + lane] = part;
        __syncthreads();
        float cwv = 0.f;
#pragma unroll
        for (int w = 0; w < 8; ++w) { const float x = psum[w * 64 + lane]; if (w < wave) cwv += x; }
#pragma unroll
        for (int q = 0; q < 8; ++q) {
            const int t = 8 * wave + q;
            cwv += ldv[q];
            const float ep = __expf(cwv), em = __expf(-cwv);
            *(LAS bf16*)(lds + R3_RN + t * T72 + lane * 2) = (bf16)f2bf(bf2f(rr[q]) * ep);
            *(LAS bf16*)(lds + R3_BN + t * T72 + lane * 2) = (bf16)f2bf(bf2f(br[q]) * em);
            *(LAS bf16*)(lds + R3_KN + t * T72 + lane * 2) = (bf16)f2bf(bf2f(kr[q]) * em);
        }
        *(LAS u32x4*)(lds + R3_VT + lane * T72 + wave * 16) = (u32x4){vr[0] | (vr[1] << 16), vr[2] | (vr[3] << 16), vr[4] | (vr[5] << 16), vr[6] | (vr[7] << 16)};
        *(LAS u32x4*)(lds + R3_WN + row * T72 + ch * 2) = wcp;
        *(LAS u32x4*)(lds + R3_S0 + row * T72 + ch * 2) = scp;
    }
    __syncthreads();
    f32x16 y = zero16();
    {
        const int p = wave >> 2, mt = (wave >> 1) & 1, nt = wave & 1;
        f32x16 d = zero16();
        if (mt <= nt) d = mm64(lds + (p ? R3_KN : R3_BN), lds + R3_RN, 32 * mt, 32 * nt, l31, hi, d);
#pragma unroll
        for (int q = 0; q < 16; ++q) { const int tau = 32 * mt + 8 * (q >> 2) + 4 * hi + (q & 3), t = 32 * nt + l31; if (!(tau <= t)) d[q] = 0.f; }
        st_tile_T_bf(lds + (p ? R3_ARK : R3_ARB), d, 32 * mt, 32 * nt, l31, hi);
        if (wave < 4) {
            f32x16 uu;
#pragma unroll
            for (int q = 0; q < 16; ++q) uu[q] = bf2f(upr[q]);
            uu = mm64(lds + R3_WN, lds + R3_S0, 32 * mt, 32 * nt, l31, hi, uu);
            st_tile_T_bf(lds + R3_UT, uu, 32 * mt, 32 * nt, l31, hi);
        } else y = mm64(lds + R3_RN, lds + R3_S0, 32 * mt, 32 * nt, l31, hi, y);
    }
    __syncthreads();
    if (wave >= 4) {
        const int mt = (wave >> 1) & 1, nt = wave & 1;
        y = mm64(lds + R3_ARB, lds + R3_UT, 32 * mt, 32 * nt, l31, hi, y);
        y = mm64(lds + R3_ARK, lds + R3_VT, 32 * mt, 32 * nt, l31, hi, y);
#pragma unroll
        for (int q = 0; q < 16; ++q) *(LAS float*)(lds + R3_YL + (32 * mt + 8 * (q >> 2) + 4 * hi + (q & 3)) * 272 + (32 * nt + l31) * 4) = y[q];
    }
    __syncthreads();
    {
        const int t = tid >> 3, i8 = (tid & 7) * 8; const size_t o = (n0 + t) * RW + cb + i8;
        const f32x4 y0 = *(const LAS f32x4*)(lds + R3_YL + t * 272 + i8 * 4), y1 = *(const LAS f32x4*)(lds + R3_YL + t * 272 + i8 * 4 + 16);
        const u32x4 rw = rw_d, kw = kw_d, vw = vw_d, gw = gw_d;
        float yy[8] = {y0[0], y0[1], y0[2], y0[3], y1[0], y1[1], y1[2], y1[3]};
        const float r[8] = {bflo(rw.x), bfhi(rw.x), bflo(rw.y), bfhi(rw.y), bflo(rw.z), bfhi(rw.z), bflo(rw.w), bfhi(rw.w)};
        const float k[8] = {bflo(kw.x), bfhi(kw.x), bflo(kw.y), bfhi(kw.y), bflo(kw.z), bfhi(kw.z), bflo(kw.w), bfhi(kw.w)};
        const float v[8] = {bflo(vw.x), bfhi(vw.x), bflo(vw.y), bfhi(vw.y), bflo(vw.z), bfhi(vw.z), bflo(vw.w), bfhi(vw.w)};
        const float g[8] = {bflo(gw.x), bfhi(gw.x), bflo(gw.y), bfhi(gw.y), bflo(gw.z), bfhi(gw.z), bflo(gw.w), bfhi(gw.w)};
        const float* gng = F.in(I_GNG) + l * RW + cb + i8; const float* gnb = F.in(I_GNB) + l * RW + cb + i8; const float* rk = F.in(I_RK) + l * RW + cb + i8;
        float sm = 0.f, bon = 0.f;
#pragma unroll
        for (int j = 0; j < 8; ++j) { sm += yy[j]; bon += r[j] * k[j] * rk[j]; }
        sm = sum8(sm); bon = sum8(bon);
        const float mean = sm * (1.f / 64.f);
        float var = 0.f;
#pragma unroll
        for (int j = 0; j < 8; ++j) { yy[j] -= mean; var += yy[j] * yy[j]; }
        var = sum8(var);
        const float inv = __builtin_amdgcn_rsqf(var * (1.f / 64.f) + 64e-5f);
        float ov[8];
#pragma unroll
        for (int j = 0; j < 8; ++j) ov[j] = (yy[j] * inv * gng[j] + gnb[j] + bon * v[j]) * g[j];
        u32x4 w; w.x = pk2(ov[0], ov[1]); w.y = pk2(ov[2], ov[3]); w.z = pk2(ov[4], ov[5]); w.w = pk2(ov[6], ov[7]);
        *(u32x4*)((bf16*)(F.ws + WS_YA) + o) = w;
    }
    __syncthreads();
}

constexpr int AT_KT = 0, AT_VT = 18432, AT_IMP = 36864, AT_MASK = 69632, AT_OUT = 70656;
struct KvRegs { u32x4 k, v; };
__device__ __forceinline__ KvRegs kv_load(const bf16* kbase, const bf16* vtbase, int vstride, int key0, int tid) {
    KvRegs r; const int row = tid >> 3, ch = (tid & 7) * 8;
    r.k = *(const u32x4*)(kbase + (size_t)(key0 + row) * 64 + ch);
    r.v = *(const u32x4*)(vtbase + (size_t)row * vstride + key0 + ch);
    return r;
}
__device__ __forceinline__ void kv_store(LAS unsigned char* lds, int buf, const KvRegs& r, int tid) {
    const int row = tid >> 3, ch = (tid & 7) * 16;
    *(LAS u32x4*)(lds + AT_KT + buf * 9216 + row * 144 + ch) = r.k;
    {   const int c = tid & 7, s_ = c >> 1, half = c & 1, dt = row >> 5, r31 = row & 31;
        LAS unsigned char* vb = lds + AT_VT + buf * 9216 + ((((dt * 4 + s_) * 2) * 32 + r31) * 16) + half * 8;
        *(LAS u32x2*)vb = (u32x2){r.v.x, r.v.y}; *(LAS u32x2*)(vb + 512) = (u32x2){r.v.z, r.v.w}; }
}
__device__ __forceinline__ void qk_tile(const LAS unsigned char* kt, const bf16x8 (&qf)[4], int l31, int hi, f32x16& s0, f32x16& s1, float init) {
#pragma unroll
    for (int q = 0; q < 16; ++q) { s0[q] = init; s1[q] = init; }
#pragma unroll
    for (int sl = 0; sl < 4; ++sl) {
        const bf16x8 a0 = *(const LAS bf16x8*)(kt + l31 * 144 + sl * 32 + hi * 16), a1 = *(const LAS bf16x8*)(kt + (32 + l31) * 144 + sl * 32 + hi * 16);
        s0 = mfma32(a0, qf[sl], s0); s1 = mfma32(a1, qf[sl], s1);
    }
}
__device__ __forceinline__ void pv_tile(const LAS unsigned char* vt, const f32x16& p0, const f32x16& p1, int l31, int hi, f32x16 (&o)[2]) {
#pragma unroll
    for (int s = 0; s < 4; ++s) {
        const f32x16& pp = (s < 2) ? p0 : p1; const int rb = (s & 1) * 8;
        bf16x8 pb; u32x4 pw;
        pw.x = pg8::cvt_pk_bf16(pp[rb + 0], pp[rb + 1]); pw.y = pg8::cvt_pk_bf16(pp[rb + 2], pp[rb + 3]); pw.z = pg8::cvt_pk_bf16(pp[rb + 4], pp[rb + 5]); pw.w = pg8::cvt_pk_bf16(pp[rb + 6], pp[rb + 7]);
        pb = __builtin_bit_cast(bf16x8, pw);
#pragma unroll
        for (int dt = 0; dt < 2; ++dt) {
            const bf16x8 vf = *(const LAS bf16x8*)(vt + ((((dt * 4 + s) * 2 + hi) * 32 + l31) * 16));
            o[dt] = mfma32(vf, pb, o[dt]);
        }
    }
}
constexpr float NEG_BIG = -1e30f;
__device__ __forceinline__ void mask_lt(f32x16& s0, f32x16& s1, int lim, int hi) {
    const int l2 = lim - 4 * hi;
#pragma unroll
    for (int q = 0; q < 16; ++q) { const int kq = 8 * (q >> 2) + (q & 3); s0[q] = (kq < l2) ? s0[q] : NEG_BIG; s1[q] = (kq + 32 < l2) ? s1[q] : NEG_BIG; }
}
__device__ __forceinline__ void mask_ge(f32x16& s0, f32x16& s1, int lim, int hi) {
    const int l2 = lim - 4 * hi;
#pragma unroll
    for (int q = 0; q < 16; ++q) { const int kq = 8 * (q >> 2) + (q & 3); s0[q] = (kq >= l2) ? s0[q] : NEG_BIG; s1[q] = (kq + 32 >= l2) ? s1[q] : NEG_BIG; }
}
constexpr float SM_OFF = -16.f;
__device__ __forceinline__ void exp_tile(f32x16& s0, f32x16& s1, float& lsum) {
    float ps = 0.f;
#pragma unroll
    for (int q = 0; q < 16; ++q) { s0[q] = __builtin_amdgcn_exp2f(s0[q]); s1[q] = __builtin_amdgcn_exp2f(s1[q]); ps += s0[q] + s1[q]; }
    lsum += ps;
}
__device__ __forceinline__ void attn_unit(const Frame& F_, int unit) {
    const Frame& F = F_;
    const int tid = F.tid, lane = F.lane, wave = F.wave, l31 = lane & 31, hi = lane >> 5;
    const int bg = unit >> 7, qb = unit & 127, b = bg >> 1, g = bg & 1;
    LAS unsigned char* lds = F.lds;
    LAS float* IMP = (LAS float*)(lds + AT_IMP); LAS unsigned* MASK = (LAS unsigned*)(lds + AT_MASK);
    const int ql = 8 * wave + (l31 >> 2), hd = l31 & 3;
    const int tq = ql;
    const size_t nq = (size_t)b * T + 64 * qb + ql;
    bf16x8 qf[4];
    {
        const bf16* qp = (const bf16*)(F.ws + NS_Q) + nq * 512 + g * 256 + hd * 64 + hi * 8;
#pragma unroll
        for (int sl = 0; sl < 4; ++sl) qf[sl] = *(const bf16x8*)(qp + sl * 16);
    }
    const float* gt = (const float*)(F.ws + NS_GATE) + nq * 24 + (g * 4 + hd) * 3;
    LAS float* outl = (LAS float*)(lds + AT_OUT) + wave * 2048 + lane;
    const bf16* kcmp = (const bf16*)(F.ws + NS_KCMP) + (size_t)bg * NCMPP * 64; const bf16* vcmpT = (const bf16*)(F.ws + NS_VCMPT) + (size_t)bg * 64 * NCMPP;
    const int ntc = (4 * qb + 3 + 63) >> 6;
    const int tabs = 64 * qb + tq;
    const int nvis = (tabs >= 31) ? ((tabs - 31) >> 4) + 1 : 0;
    const int tmin_w = 64 * qb + 8 * wave; const int nvis_min = (tmin_w >= 31) ? ((tmin_w - 31) >> 4) + 1 : 0;
    float lc = 0.f;
    f32x16 o[2];
    const bf16* ks_e = (const bf16*)(F.ws + NS_KS) + (size_t)bg * T * 64; const bf16* vsT_e = (const bf16*)(F.ws + NS_VST) + (size_t)bg * 64 * T;
    const bf16* kw_e = (const bf16*)(F.ws + NS_KW) + (size_t)bg * T * 64; const bf16* vwT_e = (const bf16*)(F.ws + NS_VWT) + (size_t)bg * 64 * T;
    const KvRegs pre_c0 = kv_load(kcmp, vcmpT, NCMPP, 0, tid);
    {
        KvRegs pre = pre_c0;
        for (int jt = 0; jt < ntc; ++jt) {
            kv_store(lds, jt & 1, pre, tid);
            if (jt + 1 < ntc) pre = kv_load(kcmp, vcmpT, NCMPP, 64 * (jt + 1), tid);
            __syncthreads();
            f32x16 s0, s1; qk_tile(lds + AT_KT + (jt & 1) * 9216, qf, l31, hi, s0, s1, SM_OFF);
            if (64 * (jt + 1) > nvis_min) { int nv = nvis - 64 * jt; asm volatile("" : "+v"(nv)); mask_lt(s0, s1, nv, hi); }
            exp_tile(s0, s1, lc);
        }
    }
    __syncthreads();
    {
        lc = sum_halves(lc);
        const float invl = (lc > 0.f) ? 1.f / lc : 0.f;
#pragma unroll
        for (int q = 0; q < 16; ++q) { o[0][q] = 0.f; o[1][q] = 0.f; }
        float carry = 0.f;
        KvRegs pre = pre_c0;
        for (int jt = 0; jt < ntc; ++jt) {
            kv_store(lds, jt & 1, pre, tid);
            if (jt + 1 < ntc) pre = kv_load(kcmp, vcmpT, NCMPP, 64 * (jt + 1), tid);
            __syncthreads();
            f32x16 s0, s1; qk_tile(lds + AT_KT + (jt & 1) * 9216, qf, l31, hi, s0, s1, SM_OFF);
            if (64 * (jt + 1) > nvis_min) { int nv = nvis - 64 * jt; asm volatile("" : "+v"(nv)); mask_lt(s0, s1, nv, hi); }
#pragma unroll
            for (int q = 0; q < 16; ++q) { s0[q] = __builtin_amdgcn_exp2f(s0[q]) * invl; s1[q] = __builtin_amdgcn_exp2f(s1[q]) * invl; }
            pv_tile(lds + AT_VT + (jt & 1) * 9216, s0, s1, l31, hi, o);
            float gs[8], ls[8];
#pragma unroll
            for (int kt = 0; kt < 2; ++kt)
#pragma unroll
                for (int j = 0; j < 4; ++j) { const f32x16& pp = kt ? s1 : s0; gs[kt * 4 + j] = quad_sum(pp[4 * j] + pp[4 * j + 1] + pp[4 * j + 2] + pp[4 * j + 3]); ls[kt * 4 + j] = quad_sum(pp[4 * j + 3]); }
            float lx[8];
#pragma unroll
            for (int i = 0; i < 8; ++i) lx[i] = other_half(ls[i], hi);
#pragma unroll
            for (int i = 0; i < 8; ++i) {
                const float add = hi ? lx[i] : (i == 0 ? carry : lx[i - 1]);
                if (hd == 0) IMP[ql * 128 + 16 * jt + 2 * i + hi] = gs[i] + add;
            }
            carry = lx[7];
        }
        const float g0 = gt[0];
#pragma unroll
        for (int q = 0; q < 16; ++q) { outl[q * 64] = g0 * o[0][q]; outl[(16 + q) * 64] = g0 * o[1][q]; }
    }
    __syncthreads();
    {
        const unsigned long long lt_mask = (1ull << lane) - 1ull;
#pragma unroll 1
        for (int qi = 0; qi < 8; ++qi) {
            const int qq = 8 * wave + qi;
            unsigned long long m0, m1;
            if (qb < 16) { m0 = __ballot(lane <= qb); m1 = 0ull; }
            else {
                const int sA = lane, sB = lane + 64;
                const unsigned kA = (sA > qb) ? 0u : ((sA == 0 || sA == qb || sA == qb - 1) ? 0x461c4000u : __builtin_bit_cast(unsigned, IMP[qq * 128 + sA]));
                const unsigned kB = (sB > qb) ? 0u : ((sB == qb || sB == qb - 1) ? 0x461c4000u : __builtin_bit_cast(unsigned, IMP[qq * 128 + sB]));
                unsigned thr = 0u;
#pragma unroll 1
                for (int bitp = 30; bitp >= 0; --bitp) { const unsigned cand = thr | (1u << bitp);
                    const int cnt = __popcll(__ballot(kA >= cand)) + __popcll(__ballot(kB >= cand)); if (cnt >= 16) { thr = cand; if (cnt == 16) break; } }
                const unsigned long long gA = __ballot(kA > thr), gB = __ballot(kB > thr), eA = __ballot(kA == thr), eB = __ballot(kB == thr);
                const int need = 16 - (__popcll(gA) + __popcll(gB));
                const bool selA = (kA > thr) || (kA == thr && __popcll(eA & lt_mask) < need);
                const bool selB = (kB > thr) || (kB == thr && __popcll(eA) + __popcll(eB & lt_mask) < need);
                m0 = __ballot(selA && sA <= qb); m1 = __ballot(selB && sB <= qb);
            }
            if (lane == 0) { MASK[qq * 4 + 0] = (unsigned)m0; MASK[qq * 4 + 1] = (unsigned)(m0 >> 32); MASK[qq * 4 + 2] = (unsigned)m1; MASK[qq * 4 + 3] = (unsigned)(m1 >> 32); }
        }
    }
    __syncthreads();
    unsigned selm[4];
#pragma unroll
    for (int i = 0; i < 4; ++i) selm[i] = MASK[ql * 4 + i];
    {
        const Frame F = relaunder(F_);
        const bf16* ks = (const bf16*)(F.ws + NS_KS) + (size_t)bg * T * 64; const bf16* vsT = (const bf16*)(F.ws + NS_VST) + (size_t)bg * 64 * T;
        float lsum = 0.f;
#pragma unroll
        for (int q = 0; q < 16; ++q) { o[0][q] = 0.f; o[1][q] = 0.f; }
        unsigned wm[4];
#pragma unroll
        for (int i = 0; i < 4; ++i) { unsigned w = 0u;
#pragma unroll
            for (int q = 0; q < 8; ++q) w |= (unsigned)__builtin_amdgcn_readlane((int)selm[i], 4 * q);
            wm[i] = w; }
        unsigned long long wlo = ((unsigned long long)wm[1] << 32) | wm[0], whi = ((unsigned long long)wm[3] << 32) | wm[2];
#define SEL_NEXT(dst) do { if (wlo) { dst = __builtin_ctzll(wlo); wlo &= wlo - 1ull; } else if (whi) { dst = 64 + __builtin_ctzll(whi); whi &= whi - 1ull; } else dst = -1; } while (0)
#define SEL_LOAD(kX, vX, jj) do { const bf16* kp_ = ks + (size_t)(jj) * 4096 + (l31 * 2 + hi) * 8; const bf16* vp_ = vsT + (size_t)(jj) * 4096 + (l31 * 2 + hi) * 8; \
            _Pragma("unroll") for (int sl = 0; sl < 4; ++sl) { kX[2 * sl] = *(const bf16x8*)(kp_ + sl * 512); kX[2 * sl + 1] = *(const bf16x8*)(kp_ + 2048 + sl * 512); } \
            _Pragma("unroll") for (int i = 0; i < 8; ++i) vX[i] = *(const bf16x8*)(vp_ + i * 512); } while (0)
#define SEL_COMPUTE(kX, vX, jj) do { \
            const unsigned bit = (((jj) & 32) ? (((jj) & 64) ? selm[3] : selm[1]) : (((jj) & 64) ? selm[2] : selm[0])) >> ((jj) & 31) & 1u; \
            const float init = bit ? SM_OFF : NEG_BIG; \
            f32x16 s0, s1; \
            _Pragma("unroll") for (int q = 0; q < 16; ++q) { s0[q] = init; s1[q] = init; } \
            _Pragma("unroll") for (int sl = 0; sl < 4; ++sl) { s0 = mfma32(kX[2 * sl], qf[sl], s0); s1 = mfma32(kX[2 * sl + 1], qf[sl], s1); } \
            if ((jj) == qb) { int tql = tq + 1; asm volatile("" : "+v"(tql)); mask_lt(s0, s1, tql, hi); } \
            exp_tile(s0, s1, lsum); \
            _Pragma("unroll") for (int sq = 0; sq < 4; ++sq) { \
                const f32x16& pp = (sq < 2) ? s0 : s1; const int rb = (sq & 1) * 8; \
                u32x4 pw; \
                pw.x = pg8::cvt_pk_bf16(pp[rb + 0], pp[rb + 1]); pw.y = pg8::cvt_pk_bf16(pp[rb + 2], pp[rb + 3]); pw.z = pg8::cvt_pk_bf16(pp[rb + 4], pp[rb + 5]); pw.w = pg8::cvt_pk_bf16(pp[rb + 6], pp[rb + 7]); \
                const bf16x8 pb = __builtin_bit_cast(bf16x8, pw); \
                _Pragma("unroll") for (int dt = 0; dt < 2; ++dt) o[dt] = mfma32(vX[dt * 4 + sq], pb, o[dt]); } } while (0)
        int j; SEL_NEXT(j);
        bf16x8 kA[8], vA[8], kB[8], vB[8];
        if (j >= 0) SEL_LOAD(kA, vA, j);
        while (j >= 0) {
            int jn; SEL_NEXT(jn);
            if (jn >= 0) SEL_LOAD(kB, vB, jn);
            SEL_COMPUTE(kA, vA, j);
            if (jn < 0) break;
            j = jn; SEL_NEXT(jn);
            if (jn >= 0) SEL_LOAD(kA, vA, jn);
            SEL_COMPUTE(kB, vB, j);
            j = jn;
        }
#undef SEL_LOAD
#undef SEL_COMPUTE
#undef SEL_NEXT
        lsum = sum_halves(lsum);
        const float sc = gt[1] / fmaxf(lsum, 1.17549435e-38f);
#pragma unroll
        for (int q = 0; q < 16; ++q) { outl[q * 64] += sc * o[0][q]; outl[(16 + q) * 64] += sc * o[1][q]; }
    }
    __syncthreads();
    {
        const Frame F = relaunder(F_); const int tid = F.tid;
        const bf16* kw = (const bf16*)(F.ws + NS_KW) + (size_t)bg * T * 64; const bf16* vwT = (const bf16*)(F.ws + NS_VWT) + (size_t)bg * 64 * T;
        float lsum = 0.f;
#pragma unroll
        for (int q = 0; q < 16; ++q) { o[0][q] = 0.f; o[1][q] = 0.f; }
        const int j0 = qb >= 8 ? qb - 8 : 0;
        KvRegs pre = kv_load(kw, vwT, T, 64 * j0, tid);
        for (int j = j0; j <= qb; ++j) {
            kv_store(lds, j & 1, pre, tid);
            if (j + 1 <= qb) pre = kv_load(kw, vwT, T, 64 * (j + 1), tid);
            __syncthreads();
            f32x16 s0, s1; qk_tile(lds + AT_KT + (j & 1) * 9216, qf, l31, hi, s0, s1, SM_OFF);
            if (j == qb || j + 8 == qb) {
                int tql = tq + 1; asm volatile("" : "+v"(tql));
                if (j == qb) mask_lt(s0, s1, tql, hi); else mask_ge(s0, s1, tql, hi);
            }
            exp_tile(s0, s1, lsum);
            pv_tile(lds + AT_VT + (j & 1) * 9216, s0, s1, l31, hi, o);
        }
        lsum = sum_halves(lsum);
        const float sc = gt[2] / fmaxf(lsum, 1.17549435e-38f);
        bf16* yb = (bf16*)(F.ws + WS_YB) + nq * 512 + g * 256 + hd * 64;
#pragma unroll
        for (int dt = 0; dt < 2; ++dt)
#pragma unroll
            for (int j = 0; j < 4; ++j) {
                float v4[4];
#pragma unroll
                for (int r = 0; r < 4; ++r) v4[r] = outl[(16 * dt + 4 * j + r) * 64] + sc * o[dt][4 * j + r];
                u32x2 w; w.x = pg8::cvt_pk_bf16(v4[0], v4[1]); w.y = pg8::cvt_pk_bf16(v4[2], v4[3]);
                *(u32x2*)(yb + 32 * dt + 8 * j + 4 * hi) = w;
            }
    }
    __syncthreads();
}
__device__ __forceinline__ void phase_mix(const Frame& F, int l, int rep) {
    unsigned* head = (unsigned*)(F.ws + WS_CTL) + CW_QUEUE + 64 * l + 16 * rep;
    LAS int* slot = (LAS int*)(F.lds + LDS_MISC + 64);
    for (;;) {
        if (F.tid == 0) *slot = (int)__hip_atomic_fetch_add(head, 1u, __ATOMIC_RELAXED, __HIP_MEMORY_SCOPE_AGENT);
        __syncthreads();
        const int it = *slot;
        __syncthreads();
        const Frame Fi = relaunder(F);
        if (it >= 16 + 512) break;
        if (it < 16) { rw2_wg(Fi, it); __syncthreads(); }
        else { const int a = it - 16; attn_unit(Fi, ((a & 3) << 7) | (127 - (a >> 2))); }
    }
}
__device__ __forceinline__ void phase_rw1(const Frame& F, int l) {
    unsigned* head = (unsigned*)(F.ws + WS_CTL) + CW_QUEUE + 64 * l + 32;
    LAS int* slot = (LAS int*)(F.lds + LDS_MISC + 64);
    for (;;) {
        if (F.tid == 0) *slot = (int)__hip_atomic_fetch_add(head, 2u, __ATOMIC_RELAXED, __HIP_MEMORY_SCOPE_AGENT);
        __syncthreads();
        const int u0 = *slot;
        __syncthreads();
        if (u0 >= 2048) break;
        { const Frame Fi = relaunder(F); rw1_unit(Fi, u0); }
        { const Frame Fi = relaunder(F); rw1_unit(Fi, u0 + 1); }
    }
}
__device__ __forceinline__ void phase_rw3(const Frame& F, int l) { for (int u = F.bid; u < 2048; u += F.G) { const Frame Fi = relaunder(F); rw3_unit(Fi, u, l); } }
__device__ __forceinline__ void phase_router(const Frame& F, int l) {
    LAS float* rwt = (LAS float*)F.lds;
    LAS float* lg = (LAS float*)(F.lds + 65536);
    LAS unsigned* lcnt = (LAS unsigned*)(F.lds + 65536 + 2048);
    if (F.tid < 32) lcnt[F.tid] = 0u;
    for (int i = F.tid; i < 16384; i += NTHR) { const int c = i >> 4, e = i & 15; rwt[e * 1024 + c] = F.in(I_RTW)[i]; }
    __syncthreads();
    const bf16* xin = (const bf16*)(F.ws + WS_XR);
    int* texp = (int*)(F.ws + WS_TOK); int* tpos = (int*)(F.ws + WS_TOK + 131072); float* tw = (float*)(F.ws + WS_TOK + 2 * 131072);
    unsigned* cnt = (unsigned*)(F.ws + WS_CTL) + CW_CNT + 64 * l;
    const float* ng = F.in(I_NORMG) + (size_t)(l * 2 + 1) * D;
    LAS float* mylg = lg + F.wave * 64;
    bf16* H2 = (bf16*)(F.ws + WS_H); int* e2t = (int*)(F.ws + WS_E2T);
    for (int n4 = (F.bid * NWAVE + F.wave) * 4; n4 < NTOK; n4 += F.G * NWAVE * 4) {
        const int b = n4 / T; const float* sh = F.modp(l, b) + 3072; const float* scp = sh + 1024;
        float hv[4][16];
#pragma unroll
        for (int tk = 0; tk < 4; ++tk) {
            f32x4 xv[4]; float ss = 0.f;
#pragma unroll
            for (int j = 0; j < 4; ++j) { const u32x2 xr = *(const u32x2*)(xin + (size_t)(n4 + tk) * D + 4 * F.lane + 256 * j); xv[j] = (f32x4){bflo(xr.x), bfhi(xr.x), bflo(xr.y), bfhi(xr.y)}; ss += xv[j][0] * xv[j][0] + xv[j][1] * xv[j][1] + xv[j][2] * xv[j][2] + xv[j][3] * xv[j][3]; }
            ss = sum64(ss);
            const float inv = __builtin_amdgcn_rsqf(ss * (1.f / D) + 1e-6f);
#pragma unroll
            for (int j = 0; j < 4; ++j) { const int c = 4 * F.lane + 256 * j; const f32x4 g = *(const f32x4*)(ng + c), s1 = *(const f32x4*)(scp + c), s0 = *(const f32x4*)(sh + c);
#pragma unroll
                for (int q = 0; q < 4; ++q) hv[tk][4 * j + q] = xv[j][q] * inv * g[q] * (1.f + s1[q]) + s0[q];
                u32x2 w; w.x = pk2(hv[tk][4 * j], hv[tk][4 * j + 1]); w.y = pk2(hv[tk][4 * j + 2], hv[tk][4 * j + 3]);
                *(u32x2*)(H2 + (size_t)(n4 + tk) * D + c) = w; }
        }
        float acc[64];
#pragma unroll
        for (int i = 0; i < 64; ++i) acc[i] = 0.f;
#pragma unroll
        for (int e = 0; e < 16; ++e)
#pragma unroll
            for (int j = 0; j < 4; ++j) { const f32x4 w = *(const LAS f32x4*)(rwt + e * 1024 + 4 * F.lane + 256 * j);
#pragma unroll
                for (int tk = 0; tk < 4; ++tk) acc[tk * 16 + e] += hv[tk][4 * j] * w[0] + hv[tk][4 * j + 1] * w[1] + hv[tk][4 * j + 2] * w[2] + hv[tk][4 * j + 3] * w[3]; }
#define RT_STEP(MSK, XCHG) do { const bool up = (F.lane & (MSK)) != 0; \
            _Pragma("unroll") for (int i = 0; i < (MSK); ++i) { const float keep = up ? acc[i + (MSK)] : acc[i], send = up ? acc[i] : acc[i + (MSK)]; acc[i] = keep + XCHG; } } while (0)
        RT_STEP(32, other_half(send, F.lane >> 5)); RT_STEP(16, xor_lane<16>(send)); RT_STEP(8, xor_lane<8>(send)); RT_STEP(4, xor_lane<4>(send)); RT_STEP(2, xor_lane<2>(send)); RT_STEP(1, xor_lane<1>(send));
#undef RT_STEP
        mylg[F.lane] = acc[0];
        __builtin_amdgcn_fence(__ATOMIC_RELEASE, "workgroup"); __builtin_amdgcn_s_waitcnt(0xc07f); __builtin_amdgcn_fence(__ATOMIC_ACQUIRE, "workgroup");
        if (F.lane < 4) {
            const int tk = F.lane, n = n4 + tk;
            float sc[16], sl[16];
#pragma unroll
            for (int e = 0; e < 16; ++e) { sc[e] = sigmoidf_(mylg[tk * 16 + e]); sl[e] = sc[e] + F.in(I_RTB)[e]; }
            int bestg = 0; float bests = -1e30f;
#pragma unroll
            for (int gq = 0; gq < 4; ++gq) { float m1 = -1e30f, m2 = -1e30f;
#pragma unroll
                for (int j = 0; j < 4; ++j) { const float v = sl[gq * 4 + j]; if (v > m1) { m2 = m1; m1 = v; } else if (v > m2) m2 = v; }
                const float gs = m1 + m2; if (gs > bests) { bests = gs; bestg = gq; } }
            float v1 = -1e30f, v2 = -1e30f; int e1 = 0, e2 = 0; float s1 = 0.f, s2 = 0.f;
#pragma unroll
            for (int gq = 0; gq < 4; ++gq)
#pragma unroll
                for (int j = 0; j < 4; ++j) { if (gq == bestg) { const float v = sl[gq * 4 + j], s = sc[gq * 4 + j]; const int e = gq * 4 + j;
                    if (v > v1) { v2 = v1; e2 = e1; s2 = s1; v1 = v; e1 = e; s1 = s; } else if (v > v2) { v2 = v; e2 = e; s2 = s; } } }
            const float den = s1 + s2;
            texp[n * 2] = e1; texp[n * 2 + 1] = e2; tw[n * 2] = s1 / den; tw[n * 2 + 1] = s2 / den;
            tpos[n * 2] = (int)__hip_atomic_fetch_add(lcnt + e1, 1u, __ATOMIC_RELAXED, __HIP_MEMORY_SCOPE_WORKGROUP);
            tpos[n * 2 + 1] = (int)__hip_atomic_fetch_add(lcnt + e2, 1u, __ATOMIC_RELAXED, __HIP_MEMORY_SCOPE_WORKGROUP);
        }
    }
    __syncthreads();
    if (F.tid < NE) { const unsigned c = lcnt[F.tid]; lcnt[16 + F.tid] = c ? __hip_atomic_fetch_add(cnt + F.tid, c, __ATOMIC_RELAXED, __HIP_MEMORY_SCOPE_AGENT) : 0u; }
    __syncthreads();
    for (int n4 = (F.bid * NWAVE + F.wave) * 4; n4 < NTOK; n4 += F.G * NWAVE * 4)
        if (F.lane < 8) { const int i = (n4 + (F.lane >> 1)) * 2 + (F.lane & 1); const int e = texp[i], p = tpos[i] + (int)lcnt[16 + e]; tpos[i] = p; e2t[e * 16384 + p] = i >> 1; }
}
constexpr int PH_PER_LAYER = 14, N_PHASES = 1 + DEPTH * PH_PER_LAYER + 1;
#define KIND(k) ((k) == 0 ? 0 : ((k) == N_PHASES - 1 ? PH_PER_LAYER + 1 : (((k) - 1) % PH_PER_LAYER) + 1))
#define IN(k) ((KSEL < 0 || KIND(k) == KSEL) && lo <= (k) && (k) < hi)
#define SEAM(k) do { if (IN(k) && IN((k) + 1)) { XcdBarrier b2_ = bar; unsigned* q_ = b2_.bar; unsigned x_ = b2_.x; asm volatile("" : "+s"(q_), "+s"(x_)); b2_.bar = q_; b2_.x = x_; xcd_barrier(b2_); } } while (0)
#define FRESH() do { int t_ = threadIdx.x; asm volatile("" : "+v"(t_)); F.tid = t_; F.lane = t_ & 63; F.wave = __builtin_amdgcn_readfirstlane(t_ >> 6); \
        const CAS Params* k_ = (const CAS Params*)__builtin_amdgcn_kernarg_segment_ptr(); asm volatile("" : "+s"(k_)); F.p = k_; \
        GAS unsigned char* w_ = (GAS unsigned char*)k_->ws; asm volatile("" : "+s"(w_)); F.ws = (unsigned char*)w_; int b_ = blockIdx.x; asm volatile("" : "+s"(b_)); F.bid = b_; int g_ = gridDim.x; asm volatile("" : "+s"(g_)); F.G = g_; } while (0)

template <int KSEL, int l>
__device__ __forceinline__ void layer_phases(Frame& F, const XcdBarrier& bar, const int lo, const int hi) {
    constexpr int pb = 1 + PH_PER_LAYER * l;
        if (IN(pb + 0)) { FRESH(); if (l == 0) { phase_norm<false, true>(F, 0, 0); FRESH(); phase_convert_weights(F); } else phase_norm<true, true>(F, l, l - 1); }
        SEAM(pb + 0);
        if (IN(pb + 1)) { FRESH();
            pg8::Gemm g{(const bf16*)(F.ws + WS_H), F.lw(l, LW_WIN1), D}; pg8::StaticOrder S; S.init(NTOK, N1P, F.G, F.bid);
            pg8::EpiBf16<0> E{(bf16*)(F.ws + WS_P1), N1P, F.in(I_BIN) + (size_t)l * INC};
            pg8::gemm_phase(F.lds, g, S, E, F.tid);
        }
        SEAM(pb + 1);
        if (IN(pb + 2)) { FRESH(); phase_prep(F, l); }
        SEAM(pb + 2);
        if (IN(pb + 3)) { FRESH(); phase_compress(F, l); FRESH(); phase_rw1(F, l); }
        SEAM(pb + 3);
        if (IN(pb + 5)) { FRESH(); phase_mix(F, l, 0); }
        SEAM(pb + 5);
        if (IN(pb + 6)) { FRESH(); phase_rw3(F, l); }
        SEAM(pb + 6);
        if (IN(pb + 7)) { FRESH();
            pg8::Gemm g{(const bf16*)(F.ws + WS_H), F.lw(l, LW_WM), D}; pg8::MergePairOrder S; S.base.init(NTOK, D, F.G, F.bid);
            pg8::EpiBf16<1> E{(bf16*)(F.ws + WS_PM), NMRG, F.in(I_BIN) + (size_t)l * INC + N1};
            pg8::gemm_phase(F.lds, g, S, E, F.tid);
        }
        if (IN(pb + 8)) { FRESH();
            static_assert(WS_YB == WS_YA + (size_t)NTOK * RW * 2 && LW_UPB == LW_UPA + (size_t)D * RW * 2, "y_b follows y_a, W_up_nsa follows W_up_rwkv");
            pg8::UpPairOrder S; S.base.init(NTOK, D, F.G, F.bid);
            pg8::Gemm g{(const bf16*)(F.ws + WS_YA), F.lw(l, LW_UPA), RW}; pg8::EpiUpPair E{(const bf16*)(F.ws + WS_PM), (bf16*)(F.ws + WS_MIX)};
            pg8::gemm_phase(F.lds, g, S, E, F.tid);
        }
        SEAM(pb + 8);
        if (IN(pb + 9)) { FRESH();
            pg8::Gemm g{(const bf16*)(F.ws + WS_MIX), F.lw(l, LW_OUT), D}; pg8::StaticOrder S; S.init(NTOK, D, F.G, F.bid);
            pg8::EpiOut<(l > 0)> E{l == 0 ? (const void*)F.in(I_X) : (const void*)F.outp(), (bf16*)(F.ws + WS_XR), F.modp(l, 0) + 2048};
            pg8::gemm_phase(F.lds, g, S, E, F.tid);
        }
        SEAM(pb + 9);
        if (IN(pb + 10)) { FRESH(); phase_router(F, l); __syncthreads(); FRESH(); convert_experts(F, l); }
        SEAM(pb + 10);
        if (IN(pb + 12)) { FRESH(); const LAS int* tb = moe_tables(F, l);
            pg8::Gemm g{(const bf16*)(F.ws + WS_H), (const bf16*)(F.ws + WS_WGU), D}; pg8::MoeOrder S{tb, F.G, F.bid, (const int*)(F.ws + WS_E2T)};
            pg8::EpiGateUp E{(bf16*)(F.ws + WS_ACT)};
            pg8::gemm_phase<pg8::EpiGateUp, pg8::MoeOrder, true, true, true>(F.lds, g, S, E, F.tid);
        }
        SEAM(pb + 12);
        if (IN(pb + 13)) { FRESH(); const LAS int* tb = moe_tables(F, l);
            pg8::Gemm g{(const bf16*)(F.ws + WS_ACT), (const bf16*)(F.ws + WS_WD), DE}; pg8::MoeOrder S{tb, F.G, F.bid, (const int*)(F.ws + WS_E2T)};
            pg8::EpiBf16<0> E{(bf16*)(F.ws + WS_YBS), D, nullptr};
            pg8::gemm_phase(F.lds, g, S, E, F.tid);
        }
        SEAM(pb + 13);
    }

template <int KSEL>
__global__ void __launch_bounds__(NTHR, 2) mk_fwd(Params prm) {
    extern __shared__ __attribute__((aligned(16))) unsigned char lds_raw[];
    Frame F; F.p = (const CAS Params*)__builtin_amdgcn_kernarg_segment_ptr(); F.lds = (LAS unsigned char*)lds_raw; F.ws = F.p->ws; F.tid = threadIdx.x; F.lane = F.tid & 63; F.wave = __builtin_amdgcn_readfirstlane(F.tid >> 6); F.G = gridDim.x; F.bid = blockIdx.x;
    if (F.tid < 64) ((LAS unsigned*)(F.lds + LDS_MISC))[F.tid] = 0u;
    __syncthreads();
    const int lo = F.p->ph_lo, hi = F.p->ph_hi;
    XcdBarrier bar; bar.bar = (unsigned*)(F.ws + WS_CTL) + CW_BAR + F.p->li * XCD_BAR_WORDS; bar.x = 0; bar.st = (volatile LAS unsigned*)(F.lds + LDS_MISC);
    if (hi - lo > 1) bar = xcd_barrier_post((unsigned*)(F.ws + WS_CTL) + CW_BAR + F.p->li * XCD_BAR_WORDS, (volatile LAS unsigned*)(F.lds + LDS_MISC));
    if (IN(0)) { FRESH(); phase_prologue(F); }
    SEAM(0);
    layer_phases<KSEL, 0>(F, bar, lo, hi);
    layer_phases<KSEL, 1>(F, bar, lo, hi);
    if (IN(N_PHASES - 1)) { FRESH(); phase_norm<true, false>(F, 0, DEPTH - 1); }

}

#if MK_N_LAUNCHES == 1
static hipError_t set_lds_attr() { return hipFuncSetAttribute((const void*)mk_fwd<-1>, hipFuncAttributeMaxDynamicSharedMemorySize, LDS_BYTES); }
#else
template <int K> static hipError_t set_lds_attr_k() { hipError_t e = hipFuncSetAttribute((const void*)mk_fwd<K>, hipFuncAttributeMaxDynamicSharedMemorySize, LDS_BYTES); if (e != hipSuccess) return e; if constexpr (K > 0) return set_lds_attr_k<K - 1>(); else return hipSuccess; }
static hipError_t set_lds_attr() { return set_lds_attr_k<PH_PER_LAYER + 1>(); }
template <int K> static void launch_kind_k(int kind, int grid, hipStream_t stream, const Params& p) {
    if (kind == K) { hipLaunchKernelGGL(mk_fwd<K>, dim3(grid), dim3(NTHR), LDS_BYTES, stream, p); return; }
    if constexpr (K > 0) launch_kind_k<K - 1>(kind, grid, stream, p);
}
static void launch_kind(int kind, int grid, hipStream_t stream, const Params& p) { launch_kind_k<PH_PER_LAYER + 1>(kind, grid, stream, p); }
#endif
extern "C" void kernel_launch(void* const* d_in, const int* in_sizes, int n_in, void* d_out, int out_size, void* d_ws, size_t ws_size, hipStream_t stream) {
    static int grid = 0;
    if (grid == 0) {
        if (n_in != 30 || in_sizes[0] != NTOK * D || out_size != NTOK * D || ws_size < WS_END) {
            fprintf(stderr, "kernel_launch: unexpected problem: n_in %d in0 %d out %d ws %zu (need %zu); nothing launched\n", n_in, n_in > 0 ? in_sizes[0] : -1, out_size, ws_size, (size_t)WS_END); grid = -1; return; }
        int dev = 0, cus = 0;
        if (hipGetDevice(&dev) != hipSuccess || hipDeviceGetAttribute(&cus, hipDeviceAttributeMultiprocessorCount, dev) != hipSuccess) { grid = -1; return; }
        if (set_lds_attr() != hipSuccess) { fprintf(stderr, "kernel_launch: hipFuncSetAttribute failed\n"); grid = -1; return; }
        (void)hipGetLastError();
        grid = cus;
    }
    if (grid < 0) return;
    (void)hipMemsetAsync((char*)d_ws + WS_CTL, 0, CTL_BYTES, stream);
    Params p{};
    for (int i = 0; i < 30; ++i) p.in[i] = (const float*)d_in[i];
    p.out = (float*)d_out; p.ws = (unsigned char*)d_ws;
#if MK_N_LAUNCHES == 1
#ifdef MK_CUTS
    { const int cuts[] = {0, MK_CUTS, N_PHASES}; const int nc = (int)(sizeof(cuts) / sizeof(int));
      for (int i = 0; i + 1 < nc; ++i) { p.ph_lo = cuts[i]; p.ph_hi = cuts[i + 1]; p.li = i; hipLaunchKernelGGL(mk_fwd<-1>, dim3(grid), dim3(NTHR), LDS_BYTES, stream, p); } }
#else
    p.ph_lo = 0; p.ph_hi = N_PHASES;
    hipLaunchKernelGGL(mk_fwd<-1>, dim3(grid), dim3(NTHR), LDS_BYTES, stream, p);
#endif
#else
    for (int k = 0; k < N_PHASES; ++k) { p.ph_lo = k; p.ph_hi = k + 1; launch_kind(KIND(k), grid, stream, p); }
#endif
}
```
